# Optimizing an MI355X kernel written in HIP

```python
import jax, jax.numpy as jnp
from jax import lax
import numpy as np

D_MODEL = 1024
BATCH = 4
SEQ = 8192
DEPTH = 1

PLE_DIM = 256
ROPE_THETA = 10000.0
EPS = 1e-6
NEG_INF = -1e30

MOBA_HEADS = 8
MOBA_HEAD_DIM = 64
MOBA_WIDTH = MOBA_HEADS * MOBA_HEAD_DIM
MOBA_BLOCK = 256
MOBA_TOPK = 3
MOBA_Q_CHUNK = 64

MLA_HEADS = 8
MLA_Q_RANK = 256
MLA_KV_RANK = 128
MLA_NOPE_DIM = 64
MLA_ROPE_DIM = 32
MLA_V_DIM = 64
MLA_QK_DIM = MLA_NOPE_DIM + MLA_ROPE_DIM
MLA_WIDTH = MLA_HEADS * MLA_V_DIM
MLA_Q_CHUNK = 128

D_FF = -(-8 * D_MODEL // (3 * 256)) * 256

IN_SIZES = (MOBA_WIDTH, MOBA_WIDTH, MOBA_WIDTH,
            MLA_Q_RANK, MLA_KV_RANK, MLA_ROPE_DIM,
            D_MODEL, D_MODEL)
IN_COLS = sum(IN_SIZES)

kernel_name = "hybrid_moba_mla_gated_block"


def _split_cols(t, sizes):
    offs = np.cumsum(sizes)[:-1].tolist()
    return jnp.split(t, offs, axis=-1)


def rmsnorm(x, g):
    xf = x.astype(jnp.float32)
    xf = xf * lax.rsqrt(jnp.mean(xf * xf, axis=-1, keepdims=True) + EPS)
    return (xf * g.astype(jnp.float32)).astype(x.dtype)


def rope(x, pos):
    d = x.shape[-1]
    half = d // 2
    inv_freq = 1.0 / (ROPE_THETA ** (jnp.arange(half, dtype=jnp.float32) * (2.0 / d)))
    ang = pos.astype(jnp.float32)[:, None] * inv_freq[None, :]
    cos = jnp.cos(ang).astype(x.dtype)
    sin = jnp.sin(ang).astype(x.dtype)
    x1, x2 = x[..., :half], x[..., half:]
    return jnp.concatenate([x1 * cos - x2 * sin, x2 * cos + x1 * sin], axis=-1)


def split_heads(t, n_heads):
    b, s, w = t.shape
    return t.reshape(b, s, n_heads, w // n_heads).transpose(0, 2, 1, 3)


def merge_heads(t):
    b, h, s, d = t.shape
    return t.transpose(0, 2, 1, 3).reshape(b, s, h * d)


def moba_attention(q, k, v):
    B, H, S, Dh = q.shape
    nb = -(-S // MOBA_BLOCK)
    pad = nb * MOBA_BLOCK - S
    kp = jnp.pad(k, ((0, 0), (0, 0), (0, pad), (0, 0)))
    vp = jnp.pad(v, ((0, 0), (0, 0), (0, pad), (0, 0)))
    kb = kp.reshape(B, H, nb, MOBA_BLOCK, Dh)
    vb = vp.reshape(B, H, nb, MOBA_BLOCK, Dh)
    k_mean = jnp.mean(kb.astype(jnp.float32), axis=3)
    k_sel_n = min(MOBA_TOPK, nb)
    scale = Dh ** -0.5
    n_chunks = S // MOBA_Q_CHUNK
    gather_blocks = jax.vmap(jax.vmap(lambda blocks, idx: blocks[idx]))

    def chunk(c):
        q0 = c * MOBA_Q_CHUNK
        qc = lax.dynamic_slice_in_dim(q, q0, MOBA_Q_CHUNK, axis=2)
        qpos = q0 + jnp.arange(MOBA_Q_CHUNK)
        cur = q0 // MOBA_BLOCK
        gate = jnp.einsum('bhqd,bhnd->bhqn', qc.astype(jnp.float32), k_mean)
        past = jnp.arange(nb) < cur
        gate = jnp.where(past[None, None, None, :], gate, NEG_INF)
        gval, idx = lax.top_k(gate, k_sel_n)
        valid = gval > (NEG_INF * 0.5)
        k_sel = gather_blocks(kb, idx)
        v_sel = gather_blocks(vb, idx)
        s_sel = jnp.einsum('bhqd,bhqkjd->bhqkj', qc, k_sel).astype(jnp.float32) * scale
        s_sel = jnp.where(valid[..., None], s_sel, NEG_INF)
        s_sel = s_sel.reshape(B, H, MOBA_Q_CHUNK, k_sel_n * MOBA_BLOCK)
        k_own = lax.dynamic_index_in_dim(kb, cur, axis=2, keepdims=False)
        v_own = lax.dynamic_index_in_dim(vb, cur, axis=2, keepdims=False)
        kpos = cur * MOBA_BLOCK + jnp.arange(MOBA_BLOCK)
        s_own = jnp.einsum('bhqd,bhjd->bhqj', qc, k_own).astype(jnp.float32) * scale
        s_own = jnp.where((kpos[None, :] <= qpos[:, None])[None, None], s_own, NEG_INF)
        probs = jax.nn.softmax(jnp.concatenate([s_sel, s_own], axis=-1), axis=-1).astype(v.dtype)
        p_sel = probs[..., :k_sel_n * MOBA_BLOCK].reshape(B, H, MOBA_Q_CHUNK, k_sel_n, MOBA_BLOCK)
        p_own = probs[..., k_sel_n * MOBA_BLOCK:]
        return (jnp.einsum('bhqkj,bhqkjd->bhqd', p_sel, v_sel)
                + jnp.einsum('bhqj,bhjd->bhqd', p_own, v_own))

    out = lax.map(chunk, jnp.arange(n_chunks))
    return jnp.moveaxis(out, 0, 2).reshape(B, H, S, Dh)


def mla_attention(q_nope, q_rope, k_nope, k_rope, v):
    B, H, S, _ = q_nope.shape
    scale = MLA_QK_DIM ** -0.5
    kpos = jnp.arange(S)
    n_chunks = S // MLA_Q_CHUNK

    def chunk(c):
        q0 = c * MLA_Q_CHUNK
        qn = lax.dynamic_slice_in_dim(q_nope, q0, MLA_Q_CHUNK, axis=2)
        qr = lax.dynamic_slice_in_dim(q_rope, q0, MLA_Q_CHUNK, axis=2)
        s = (jnp.einsum('bhqd,bhkd->bhqk', qn, k_nope)
             + jnp.einsum('bhqd,bkd->bhqk', qr, k_rope)).astype(jnp.float32) * scale
        qpos = q0 + jnp.arange(MLA_Q_CHUNK)
        s = jnp.where((kpos[None, :] <= qpos[:, None])[None, None], s, NEG_INF)
        probs = jax.nn.softmax(s, axis=-1).astype(v.dtype)
        return jnp.einsum('bhqk,bhkd->bhqd', probs, v)

    out = lax.map(chunk, jnp.arange(n_chunks))
    return jnp.moveaxis(out, 0, 2).reshape(B, H, S, MLA_V_DIM)


def setup_inputs(seed: int = 0) -> dict:
    key = jax.random.key(seed)
    ks = jax.random.split(key, 20)

    def w(k, shape, fan_in):
        return jax.random.normal(k, shape, jnp.float32) * (fan_in ** -0.5)

    def gain(k, shape):
        return 1.0 + 0.05 * jax.random.normal(k, shape, jnp.float32)

    return {
        "x": jax.random.normal(ks[0], (BATCH, SEQ, D_MODEL), jnp.float32),
        "p": jax.random.normal(ks[1], (DEPTH, BATCH, SEQ, PLE_DIM), jnp.float32),
        "attn_norm": gain(ks[2], (DEPTH, D_MODEL)),
        "w_in": w(ks[3], (DEPTH, D_MODEL, IN_COLS), D_MODEL),
        "mla_q_norm": gain(ks[4], (DEPTH, MLA_Q_RANK)),
        "w_q_b": w(ks[5], (DEPTH, MLA_Q_RANK, MLA_HEADS * MLA_QK_DIM), MLA_Q_RANK),
        "mla_kv_norm": gain(ks[6], (DEPTH, MLA_KV_RANK)),
        "w_kv_b": w(ks[7], (DEPTH, MLA_KV_RANK, MLA_HEADS * (MLA_NOPE_DIM + MLA_V_DIM)), MLA_KV_RANK),
        "w_moba_branch": w(ks[8], (DEPTH, MOBA_WIDTH, D_MODEL), MOBA_WIDTH),
        "w_mla_branch": w(ks[9], (DEPTH, MLA_WIDTH, D_MODEL), MLA_WIDTH),
        "w_o": w(ks[10], (DEPTH, D_MODEL, D_MODEL), D_MODEL),
        "ffn_norm": gain(ks[11], (DEPTH, D_MODEL)),
        "w_gate_up": w(ks[12], (DEPTH, D_MODEL, 2 * D_FF), D_MODEL),
        "w_down": w(ks[13], (DEPTH, D_FF, D_MODEL), D_FF),
        "ple_norm": gain(ks[14], (DEPTH, D_MODEL)),
        "w_ple_gate": w(ks[15], (DEPTH, D_MODEL, D_MODEL), D_MODEL),
        "w_ple_proj": w(ks[16], (DEPTH, PLE_DIM, D_MODEL), PLE_DIM),
        "final_norm": gain(ks[17], (D_MODEL,)),
    }


def reference(x, p, attn_norm, w_in, mla_q_norm, w_q_b, mla_kv_norm, w_kv_b,
              w_moba_branch, w_mla_branch, w_o, ffn_norm, w_gate_up, w_down,
              ple_norm, w_ple_gate, w_ple_proj, final_norm):
    B, S, _ = x.shape
    pos = jnp.arange(S)
    for i in range(DEPTH):
        h = rmsnorm(x, attn_norm[i])
        proj = h @ w_in[i]
        qa, ka, va, cq, ckv, kr, ga, gb = _split_cols(proj, IN_SIZES)

        qa = rope(split_heads(qa, MOBA_HEADS), pos)
        ka = rope(split_heads(ka, MOBA_HEADS), pos)
        va = split_heads(va, MOBA_HEADS)
        ya = merge_heads(moba_attention(qa, ka, va)) @ w_moba_branch[i]

        qm = split_heads(rmsnorm(cq, mla_q_norm[i]) @ w_q_b[i], MLA_HEADS)
        q_nope, q_rope = qm[..., :MLA_NOPE_DIM], rope(qm[..., MLA_NOPE_DIM:], pos)
        kvm = split_heads(rmsnorm(ckv, mla_kv_norm[i]) @ w_kv_b[i], MLA_HEADS)
        k_nope, vm = kvm[..., :MLA_NOPE_DIM], kvm[..., MLA_NOPE_DIM:]
        k_rope = rope(kr, pos)
        yb = merge_heads(mla_attention(q_nope, q_rope, k_nope, k_rope, vm)) @ w_mla_branch[i]

        mix = jax.nn.sigmoid(ga) * ya + jax.nn.sigmoid(gb) * yb
        x = x + mix @ w_o[i]

        h = rmsnorm(x, ffn_norm[i])
        g, u = jnp.split(h @ w_gate_up[i], 2, axis=-1)
        x = x + (jax.nn.silu(g) * u) @ w_down[i]

        h = rmsnorm(x, ple_norm[i])
        x = x + jax.nn.sigmoid(h @ w_ple_gate[i]) * (p[i] @ w_ple_proj[i])
    return rmsnorm(x, final_norm)
```

```cpp
#include <hip/hip_runtime.h>
#include <cstdio>
#include <cstdint>
namespace refp {
constexpr int S = 8192, DM = 1024, INC = 4000, DFF = 2816;
constexpr float EPS = 1e-6f;

__device__ __forceinline__ void sincos_acc(float ang, float& c, float& s) {
    const double x = (double)ang;
    const double k = __builtin_rint(x * 0.63661977236758134308);
    const double r = __builtin_fma(-k, 1.5707963267948966192, x) - k * 6.123233995736766036e-17;
    const double r2 = r * r;
    double sp = -2.5052108385441718775e-08; sp = sp * r2 + 2.7557319223985890653e-06; sp = sp * r2 - 1.9841269841269841270e-04; sp = sp * r2 + 8.3333333333333333333e-03; sp = sp * r2 - 1.6666666666666666667e-01;
    const double sn = r + r * r2 * sp;
    double cp = 2.0876756987868098979e-09; cp = cp * r2 - 2.7557319223985890653e-07; cp = cp * r2 + 2.4801587301587301587e-05; cp = cp * r2 - 1.3888888888888888889e-03; cp = cp * r2 + 4.1666666666666666667e-02; cp = cp * r2 - 0.5;
    const double cs = 1.0 + r2 * cp;
    const int q = (int)((long long)k & 3);
    const double cc = (q == 0) ? cs : (q == 1) ? -sn : (q == 2) ? -cs : sn;
    const double ss = (q == 0) ? sn : (q == 1) ? cs : (q == 2) ? -sn : -cs;
    c = (float)cc; s = (float)ss;
}
__global__ void rope_tab_k(float2* tab64, float2* tab32) {
    const int idx = blockIdx.x * blockDim.x + threadIdx.x;
    if (idx >= S * 48) return;
    const int t = idx / 48, j = idx % 48;
    const int half = (j < 32) ? 32 : 16, i = (j < 32) ? j : j - 32;
    const float e = (float)i * (2.0f / (float)(2 * half));
    const float inv = 1.0f / powf(10000.0f, e);
    const float ang = (float)t * inv;
    float c, s; sincos_acc(ang, c, s);
    if (j < 32) tab64[t * 32 + i] = make_float2(c, s); else tab32[t * 16 + i] = make_float2(c, s);
}

__global__ void rmsnorm_k(const float* x, int ldx, const float* g, float* y, int ldy, int D, int rows) {
    const int row = blockIdx.x * 4 + (threadIdx.x >> 6), lane = threadIdx.x & 63;
    if (row >= rows) return;
    const float* xr = x + (size_t)row * ldx; float s = 0.f;
    for (int i = lane; i < D; i += 64) { const float v = xr[i]; s += v * v; }
    for (int o = 32; o > 0; o >>= 1) s += __shfl_xor(s, o);
    const float r = 1.0f / sqrtf(s / (float)D + EPS);
    float* yr = y + (size_t)row * ldy;
    for (int i = lane; i < D; i += 64) yr[i] = xr[i] * r * (g ? g[i] : 1.0f);
}

__global__ __launch_bounds__(256) void gemm_k(const float* A, int lda, const float* B, int ldb, float* C, int ldc, const float* R, int ldr, int M, int N, int K) {
    __shared__ float As[16][68];
    __shared__ float Bs[16][68];
    const int tid = threadIdx.x, tx = tid & 15, ty = tid >> 4;
    const int m0 = blockIdx.y * 64, n0 = blockIdx.x * 64;
    float acc[4][4];
#pragma unroll
    for (int i = 0; i < 4; ++i)
#pragma unroll
        for (int j = 0; j < 4; ++j) acc[i][j] = 0.f;
    const int ar = tid >> 2, ac = (tid & 3) * 4;
    const int br = tid >> 4, bc = (tid & 15) * 4;
    for (int k0 = 0; k0 < K; k0 += 16) {
        const float4 av = *(const float4*)(A + (size_t)(m0 + ar) * lda + k0 + ac);
        float4 bv = make_float4(0.f, 0.f, 0.f, 0.f);
        if (n0 + bc < N) bv = *(const float4*)(B + (size_t)(k0 + br) * ldb + n0 + bc);
        __syncthreads();
        As[ac + 0][ar] = av.x; As[ac + 1][ar] = av.y; As[ac + 2][ar] = av.z; As[ac + 3][ar] = av.w;
        Bs[br][bc + 0] = bv.x; Bs[br][bc + 1] = bv.y; Bs[br][bc + 2] = bv.z; Bs[br][bc + 3] = bv.w;
        __syncthreads();
#pragma unroll
        for (int kk = 0; kk < 16; ++kk) {
            float a[4], b[4];
#pragma unroll
            for (int i = 0; i < 4; ++i) a[i] = As[kk][ty * 4 + i];
#pragma unroll
            for (int j = 0; j < 4; ++j) b[j] = Bs[kk][tx * 4 + j];
#pragma unroll
            for (int i = 0; i < 4; ++i)
#pragma unroll
                for (int j = 0; j < 4; ++j) acc[i][j] = fmaf(a[i], b[j], acc[i][j]);
        }
    }
#pragma unroll
    for (int i = 0; i < 4; ++i) {
        const int row = m0 + ty * 4 + i, col = n0 + tx * 4;
        if (col < N) {
            float4 o = make_float4(acc[i][0], acc[i][1], acc[i][2], acc[i][3]);
            if (R) { const float4 r = *(const float4*)(R + (size_t)row * ldr + col); o.x += r.x; o.y += r.y; o.z += r.z; o.w += r.w; }
            *(float4*)(C + (size_t)row * ldc + col) = o;
        }
    }
}

__global__ void rope_k(float* buf, int ld, int col0, int nheads, int d, int hstride, const float2* tab, int rows) {
    const int half = d / 2; const long idx = (long)blockIdx.x * blockDim.x + threadIdx.x; const long total = (long)rows * nheads * half;
    if (idx >= total) return;
    const int i = (int)(idx % half); const int h = (int)((idx / half) % nheads); const int t = (int)(idx / ((long)half * nheads));
    const float2 cs = tab[t * half + i];
    float* p = buf + (size_t)t * ld + col0 + h * hstride;
    const float x1 = p[i], x2 = p[i + half];
    p[i] = x1 * cs.x - x2 * cs.y; p[i + half] = x2 * cs.x + x1 * cs.y;
}

__global__ void kmean_k(const float* Kb, int ld, float* kmean) {
    const int blk = blockIdx.x, h = blockIdx.y, d = threadIdx.x; float s = 0.f;
    for (int j = 0; j < 256; ++j) s += Kb[(size_t)(blk * 256 + j) * ld + h * 64 + d];
    kmean[(h * 32 + blk) * 64 + d] = s * (1.0f / 256.0f);
}

template <int D2, bool MOBA>
__global__ __launch_bounds__(256) void attn_k(const float* Q, int ldq, int qstride  , const float* K1, int ldk1, int k1stride, const float* K2, int ldk2,
                                              const float* V, int ldv, int vstride, float* O, int ldo, const float* kmean, float scale) {
    constexpr int KT = 16;
    __shared__ float sk1[KT][64];
    __shared__ float sk2[KT][D2 > 0 ? D2 : 1];
    __shared__ float sv[KT][64];
    const int qb = blockIdx.x, h = blockIdx.y, tid = threadIdx.x, t = qb * 256 + tid;
    float q1[64], q2[D2 > 0 ? D2 : 1], o[64];
    const float* qp = Q + (size_t)t * ldq + h * qstride;
#pragma unroll
    for (int d = 0; d < 64; ++d) { q1[d] = qp[d]; o[d] = 0.f; }
#pragma unroll
    for (int d = 0; d < D2; ++d) q2[d] = qp[64 + d];
    unsigned sel = 0u;
    if (MOBA) {
        float v0 = -3e38f, v1 = -3e38f, v2 = -3e38f; int i0 = -1, i1 = -1, i2 = -1;
        for (int j = 0; j < qb; ++j) {
            const float* km = kmean + (h * 32 + j) * 64; float g = 0.f;
#pragma unroll
            for (int d = 0; d < 64; ++d) g = fmaf(q1[d], km[d], g);
            if (g > v0) { v2 = v1; i2 = i1; v1 = v0; i1 = i0; v0 = g; i0 = j; }
            else if (g > v1) { v2 = v1; i2 = i1; v1 = g; i1 = j; }
            else if (g > v2) { v2 = g; i2 = j; }
        }
        if (i0 >= 0) sel |= 1u << i0; if (i1 >= 0) sel |= 1u << i1; if (i2 >= 0) sel |= 1u << i2;
    }
    float m = -3e38f, l = 0.f;
    const int nkeys = qb * 256 + 256;
    for (int j0 = 0; j0 < nkeys; j0 += KT) {
        __syncthreads();
        for (int e = tid; e < KT * 64; e += 256) { const int r = e >> 6, d = e & 63; sk1[r][d] = K1[(size_t)(j0 + r) * ldk1 + h * k1stride + d]; sv[r][d] = V[(size_t)(j0 + r) * ldv + h * vstride + d]; }
        if (D2 > 0) for (int e = tid; e < KT * D2; e += 256) { const int r = e / (D2 > 0 ? D2 : 1), d = e % (D2 > 0 ? D2 : 1); sk2[r][d] = K2[(size_t)(j0 + r) * ldk2 + d]; }
        __syncthreads();
        const int blk = j0 >> 8;
        bool blk_ok = true;
        if (MOBA) blk_ok = (blk == qb) || ((sel >> blk) & 1u);
        if (!blk_ok) continue;
        for (int r = 0; r < KT; ++r) {
            const int j = j0 + r;
            if (j > t) break;
            float s = 0.f;
#pragma unroll
            for (int d = 0; d < 64; ++d) s = fmaf(q1[d], sk1[r][d], s);
#pragma unroll
            for (int d = 0; d < D2; ++d) s = fmaf(q2[d], sk2[r][d], s);
            s *= scale;
            if (s > m) { const float a = __expf(m - s); l *= a;
#pragma unroll
                for (int d = 0; d < 64; ++d) o[d] *= a;
                m = s; }
            const float p = __expf(s - m); l += p;
#pragma unroll
            for (int d = 0; d < 64; ++d) o[d] = fmaf(p, sv[r][d], o[d]);
        }
    }
    const float il = 1.0f / l; float* op = O + (size_t)t * ldo + h * 64;
#pragma unroll
    for (int d = 0; d < 64; ++d) op[d] = o[d] * il;
}

__device__ __forceinline__ float sigm(float v) { return 1.0f / (1.0f + __expf(-v)); }
__global__ void mix_k(float* ya, const float* yb, const float* proj, long n) {
    const long i = (long)blockIdx.x * blockDim.x + threadIdx.x; if (i >= n) return;
    const long r = i / DM; const int c = (int)(i % DM);
    const float ga = proj[r * INC + 1952 + c], gb = proj[r * INC + 2976 + c];
    ya[i] = sigm(ga) * ya[i] + sigm(gb) * yb[i];
}
__global__ void swiglu_k(float* gu, long n) {
    const long i = (long)blockIdx.x * blockDim.x + threadIdx.x; if (i >= n) return;
    const long r = i / DFF; const int f = (int)(i % DFF);
    const float g = gu[r * 2 * DFF + f], u = gu[r * 2 * DFF + DFF + f];
    gu[r * 2 * DFF + f] = g * sigm(g) * u;
}
__global__ void ple_k(float* x, const float* gate, const float* pp, long n) {
    const long i = (long)blockIdx.x * blockDim.x + threadIdx.x; if (i >= n) return;
    x[i] += sigm(gate[i]) * pp[i];
}

struct In { const float *x, *p, *attn_norm, *w_in, *mla_q_norm, *w_q_b, *mla_kv_norm, *w_kv_b, *w_moba, *w_mla, *w_o, *ffn_norm, *w_gu, *w_down, *ple_norm, *w_pg, *w_pp, *final_norm; };

static inline void gemm(hipStream_t st, const float* A, int lda, const float* B, int ldb, float* C, int ldc, const float* R, int ldr, int M, int N, int K) {
    hipLaunchKernelGGL(gemm_k, dim3((N + 63) / 64, M / 64), dim3(256), 0, st, A, lda, B, ldb, C, ldc, R, ldr, M, N, K);
}
static inline unsigned nblk(long n, int b) { return (unsigned)((n + b - 1) / b); }

struct Bufs { float2 *tab64, *tab32; float *H, *PROJ, *CQN, *CKVN, *QM, *KVM, *KMEAN, *MO, *ML, *YA, *YB, *GU, *GATE, *PP; };
static inline Bufs carve(unsigned char* base) {
    Bufs B; size_t off = 0; auto take = [&](size_t bytes) { unsigned char* p = base + off; off += (bytes + 255) & ~(size_t)255; return p; };
    B.tab64 = (float2*)take((size_t)S * 32 * 8); B.tab32 = (float2*)take((size_t)S * 16 * 8);
    B.H = (float*)take((size_t)S * DM * 4);
    B.PROJ = (float*)take((size_t)S * INC * 4);
    B.CQN = (float*)take((size_t)S * 256 * 4); B.CKVN = (float*)take((size_t)S * 128 * 4);
    B.QM = (float*)take((size_t)S * 768 * 4); B.KVM = (float*)take((size_t)S * 1024 * 4);
    B.KMEAN = (float*)take((size_t)8 * 32 * 64 * 4);
    B.MO = (float*)take((size_t)S * 512 * 4); B.ML = (float*)take((size_t)S * 512 * 4);
    B.YA = (float*)take((size_t)S * DM * 4); B.YB = (float*)take((size_t)S * DM * 4);
    B.GU = B.PROJ;
    B.GATE = B.YA; B.PP = B.YB;
    return B;
}
constexpr size_t WS_BYTES = (size_t)400 << 20;

static inline void run_batch(hipStream_t st, const In& I, const Bufs& B, int b, float* out) {
    const size_t ro = (size_t)b * S;
    const float* xb = I.x + ro * DM; const float* pb = I.p + ro * 256; float* ob = out + ro * DM;
    hipLaunchKernelGGL(rmsnorm_k, dim3(S / 4), dim3(256), 0, st, xb, DM, I.attn_norm, B.H, DM, DM, S);
    gemm(st, B.H, DM, I.w_in, INC, B.PROJ, INC, nullptr, 0, S, INC, DM);
    hipLaunchKernelGGL(rope_k, dim3(nblk((long)S * 8 * 32, 256)), dim3(256), 0, st, B.PROJ, INC, 0, 8, 64, 64, B.tab64, S);
    hipLaunchKernelGGL(rope_k, dim3(nblk((long)S * 8 * 32, 256)), dim3(256), 0, st, B.PROJ, INC, 512, 8, 64, 64, B.tab64, S);
    hipLaunchKernelGGL(rope_k, dim3(nblk((long)S * 1 * 16, 256)), dim3(256), 0, st, B.PROJ, INC, 1920, 1, 32, 32, B.tab32, S);
    hipLaunchKernelGGL(rmsnorm_k, dim3(S / 4), dim3(256), 0, st, B.PROJ + 1536, INC, I.mla_q_norm, B.CQN, 256, 256, S);
    hipLaunchKernelGGL(rmsnorm_k, dim3(S / 4), dim3(256), 0, st, B.PROJ + 1792, INC, I.mla_kv_norm, B.CKVN, 128, 128, S);
    gemm(st, B.CQN, 256, I.w_q_b, 768, B.QM, 768, nullptr, 0, S, 768, 256);
    gemm(st, B.CKVN, 128, I.w_kv_b, 1024, B.KVM, 1024, nullptr, 0, S, 1024, 128);
    hipLaunchKernelGGL(rope_k, dim3(nblk((long)S * 8 * 16, 256)), dim3(256), 0, st, B.QM, 768, 64, 8, 32, 96, B.tab32, S);
    hipLaunchKernelGGL(kmean_k, dim3(32, 8), dim3(64), 0, st, B.PROJ + 512, INC, B.KMEAN);
    hipLaunchKernelGGL((attn_k<0, true>), dim3(32, 8), dim3(256), 0, st, B.PROJ, INC, 64, B.PROJ + 512, INC, 64, (const float*)nullptr, 0, B.PROJ + 1024, INC, 64, B.MO, 512, B.KMEAN, 0.125f);
    hipLaunchKernelGGL((attn_k<32, false>), dim3(32, 8), dim3(256), 0, st, B.QM, 768, 96, B.KVM, 1024, 128, B.PROJ + 1920, INC, B.KVM + 64, 1024, 128, B.ML, 512, (const float*)nullptr, 0.10206207261596577f);
    gemm(st, B.MO, 512, I.w_moba, DM, B.YA, DM, nullptr, 0, S, DM, 512);
    gemm(st, B.ML, 512, I.w_mla, DM, B.YB, DM, nullptr, 0, S, DM, 512);
    hipLaunchKernelGGL(mix_k, dim3(nblk((long)S * DM, 256)), dim3(256), 0, st, B.YA, B.YB, B.PROJ, (long)S * DM);
    gemm(st, B.YA, DM, I.w_o, DM, ob, DM, xb, DM, S, DM, DM);
    hipLaunchKernelGGL(rmsnorm_k, dim3(S / 4), dim3(256), 0, st, ob, DM, I.ffn_norm, B.H, DM, DM, S);
    gemm(st, B.H, DM, I.w_gu, 2 * DFF, B.GU, 2 * DFF, nullptr, 0, S, 2 * DFF, DM);
    hipLaunchKernelGGL(swiglu_k, dim3(nblk((long)S * DFF, 256)), dim3(256), 0, st, B.GU, (long)S * DFF);
    gemm(st, B.GU, 2 * DFF, I.w_down, DM, ob, DM, ob, DM, S, DM, DFF);
    hipLaunchKernelGGL(rmsnorm_k, dim3(S / 4), dim3(256), 0, st, ob, DM, I.ple_norm, B.H, DM, DM, S);
    gemm(st, B.H, DM, I.w_pg, DM, B.GATE, DM, nullptr, 0, S, DM, DM);
    gemm(st, pb, 256, I.w_pp, DM, B.PP, DM, nullptr, 0, S, DM, 256);
    hipLaunchKernelGGL(ple_k, dim3(nblk((long)S * DM, 256)), dim3(256), 0, st, ob, B.GATE, B.PP, (long)S * DM);
    hipLaunchKernelGGL(rmsnorm_k, dim3(S / 4), dim3(256), 0, st, ob, DM, I.final_norm, ob, DM, DM, S);
}
static inline void run_all(hipStream_t st, const In& I, unsigned char* ws, float* out, int nbatch) {
    const Bufs B = carve(ws);
    hipLaunchKernelGGL(rope_tab_k, dim3(nblk((long)S * 48, 256)), dim3(256), 0, st, B.tab64, B.tab32);
    for (int b = 0; b < nbatch; ++b) run_batch(st, I, B, b, out);
}
}
extern "C" void kernel_launch(void* const* d_in, const int* in_sizes, int n_in, void* d_out, int out_size, void* d_ws, size_t ws_size, hipStream_t stream) {
    if (n_in != 18 || out_size != 4 * 8192 * 1024 || ws_size < refp::WS_BYTES) { fprintf(stderr, "kernel_launch: unexpected sizes n_in %d out %d ws %zu\n", n_in, out_size, ws_size); return; }
    refp::In I;
    I.x = (const float*)d_in[0]; I.p = (const float*)d_in[1]; I.attn_norm = (const float*)d_in[2]; I.w_in = (const float*)d_in[3]; I.mla_q_norm = (const float*)d_in[4];
    I.w_q_b = (const float*)d_in[5]; I.mla_kv_norm = (const float*)d_in[6]; I.w_kv_b = (const float*)d_in[7]; I.w_moba = (const float*)d_in[8]; I.w_mla = (const float*)d_in[9];
    I.w_o = (const float*)d_in[10]; I.ffn_norm = (const float*)d_in[11]; I.w_gu = (const float*)d_in[12]; I.w_down = (const float*)d_in[13]; I.ple_norm = (const float*)d_in[14];
    I.w_pg = (const float*)d_in[15]; I.w_pp = (const float*)d_in[16]; I.final_norm = (const float*)d_in[17];
    refp::run_all(stream, I, (unsigned char*)d_ws, (float*)d_out, 4);
}
```

```cpp
#include <hip/hip_runtime.h>
#include <cstdio>
#include <cstdint>
namespace refp {
constexpr int S = 8192, DM = 1024, INC = 4000, DFF = 2816;
constexpr float EPS = 1e-6f;

__device__ __forceinline__ void sincos_acc(float ang, float& c, float& s) {
    const double x = (double)ang;
    const double k = __builtin_rint(x * 0.63661977236758134308);
    const double r = __builtin_fma(-k, 1.5707963267948966192, x) - k * 6.123233995736766036e-17;
    const double r2 = r * r;
    double sp = -2.5052108385441718775e-08; sp = sp * r2 + 2.7557319223985890653e-06; sp = sp * r2 - 1.9841269841269841270e-04; sp = sp * r2 + 8.3333333333333333333e-03; sp = sp * r2 - 1.6666666666666666667e-01;
    const double sn = r + r * r2 * sp;
    double cp = 2.0876756987868098979e-09; cp = cp * r2 - 2.7557319223985890653e-07; cp = cp * r2 + 2.4801587301587301587e-05; cp = cp * r2 - 1.3888888888888888889e-03; cp = cp * r2 + 4.1666666666666666667e-02; cp = cp * r2 - 0.5;
    const double cs = 1.0 + r2 * cp;
    const int q = (int)((long long)k & 3);
    const double cc = (q == 0) ? cs : (q == 1) ? -sn : (q == 2) ? -cs : sn;
    const double ss = (q == 0) ? sn : (q == 1) ? cs : (q == 2) ? -sn : -cs;
    c = (float)cc; s = (float)ss;
}
__global__ void rope_tab_k(float2* tab64, float2* tab32) {
    const int idx = blockIdx.x * blockDim.x + threadIdx.x;
    if (idx >= S * 48) return;
    const int t = idx / 48, j = idx % 48;
    const int half = (j < 32) ? 32 : 16, i = (j < 32) ? j : j - 32;
    const float e = (float)i * (2.0f / (float)(2 * half));
    const float inv = 1.0f / powf(10000.0f, e);
    const float ang = (float)t * inv;
    float c, s; sincos_acc(ang, c, s);
    if (j < 32) tab64[t * 32 + i] = make_float2(c, s); else tab32[t * 16 + i] = make_float2(c, s);
}

__global__ void rmsnorm_k(const float* x, int ldx, const float* g, float* y, int ldy, int D, int rows) {
    const int row = blockIdx.x * 4 + (threadIdx.x >> 6), lane = threadIdx.x & 63;
    if (row >= rows) return;
    const float* xr = x + (size_t)row * ldx; float s = 0.f;
    for (int i = lane; i < D; i += 64) { const float v = xr[i]; s += v * v; }
    for (int o = 32; o > 0; o >>= 1) s += __shfl_xor(s, o);
    const float r = 1.0f / sqrtf(s / (float)D + EPS);
    float* yr = y + (size_t)row * ldy;
    for (int i = lane; i < D; i += 64) yr[i] = xr[i] * r * (g ? g[i] : 1.0f);
}

__global__ __launch_bounds__(256) void gemm_k(const float* A, int lda, const float* B, int ldb, float* C, int ldc, const float* R, int ldr, int M, int N, int K) {
    __shared__ float As[16][68];
    __shared__ float Bs[16][68];
    const int tid = threadIdx.x, tx = tid & 15, ty = tid >> 4;
    const int m0 = blockIdx.y * 64, n0 = blockIdx.x * 64;
    float acc[4][4];
#pragma unroll
    for (int i = 0; i < 4; ++i)
#pragma unroll
        for (int j = 0; j < 4; ++j) acc[i][j] = 0.f;
    const int ar = tid >> 2, ac = (tid & 3) * 4;
    const int br = tid >> 4, bc = (tid & 15) * 4;
    for (int k0 = 0; k0 < K; k0 += 16) {
        const float4 av = *(const float4*)(A + (size_t)(m0 + ar) * lda + k0 + ac);
        float4 bv = make_float4(0.f, 0.f, 0.f, 0.f);
        if (n0 + bc < N) bv = *(const float4*)(B + (size_t)(k0 + br) * ldb + n0 + bc);
        __syncthreads();
        As[ac + 0][ar] = av.x; As[ac + 1][ar] = av.y; As[ac + 2][ar] = av.z; As[ac + 3][ar] = av.w;
        Bs[br][bc + 0] = bv.x; Bs[br][bc + 1] = bv.y; Bs[br][bc + 2] = bv.z; Bs[br][bc + 3] = bv.w;
        __syncthreads();
#pragma unroll
        for (int kk = 0; kk < 16; ++kk) {
            float a[4], b[4];
#pragma unroll
            for (int i = 0; i < 4; ++i) a[i] = As[kk][ty * 4 + i];
#pragma unroll
            for (int j = 0; j < 4; ++j) b[j] = Bs[kk][tx * 4 + j];
#pragma unroll
            for (int i = 0; i < 4; ++i)
#pragma unroll
                for (int j = 0; j < 4; ++j) acc[i][j] = fmaf(a[i], b[j], acc[i][j]);
        }
    }
#pragma unroll
    for (int i = 0; i < 4; ++i) {
        const int row = m0 + ty * 4 + i, col = n0 + tx * 4;
        if (col < N) {
            float4 o = make_float4(acc[i][0], acc[i][1], acc[i][2], acc[i][3]);
            if (R) { const float4 r = *(const float4*)(R + (size_t)row * ldr + col); o.x += r.x; o.y += r.y; o.z += r.z; o.w += r.w; }
            *(float4*)(C + (size_t)row * ldc + col) = o;
        }
    }
}

__global__ void rope_k(float* buf, int ld, int col0, int nheads, int d, int hstride, const float2* tab, int rows) {
    const int half = d / 2; const long idx = (long)blockIdx.x * blockDim.x + threadIdx.x; const long total = (long)rows * nheads * half;
    if (idx >= total) return;
    const int i = (int)(idx % half); const int h = (int)((idx / half) % nheads); const int t = (int)(idx / ((long)half * nheads));
    const float2 cs = tab[t * half + i];
    float* p = buf + (size_t)t * ld + col0 + h * hstride;
    const float x1 = p[i], x2 = p[i + half];
    p[i] = x1 * cs.x - x2 * cs.y; p[i + half] = x2 * cs.x + x1 * cs.y;
}

__global__ void kmean_k(const float* Kb, int ld, float* kmean) {
    const int blk = blockIdx.x, h = blockIdx.y, d = threadIdx.x; float s = 0.f;
    for (int j = 0; j < 256; ++j) s += Kb[(size_t)(blk * 256 + j) * ld + h * 64 + d];
    kmean[(h * 32 + blk) * 64 + d] = s * (1.0f / 256.0f);
}

template <int D2, bool MOBA>
__global__ __launch_bounds__(256) void attn_k(const float* Q, int ldq, int qstride  , const float* K1, int ldk1, int k1stride, const float* K2, int ldk2,
                                              const float* V, int ldv, int vstride, float* O, int ldo, const float* kmean, float scale) {
    constexpr int KT = 16;
    __shared__ float sk1[KT][64];
    __shared__ float sk2[KT][D2 > 0 ? D2 : 1];
    __shared__ float sv[KT][64];
    const int qb = blockIdx.x, h = blockIdx.y, tid = threadIdx.x, t = qb * 256 + tid;
    float q1[64], q2[D2 > 0 ? D2 : 1], o[64];
    const float* qp = Q + (size_t)t * ldq + h * qstride;
#pragma unroll
    for (int d = 0; d < 64; ++d) { q1[d] = qp[d]; o[d] = 0.f; }
#pragma unroll
    for (int d = 0; d < D2; ++d) q2[d] = qp[64 + d];
    unsigned sel = 0u;
    if (MOBA) {
        float v0 = -3e38f, v1 = -3e38f, v2 = -3e38f; int i0 = -1, i1 = -1, i2 = -1;
        for (int j = 0; j < qb; ++j) {
            const float* km = kmean + (h * 32 + j) * 64; float g = 0.f;
#pragma unroll
            for (int d = 0; d < 64; ++d) g = fmaf(q1[d], km[d], g);
            if (g > v0) { v2 = v1; i2 = i1; v1 = v0; i1 = i0; v0 = g; i0 = j; }
            else if (g > v1) { v2 = v1; i2 = i1; v1 = g; i1 = j; }
            else if (g > v2) { v2 = g; i2 = j; }
        }
        if (i0 >= 0) sel |= 1u << i0; if (i1 >= 0) sel |= 1u << i1; if (i2 >= 0) sel |= 1u << i2;
    }
    float m = -3e38f, l = 0.f;
    const int nkeys = qb * 256 + 256;
    for (int j0 = 0; j0 < nkeys; j0 += KT) {
        __syncthreads();
        for (int e = tid; e < KT * 64; e += 256) { const int r = e >> 6, d = e & 63; sk1[r][d] = K1[(size_t)(j0 + r) * ldk1 + h * k1stride + d]; sv[r][d] = V[(size_t)(j0 + r) * ldv + h * vstride + d]; }
        if (D2 > 0) for (int e = tid; e < KT * D2; e += 256) { const int r = e / (D2 > 0 ? D2 : 1), d = e % (D2 > 0 ? D2 : 1); sk2[r][d] = K2[(size_t)(j0 + r) * ldk2 + d]; }
        __syncthreads();
        const int blk = j0 >> 8;
        bool blk_ok = true;
        if (MOBA) blk_ok = (blk == qb) || ((sel >> blk) & 1u);
        if (!blk_ok) continue;
        for (int r = 0; r < KT; ++r) {
            const int j = j0 + r;
            if (j > t) break;
            float s = 0.f;
#pragma unroll
            for (int d = 0; d < 64; ++d) s = fmaf(q1[d], sk1[r][d], s);
#pragma unroll
            for (int d = 0; d < D2; ++d) s = fmaf(q2[d], sk2[r][d], s);
            s *= scale;
            if (s > m) { const float a = __expf(m - s); l *= a;
#pragma unroll
                for (int d = 0; d < 64; ++d) o[d] *= a;
                m = s; }
            const float p = __expf(s - m); l += p;
#pragma unroll
            for (int d = 0; d < 64; ++d) o[d] = fmaf(p, sv[r][d], o[d]);
        }
    }
    const float il = 1.0f / l; float* op = O + (size_t)t * ldo + h * 64;
#pragma unroll
    for (int d = 0; d < 64; ++d) op[d] = o[d] * il;
}

__device__ __forceinline__ float sigm(float v) { return 1.0f / (1.0f + __expf(-v)); }
__global__ void mix_k(float* ya, const float* yb, const float* proj, long n) {
    const long i = (long)blockIdx.x * blockDim.x + threadIdx.x; if (i >= n) return;
    const long r = i / DM; const int c = (int)(i % DM);
    const float ga = proj[r * INC + 1952 + c], gb = proj[r * INC + 2976 + c];
    ya[i] = sigm(ga) * ya[i] + sigm(gb) * yb[i];
}
__global__ void swiglu_k(float* gu, long n) {
    const long i = (long)blockIdx.x * blockDim.x + threadIdx.x; if (i >= n) return;
    const long r = i / DFF; const int f = (int)(i % DFF);
    const float g = gu[r * 2 * DFF + f], u = gu[r * 2 * DFF + DFF + f];
    gu[r * 2 * DFF + f] = g * sigm(g) * u;
}
__global__ void ple_k(float* x, const float* gate, const float* pp, long n) {
    const long i = (long)blockIdx.x * blockDim.x + threadIdx.x; if (i >= n) return;
    x[i] += sigm(gate[i]) * pp[i];
}

struct In { const float *x, *p, *attn_norm, *w_in, *mla_q_norm, *w_q_b, *mla_kv_norm, *w_kv_b, *w_moba, *w_mla, *w_o, *ffn_norm, *w_gu, *w_down, *ple_norm, *w_pg, *w_pp, *final_norm; };

static inline void gemm(hipStream_t st, const float* A, int lda, const float* B, int ldb, float* C, int ldc, const float* R, int ldr, int M, int N, int K) {
    hipLaunchKernelGGL(gemm_k, dim3((N + 63) / 64, M / 64), dim3(256), 0, st, A, lda, B, ldb, C, ldc, R, ldr, M, N, K);
}
static inline unsigned nblk(long n, int b) { return (unsigned)((n + b - 1) / b); }

struct Bufs { float2 *tab64, *tab32; float *H, *PROJ, *CQN, *CKVN, *QM, *KVM, *KMEAN, *MO, *ML, *YA, *YB, *GU, *GATE, *PP; };
static inline Bufs carve(unsigned char* base) {
    Bufs B; size_t off = 0; auto take = [&](size_t bytes) { unsigned char* p = base + off; off += (bytes + 255) & ~(size_t)255; return p; };
    B.tab64 = (float2*)take((size_t)S * 32 * 8); B.tab32 = (float2*)take((size_t)S * 16 * 8);
    B.H = (float*)take((size_t)S * DM * 4);
    B.PROJ = (float*)take((size_t)S * INC * 4);
    B.CQN = (float*)take((size_t)S * 256 * 4); B.CKVN = (float*)take((size_t)S * 128 * 4);
    B.QM = (float*)take((size_t)S * 768 * 4); B.KVM = (float*)take((size_t)S * 1024 * 4);
    B.KMEAN = (float*)take((size_t)8 * 32 * 64 * 4);
    B.MO = (float*)take((size_t)S * 512 * 4); B.ML = (float*)take((size_t)S * 512 * 4);
    B.YA = (float*)take((size_t)S * DM * 4); B.YB = (float*)take((size_t)S * DM * 4);
    B.GU = B.PROJ;
    B.GATE = B.YA; B.PP = B.YB;
    return B;
}
constexpr size_t WS_BYTES = (size_t)400 << 20;

static inline void run_batch(hipStream_t st, const In& I, const Bufs& B, int b, float* out) {
    const size_t ro = (size_t)b * S;
    const float* xb = I.x + ro * DM; const float* pb = I.p + ro * 256; float* ob = out + ro * DM;
    hipLaunchKernelGGL(rmsnorm_k, dim3(S / 4), dim3(256), 0, st, xb, DM, I.attn_norm, B.H, DM, DM, S);
    gemm(st, B.H, DM, I.w_in, INC, B.PROJ, INC, nullptr, 0, S, INC, DM);
    hipLaunchKernelGGL(rope_k, dim3(nblk((long)S * 8 * 32, 256)), dim3(256), 0, st, B.PROJ, INC, 0, 8, 64, 64, B.tab64, S);
    hipLaunchKernelGGL(rope_k, dim3(nblk((long)S * 8 * 32, 256)), dim3(256), 0, st, B.PROJ, INC, 512, 8, 64, 64, B.tab64, S);
    hipLaunchKernelGGL(rope_k, dim3(nblk((long)S * 1 * 16, 256)), dim3(256), 0, st, B.PROJ, INC, 1920, 1, 32, 32, B.tab32, S);
    hipLaunchKernelGGL(rmsnorm_k, dim3(S / 4), dim3(256), 0, st, B.PROJ + 1536, INC, I.mla_q_norm, B.CQN, 256, 256, S);
    hipLaunchKernelGGL(rmsnorm_k, dim3(S / 4), dim3(256), 0, st, B.PROJ + 1792, INC, I.mla_kv_norm, B.CKVN, 128, 128, S);
    gemm(st, B.CQN, 256, I.w_q_b, 768, B.QM, 768, nullptr, 0, S, 768, 256);
    gemm(st, B.CKVN, 128, I.w_kv_b, 1024, B.KVM, 1024, nullptr, 0, S, 1024, 128);
    hipLaunchKernelGGL(rope_k, dim3(nblk((long)S * 8 * 16, 256)), dim3(256), 0, st, B.QM, 768, 64, 8, 32, 96, B.tab32, S);
    hipLaunchKernelGGL(kmean_k, dim3(32, 8), dim3(64), 0, st, B.PROJ + 512, INC, B.KMEAN);
    hipLaunchKernelGGL((attn_k<0, true>), dim3(32, 8), dim3(256), 0, st, B.PROJ, INC, 64, B.PROJ + 512, INC, 64, (const float*)nullptr, 0, B.PROJ + 1024, INC, 64, B.MO, 512, B.KMEAN, 0.125f);
    hipLaunchKernelGGL((attn_k<32, false>), dim3(32, 8), dim3(256), 0, st, B.QM, 768, 96, B.KVM, 1024, 128, B.PROJ + 1920, INC, B.KVM + 64, 1024, 128, B.ML, 512, (const float*)nullptr, 0.10206207261596577f);
    gemm(st, B.MO, 512, I.w_moba, DM, B.YA, DM, nullptr, 0, S, DM, 512);
    gemm(st, B.ML, 512, I.w_mla, DM, B.YB, DM, nullptr, 0, S, DM, 512);
    hipLaunchKernelGGL(mix_k, dim3(nblk((long)S * DM, 256)), dim3(256), 0, st, B.YA, B.YB, B.PROJ, (long)S * DM);
    gemm(st, B.YA, DM, I.w_o, DM, ob, DM, xb, DM, S, DM, DM);
    hipLaunchKernelGGL(rmsnorm_k, dim3(S / 4), dim3(256), 0, st, ob, DM, I.ffn_norm, B.H, DM, DM, S);
    gemm(st, B.H, DM, I.w_gu, 2 * DFF, B.GU, 2 * DFF, nullptr, 0, S, 2 * DFF, DM);
    hipLaunchKernelGGL(swiglu_k, dim3(nblk((long)S * DFF, 256)), dim3(256), 0, st, B.GU, (long)S * DFF);
    gemm(st, B.GU, 2 * DFF, I.w_down, DM, ob, DM, ob, DM, S, DM, DFF);
    hipLaunchKernelGGL(rmsnorm_k, dim3(S / 4), dim3(256), 0, st, ob, DM, I.ple_norm, B.H, DM, DM, S);
    gemm(st, B.H, DM, I.w_pg, DM, B.GATE, DM, nullptr, 0, S, DM, DM);
    gemm(st, pb, 256, I.w_pp, DM, B.PP, DM, nullptr, 0, S, DM, 256);
    hipLaunchKernelGGL(ple_k, dim3(nblk((long)S * DM, 256)), dim3(256), 0, st, ob, B.GATE, B.PP, (long)S * DM);
    hipLaunchKernelGGL(rmsnorm_k, dim3(S / 4), dim3(256), 0, st, ob, DM, I.final_norm, ob, DM, DM, S);
}
static inline void run_all(hipStream_t st, const In& I, unsigned char* ws, float* out, int nbatch) {
    const Bufs B = carve(ws);
    hipLaunchKernelGGL(rope_tab_k, dim3(nblk((long)S * 48, 256)), dim3(256), 0, st, B.tab64, B.tab32);
    for (int b = 0; b < nbatch; ++b) run_batch(st, I, B, b, out);
}
}
namespace pg8 {
#define PG8_LAS __attribute__((address_space(3)))
typedef unsigned short bf16_t;
typedef short bf16x8 __attribute__((ext_vector_type(8)));
typedef float f32x4 __attribute__((ext_vector_type(4)));
typedef unsigned u32x4 __attribute__((ext_vector_type(4)));
constexpr int BM = 256, BK = 64, HALF = 128, HTB = HALF * BK * 2  , STAGE_BYTES = 8 * HTB, NXCD = 8, WGM = 8;

__host__ __device__ __forceinline__ int lds_byte(int r, int c) { const int st = (r >> 4) * 2 + (c >> 5), rr = r & 15, cc = c & 31, ob = rr * 64 + cc * 2; return st * 1024 + (ob ^ (((ob >> 9) & 1) << 5)); }
__host__ __device__ __forceinline__ void stage_rc(int b, int& R, int& C) { const int st = b / 1024, sb = b % 1024, swz = sb ^ (((sb >> 9) & 1) << 5); R = (st >> 1) * 16 + swz / 64; C = (st & 1) * 32 + (swz % 64) / 2; }
__host__ __device__ __forceinline__ int perm32(int rho) { const int n = rho >> 4, i = rho & 15; return 8 * (i >> 2) + 4 * n + (i & 3); }

struct Unit { int pm, pn; };
struct Gemm { const bf16_t* A; const bf16_t* Bt; int M, N, K, lda; };

struct StaticOrder {
    int nM, nN, nwg, G, c;
    __host__ __device__ void init(int M, int N, int G_, int c_) { nM = M / BM; nN = N / BM; nwg = nM * nN; G = G_; c = c_; }
    __host__ __device__ bool next(int i, Unit& u) const {
        const long L = (long)i * G + c; if (L >= nwg) return false;
        int wgid = (int)L; { const int q = nwg / NXCD, r = nwg % NXCD, xcd = wgid % NXCD, off = wgid / NXCD; wgid = (xcd < r ? xcd * (q + 1) : r * (q + 1) + (xcd - r) * q) + off; }
        const int nig = WGM * nN, gid = wgid / nig, fm = gid * WGM, gsz = (nM - fm) < WGM ? (nM - fm) : WGM;
        u.pm = fm + ((wgid % nig) % gsz); u.pn = (wgid % nig) / gsz; return true;
    }
    __device__ __forceinline__ void a_ready(const Unit&) const {}
    __device__ __forceinline__ void done(const Unit&) const {}
};


typedef float f32x2 __attribute__((ext_vector_type(2)));
template <class Epi, class Sched, bool ALIGN_EPI = false, bool SP2 = false>
__device__ __forceinline__ void gemm_phase(PG8_LAS unsigned char* lds, const Gemm g, const Sched& S, const Epi& E) {
    const int tid = threadIdx.x, wid = __builtin_amdgcn_readfirstlane(tid >> 6), lane = tid & 63, wr = wid >> 2, wc = wid & 3, fr = lane & 15, fq = lane >> 4;
    int K_ = g.K; asm volatile("" : "+s"(K_));
    const int K = K_, nt = K / BK;
    unsigned voffA[2], voffB[2];
#pragma unroll
    for (int i = 0; i < 2; ++i) { int R, C; stage_rc(tid * 16 + i * 8192, R, C); const int Rb = Epi::PERM ? ((R & ~31) + perm32(R & 31)) : R;
        voffA[i] = (unsigned)(R * g.lda + C) * 2u; voffB[i] = (unsigned)(Rb * K + C) * 2u; }
    const size_t kstep = (size_t)(BK * 2);
    const size_t hstep = (size_t)HALF * K * 2, hstepA = (size_t)HALF * g.lda * 2;
    const size_t tstep = 2 * hstep, tstepA = 2 * hstepA;
    const unsigned ldsw = (unsigned)wid * 1024u;
    const int aoff = lds_byte(wr * 64 + fr, fq * 8), boff = lds_byte(wc * 32 + fr, fq * 8);
#define PG8_SA(b, h) (((b) * 2 + (h)) * HTB)
#define PG8_SB(b, h) ((4 + (b) * 2 + (h)) * HTB)
#define PG8_STAGE(bufoff, gbase, voff) do { _Pragma("unroll") for (int _i = 0; _i < 2; ++_i) \
        __builtin_amdgcn_global_load_lds((const unsigned*)((const char*)(gbase) + (voff)[_i]), (PG8_LAS unsigned*)(lds + (bufoff) + ldsw + _i * 8192), 16, 0, 0); } while (0)
#define PG8_LDA(dst, b, h) do { _Pragma("unroll") for (int m = 0; m < 4; ++m) _Pragma("unroll") for (int k = 0; k < 2; ++k) dst[m][k] = *(const PG8_LAS bf16x8*)(lds + PG8_SA(b, h) + aoff + m * 2048 + k * 1024); } while (0)
#define PG8_LDB(dst, b, h) do { _Pragma("unroll") for (int n = 0; n < 2; ++n) _Pragma("unroll") for (int k = 0; k < 2; ++k) dst[n][k] = *(const PG8_LAS bf16x8*)(lds + PG8_SB(b, h) + boff + n * 2048 + k * 1024); } while (0)
#define PG8_MMA(ai, bj, At, Bt) do { __builtin_amdgcn_s_setprio(1); _Pragma("unroll") for (int m = 0; m < 4; ++m) _Pragma("unroll") for (int n = 0; n < 2; ++n) _Pragma("unroll") for (int k = 0; k < 2; ++k) \
        acc[ai][bj][m][n] = __builtin_amdgcn_mfma_f32_16x16x32_bf16(Bt[n][k], At[m][k], acc[ai][bj][m][n], 0, 0, 0); __builtin_amdgcn_s_setprio(0); } while (0)
#define PG8_WAIT_V(n) asm volatile("s_waitcnt vmcnt(" #n ")" ::: "memory")
#define PG8_WAIT_L(n) asm volatile("s_waitcnt lgkmcnt(" #n ")" ::: "memory")
#define PG8_BAR __builtin_amdgcn_s_barrier()
#define PG8_SCHED __builtin_amdgcn_sched_barrier(0)
    Unit cur, nxt; int ui = 0;
    if (!S.next(0, cur)) return;
    f32x4 acc[2][2][4][2];
#pragma unroll
    for (int a = 0; a < 2; ++a)
#pragma unroll
        for (int b = 0; b < 2; ++b)
#pragma unroll
            for (int m = 0; m < 4; ++m)
#pragma unroll
                for (int n = 0; n < 2; ++n) acc[a][b][m][n] = (f32x4){0.f, 0.f, 0.f, 0.f};
    bf16x8 At[4][2], B0[2][2], B1[2][2];
    const char* cA = (const char*)g.A + (size_t)cur.pm * tstepA; const char* cB = (const char*)g.Bt + (size_t)cur.pn * tstep;
    S.a_ready(cur);
    if constexpr (SP2) {
        PG8_STAGE(PG8_SB(0, 0), cB, voffB); PG8_STAGE(PG8_SB(0, 1), cB + hstep, voffB); PG8_STAGE(PG8_SA(0, 0), cA, voffA); PG8_STAGE(PG8_SA(0, 1), cA + hstepA, voffA);
        if (wr == 1) PG8_BAR;
        PG8_WAIT_V(2); PG8_BAR;
        PG8_STAGE(PG8_SB(1, 0), cB + kstep, voffB); PG8_STAGE(PG8_SA(1, 0), cA + kstep, voffA); PG8_STAGE(PG8_SB(1, 1), cB + hstep + kstep, voffB);
        PG8_WAIT_V(6); PG8_BAR;
    } else {
        PG8_STAGE(PG8_SB(0, 0), cB, voffB); PG8_STAGE(PG8_SA(0, 0), cA, voffA); PG8_STAGE(PG8_SB(0, 1), cB + hstep, voffB); PG8_STAGE(PG8_SA(0, 1), cA + hstepA, voffA);
        if (wr == 1) PG8_BAR;
        PG8_WAIT_V(4); PG8_BAR;
        PG8_STAGE(PG8_SB(1, 0), cB + kstep, voffB); PG8_STAGE(PG8_SA(1, 0), cA + kstep, voffA); PG8_STAGE(PG8_SB(1, 1), cB + hstep + kstep, voffB);
        PG8_WAIT_V(6); PG8_BAR;
    }
    for (;;) {
        const bool has_next = S.next(ui + 1, nxt);
        const char* nA = has_next ? (const char*)g.A + (size_t)nxt.pm * tstepA : cA; const char* nB = has_next ? (const char*)g.Bt + (size_t)nxt.pn * tstep : cB;
        for (int t = 0; t < nt; t += 2) {
            const bool last = (t == nt - 2);
            const char* a1 = cA + (size_t)(t + 1) * kstep;
            const char* a2 = last ? nA : cA + (size_t)(t + 2) * kstep; const char* b2 = last ? nB : cB + (size_t)(t + 2) * kstep;
            const char* a3 = a2 + kstep; const char* b3 = b2 + kstep;
            if (last && has_next) S.a_ready(nxt);
            if constexpr (SP2) {
            PG8_LDB(B0, 0, 0); PG8_LDB(B1, 0, 1); PG8_SCHED; PG8_LDA(At, 0, 0); PG8_STAGE(PG8_SA(1, 1), a1 + hstepA, voffA);
            PG8_WAIT_V(8); PG8_WAIT_L(0); PG8_BAR; PG8_MMA(0, 0, At, B0); PG8_MMA(0, 1, At, B1); PG8_BAR; PG8_SCHED;
            PG8_LDA(At, 0, 1); PG8_STAGE(PG8_SB(0, 0), b2, voffB); PG8_STAGE(PG8_SB(0, 1), b2 + hstep, voffB); PG8_STAGE(PG8_SA(0, 0), a2, voffA);
            PG8_WAIT_V(8); PG8_WAIT_L(0); PG8_BAR; PG8_MMA(1, 0, At, B0); PG8_MMA(1, 1, At, B1); PG8_BAR; PG8_SCHED;
            PG8_LDB(B0, 1, 0); PG8_LDB(B1, 1, 1); PG8_SCHED; PG8_LDA(At, 1, 0); PG8_STAGE(PG8_SA(0, 1), a2 + hstepA, voffA);
            PG8_WAIT_V(8); PG8_WAIT_L(0); PG8_BAR; PG8_MMA(0, 0, At, B0); PG8_MMA(0, 1, At, B1); PG8_BAR; PG8_SCHED;
            PG8_LDA(At, 1, 1); PG8_STAGE(PG8_SB(1, 0), b3, voffB); PG8_STAGE(PG8_SB(1, 1), b3 + hstep, voffB); PG8_STAGE(PG8_SA(1, 0), a3, voffA);
            PG8_WAIT_V(8); PG8_WAIT_L(0); PG8_BAR; PG8_MMA(1, 0, At, B0); PG8_MMA(1, 1, At, B1); PG8_BAR; PG8_SCHED;
            } else {
            PG8_LDB(B0, 0, 0); PG8_SCHED; PG8_LDA(At, 0, 0); PG8_STAGE(PG8_SA(1, 1), a1 + hstepA, voffA);
            PG8_WAIT_L(8); PG8_BAR; PG8_WAIT_L(0); PG8_MMA(0, 0, At, B0); PG8_BAR; PG8_SCHED;
            PG8_LDB(B1, 0, 1); PG8_STAGE(PG8_SB(0, 0), b2, voffB);
            PG8_BAR; PG8_WAIT_L(0); PG8_MMA(0, 1, At, B1); PG8_BAR;
            PG8_LDA(At, 0, 1); PG8_STAGE(PG8_SA(0, 0), a2, voffA);
            PG8_BAR; PG8_WAIT_L(0); PG8_MMA(1, 0, At, B0); PG8_BAR; PG8_SCHED;
            PG8_STAGE(PG8_SB(0, 1), b2 + hstep, voffB);
            PG8_WAIT_V(6); PG8_BAR; PG8_MMA(1, 1, At, B1); PG8_BAR;
            PG8_LDB(B0, 1, 0); PG8_SCHED; PG8_LDA(At, 1, 0); PG8_STAGE(PG8_SA(0, 1), a2 + hstepA, voffA);
            PG8_WAIT_L(8); PG8_BAR; PG8_WAIT_L(0); PG8_MMA(0, 0, At, B0); PG8_BAR; PG8_SCHED;
            PG8_LDB(B1, 1, 1); PG8_STAGE(PG8_SB(1, 0), b3, voffB);
            PG8_BAR; PG8_WAIT_L(0); PG8_MMA(0, 1, At, B1); PG8_BAR;
            PG8_LDA(At, 1, 1); PG8_STAGE(PG8_SA(1, 0), a3, voffA);
            PG8_BAR; PG8_WAIT_L(0); PG8_MMA(1, 0, At, B0); PG8_BAR; PG8_SCHED;
            PG8_STAGE(PG8_SB(1, 1), b3 + hstep, voffB);
            PG8_WAIT_V(6); PG8_BAR; PG8_MMA(1, 1, At, B1); PG8_BAR;
            }
        }
        if constexpr (ALIGN_EPI) { if (wr == 0) PG8_BAR; }
        if constexpr (!Epi::AFTER_DRAIN) { E(acc, cur, wr, wc, fr, fq); S.done(cur); }
        if (!has_next) break;
#pragma unroll
        for (int a = 0; a < 2; ++a)
#pragma unroll
            for (int b = 0; b < 2; ++b)
#pragma unroll
                for (int m = 0; m < 4; ++m)
#pragma unroll
                    for (int n = 0; n < 2; ++n) acc[a][b][m][n] = (f32x4){0.f, 0.f, 0.f, 0.f};
        cur = nxt; cA = nA; cB = nB; ++ui;
        if constexpr (ALIGN_EPI) { if (wr == 1) PG8_BAR; }
    }
    PG8_WAIT_V(0);
    if constexpr (!ALIGN_EPI) { if (wr == 0) PG8_BAR; }
    PG8_BAR;
    if constexpr (Epi::AFTER_DRAIN) { E.fused(acc, cur, wr, wc, fr, fq, lds, wid, lane); S.done(cur); }
#undef PG8_SA
#undef PG8_SB
#undef PG8_STAGE
#undef PG8_LDA
#undef PG8_LDB
#undef PG8_MMA
#undef PG8_WAIT_V
#undef PG8_WAIT_L
#undef PG8_BAR
#undef PG8_SCHED
}
}
#ifndef MK_NB
#define MK_NB 4
#endif
namespace mk {
using pg8::bf16_t; using pg8::f32x4; using pg8::u32x4; using pg8::bf16x8;
typedef unsigned u32x2 __attribute__((ext_vector_type(2)));
typedef float f32x16 __attribute__((ext_vector_type(16)));
typedef short s16x4 __attribute__((ext_vector_type(4)));
constexpr int NB = MK_NB, S = 8192, T = NB * S, D = 1024, DFF = 2816, NWAVES = 8;
constexpr float EPS = 1e-6f;
constexpr float LOG2E = 1.4426950408889634f;
constexpr float C2A = 0.125f * LOG2E;
constexpr float C2B = 0.10206207261596577f * LOG2E;

constexpr size_t MiB = (size_t)1 << 20;
constexpr size_t WS_CTL = 0, CTL_ZERO_BYTES = 1 * MiB;
constexpr size_t WS_ROPE64 = 1 * MiB, WS_ROPE32 = 3 * MiB;
constexpr size_t WS_RSTD0 = 4 * MiB;
constexpr size_t WS_SSQ_CQ = WS_RSTD0 + 256 * 1024;
constexpr size_t WS_SSQ_KV = WS_SSQ_CQ + 512 * 1024;
constexpr size_t WS_KMP = WS_SSQ_KV + 512 * 1024;
constexpr size_t WS_SSQ_X = 6 * MiB;
constexpr size_t WS_SSQ_Y = 8 * MiB;
constexpr size_t WS_W = 10 * MiB;
constexpr size_t WS_WIN = WS_W, WS_WGU = WS_WIN + (size_t)4096 * 1024 * 2, WS_WD = WS_WGU + (size_t)5632 * 1024 * 2, WS_WO = WS_WD + (size_t)1024 * 2816 * 2,
                 WS_WPG = WS_WO + 2 * MiB, WS_WMB = WS_WPG + 2 * MiB, WS_WML = WS_WMB + 1 * MiB, WS_WQB = WS_WML + 1 * MiB, WS_WKVB = WS_WQB + (size_t)768 * 256 * 2,
                 WS_WPP = WS_WKVB + (size_t)1024 * 256 * 2, WS_WEND = WS_WPP + (size_t)1024 * 256 * 2;
constexpr size_t WS_ACT0 = 44 * MiB;
static_assert(WS_WEND <= WS_ACT0, "weights fit");
constexpr size_t TB = (size_t)T;
constexpr size_t WS_XB = WS_ACT0;
constexpr size_t WS_PB = WS_XB + TB * 1024 * 2;
constexpr size_t WS_QA = WS_PB + TB * 256 * 2;
constexpr size_t WS_KA = WS_QA + TB * 512 * 2;
constexpr size_t WS_VA = WS_KA + TB * 512 * 2;
constexpr size_t WS_LAT = WS_VA + TB * 512 * 2;
constexpr size_t WS_KR = WS_LAT + TB * 512 * 2;
constexpr size_t WS_GA = WS_KR + TB * 64;
constexpr size_t WS_GB = WS_GA + TB * 1024 * 2;
constexpr size_t WS_QM = WS_GB + TB * 1024 * 2;
constexpr size_t WS_KM = WS_QM + TB * 768 * 2;
constexpr size_t WS_VM = WS_KM + TB * 768 * 2;
constexpr size_t WS_MEGA_END = WS_VM + TB * 512 * 2;
constexpr size_t WS_MO = WS_QA, WS_ML = WS_LAT;
constexpr size_t WS_MIX = WS_KA;
constexpr size_t WS_TMP4 = WS_QM;
constexpr size_t WS_ACT = WS_QA;
constexpr size_t WS_TMP8 = WS_QA;
static_assert(WS_TMP4 + TB * 1024 * 4 <= WS_MEGA_END, "TMP4 overlay");
static_assert(WS_ACT + TB * 2816 * 2 <= WS_MEGA_END, "ACT overlay");
static_assert(NB != 4 || WS_MEGA_END <= 512 * MiB, "workspace map fits 512 MiB");
constexpr int CW_BAR = 4096;

constexpr int LDS_BYTES = 163840;
constexpr int RING_BYTES = 131072, MISC_OFF = 163840 - 512;

#define GAS __attribute__((address_space(1)))
#define LAS __attribute__((address_space(3)))
typedef GAS unsigned gu32;
#define LDS_WAIT() asm volatile("s_waitcnt lgkmcnt(0)" ::: "memory")
#define VM_WAIT() asm volatile("s_waitcnt vmcnt(0)" ::: "memory")
__device__ __forceinline__ unsigned f2bf(float f) { unsigned u = __builtin_bit_cast(unsigned, f); return (u + 0x7fffu + ((u >> 16) & 1u)) >> 16; }
__device__ __forceinline__ unsigned pk2(float lo, float hi) { return f2bf(lo) | (f2bf(hi) << 16); }
__device__ __forceinline__ float bf2f(unsigned short b) { return __builtin_bit_cast(float, (unsigned)b << 16); }
__device__ __forceinline__ float bflo(unsigned w) { return __builtin_bit_cast(float, w << 16); }
__device__ __forceinline__ float bfhi(unsigned w) { return __builtin_bit_cast(float, w & 0xffff0000u); }
__device__ __forceinline__ float sigm(float v) { return __builtin_amdgcn_rcpf(1.0f + __builtin_amdgcn_exp2f(-LOG2E * v)); }
__device__ __forceinline__ u32x4 pack8(const f32x4& a, const f32x4& b) { u32x4 w; w.x = pk2(a[0], a[1]); w.y = pk2(a[2], a[3]); w.z = pk2(b[0], b[1]); w.w = pk2(b[2], b[3]); return w; }
__device__ __forceinline__ u32x2 pack4(const f32x4& a) { u32x2 w; w.x = pk2(a[0], a[1]); w.y = pk2(a[2], a[3]); return w; }

#define XB_TMO      128
#define XB_XCNT(j)  (256  + 64 * (j))
#define XB_XSUB(j)  (1280 + 64 * (j))
#define XB_XGEN(j)  (2304 + 64 * (j))
#define XB_TOP      3328
#define XB_TOPGEN   3392
#define XCD_BAR_WORDS 3456
#define XB_SPIN_CAP (1u << 18)
__device__ __forceinline__ unsigned xb_ld(unsigned* p)              { return __hip_atomic_load(p, __ATOMIC_RELAXED, __HIP_MEMORY_SCOPE_AGENT); }
__device__ __forceinline__ unsigned xb_add(unsigned* p, unsigned v) { return __hip_atomic_fetch_add(p, v, __ATOMIC_RELAXED, __HIP_MEMORY_SCOPE_AGENT); }
__device__ __forceinline__ unsigned xb_xcc_id() { return (unsigned)__builtin_amdgcn_s_getreg((3 << 11) | 20) & 0xFu; }
#define XB_SPIN(cond, bar) do { unsigned _sp = 0; while (cond) { __builtin_amdgcn_s_sleep(1); \
    if ((++_sp & 255u) == 0u) { if (xb_ld(&(bar)[XB_TMO])) break; if (_sp > XB_SPIN_CAP) { atomicAdd(&(bar)[XB_TMO], 1u); break; } } } } while (0)
struct XcdBarrier { unsigned* bar; unsigned x; volatile LAS unsigned* st; };
__device__ __forceinline__ XcdBarrier xcd_barrier_post(unsigned* bar, volatile LAS unsigned* st) {
    XcdBarrier b; b.bar = bar; b.x = xb_xcc_id(); b.st = st;
    if (threadIdx.x == 0) (void)xb_add(&bar[XB_XCNT(b.x)], 1u);
    return b;
}
__device__ __forceinline__ void xcd_barrier_complete(unsigned* bar, unsigned x, unsigned& nloc, unsigned& nx) {
    const unsigned G = gridDim.x * gridDim.y * gridDim.z;
    unsigned sum, cnt, mine, sp = 0u;
    for (;;) {
        sum = 0u; cnt = 0u; mine = 0u;
#pragma unroll
        for (unsigned j = 0; j < 16; ++j) { const unsigned c = xb_ld(&bar[XB_XCNT(j)]); sum += c; cnt += (c > 0u) ? 1u : 0u; mine = (j == x) ? c : mine; }
        if (sum == G) break;
        __builtin_amdgcn_s_sleep(1);
        if ((++sp & 255u) == 0u) { if (xb_ld(&bar[XB_TMO])) break; if (sp > XB_SPIN_CAP) { atomicAdd(&bar[XB_TMO], 1u); break; } }
    }
    nloc = mine > 0u ? mine : 1u; nx = cnt > 0u ? cnt : 1u;
}
__device__ __forceinline__ void xcd_barrier(const XcdBarrier& b) {
    asm volatile("s_waitcnt vmcnt(0)" ::: "memory");
    __syncthreads();
    if (threadIdx.x == 0) {
        unsigned* bar = b.bar;
        __builtin_amdgcn_s_waitcnt(0);
        unsigned nloc = b.st[0], nx = b.st[1];
        if (nloc == 0u) { xcd_barrier_complete(bar, b.x, nloc, nx); b.st[0] = nloc; b.st[1] = nx; }
        const unsigned old = xb_add(&bar[XB_XSUB(b.x)], 1u);
        const unsigned gen = old / nloc;
        if (old + 1u == (gen + 1u) * nloc) {
            __builtin_amdgcn_fence(__ATOMIC_RELEASE, "agent");
            asm volatile("s_waitcnt vmcnt(0)" ::: "memory");
            const unsigned og = xb_add(&bar[XB_TOP], 1u);
            const unsigned tg = og / nx;
            if (og + 1u == (tg + 1u) * nx) xb_add(&bar[XB_TOPGEN], 1u);
            else XB_SPIN(xb_ld(&bar[XB_TOPGEN]) == tg, bar);
            __builtin_amdgcn_fence(__ATOMIC_ACQUIRE, "agent");
            xb_add(&bar[XB_XGEN(b.x)], 1u);
            asm volatile("s_waitcnt vmcnt(0)" ::: "memory");
        } else {
            XB_SPIN(xb_ld(&bar[XB_XGEN(b.x)]) == gen, bar);
            __builtin_amdgcn_fence(__ATOMIC_ACQUIRE, "agent");
            asm volatile("s_waitcnt vmcnt(0)" ::: "memory");
        }
    }
    __syncthreads();
}
}
namespace mk {
using pg8::Unit;
#define EPI_ROW(u, ai, m) ((u).pm * 256 + (ai) * 128 + wr * 64 + (m) * 16 + fr)
#define EPI_FOR_ROWS _Pragma("unroll") for (int ai = 0; ai < 2; ++ai) _Pragma("unroll") for (int m = 0; m < 4; ++m) if (epi_fence())
__device__ __forceinline__ bool epi_fence() { asm volatile("" ::: "memory"); return true; }

__device__ __forceinline__ float rstd_from16(const float* p) {
    const f32x4 a = *(const f32x4*)p, b = *(const f32x4*)(p + 4), c = *(const f32x4*)(p + 8), d = *(const f32x4*)(p + 12);
    const float s = (((a[0] + a[1]) + (a[2] + a[3])) + ((b[0] + b[1]) + (b[2] + b[3]))) + (((c[0] + c[1]) + (c[2] + c[3])) + ((d[0] + d[1]) + (d[2] + d[3])));
    return 1.0f / sqrtf(s * (1.0f / 1024.0f) + EPS);
}
__device__ __forceinline__ float rstd_from4(const float* p, float invn) {
    const f32x4 a = *(const f32x4*)p; return 1.0f / sqrtf(((a[0] + a[1]) + (a[2] + a[3])) * invn + EPS);
}
__device__ __forceinline__ float sumsq8(const f32x4& a, const f32x4& b) { return ((a[0] * a[0] + a[1] * a[1]) + (a[2] * a[2] + a[3] * a[3])) + ((b[0] * b[0] + b[1] * b[1]) + (b[2] * b[2] + b[3] * b[3])); }

struct EpiInProj {
    static constexpr bool PERM = true, AFTER_DRAIN = false;
    const float* rstd0; const float2* rope64; const float2* rope32;
    bf16_t *QA, *KA, *VA, *LAT, *KR, *GA, *GB; float *ssq_cq, *ssq_kv, *kmp;
    __device__ __forceinline__ void operator()(const f32x4 (&acc)[2][2][4][2], const Unit& u, int wr, int wc, int fr, int fq) const {
        const int pn = u.pn;
        if (pn < 4) {
            const bool isk = pn >= 2; bf16_t* dst = isk ? KA : QA; const float sc = isk ? 1.0f : C2A;
            const int e = (wc & 1) * 16 + fq * 4;
            float cs1[2][4], cs2[2][4];
#pragma unroll
            for (int bj = 0; bj < 2; ++bj)
#pragma unroll
                for (int i = 0; i < 4; ++i) { cs1[bj][i] = 0.f; cs2[bj][i] = 0.f; }
            EPI_FOR_ROWS {
                const int row = EPI_ROW(u, ai, m); const float rs = rstd0[row]; const int t = row & (S - 1);
                const f32x4 ca = *(const f32x4*)(rope64 + t * 32 + e), cb = *(const f32x4*)(rope64 + t * 32 + e + 2);
                const float c[4] = {ca[0], ca[2], cb[0], cb[2]}, s[4] = {ca[1], ca[3], cb[1], cb[3]};
#pragma unroll
                for (int bj = 0; bj < 2; ++bj) {
                    const int head = 4 * (pn & 1) + 2 * bj + (wc >> 1);
                    f32x4 y1, y2;
#pragma unroll
                    for (int i = 0; i < 4; ++i) { const float x1 = acc[ai][bj][m][0][i] * rs, x2 = acc[ai][bj][m][1][i] * rs; y1[i] = x1 * c[i] - x2 * s[i]; y2[i] = x2 * c[i] + x1 * s[i]; }
                    if (isk) {
#pragma unroll
                        for (int i = 0; i < 4; ++i) { cs1[bj][i] += y1[i]; cs2[bj][i] += y2[i]; } }
                    bf16_t* p = dst + (size_t)row * 512 + head * 64 + e;
                    *(u32x2*)p = pack4(y1 * sc); *(u32x2*)(p + 32) = pack4(y2 * sc);
                }
            }
            if (isk) {
#pragma unroll
                for (int bj = 0; bj < 2; ++bj)
#pragma unroll
                    for (int i = 0; i < 4; ++i) {
                        float a = cs1[bj][i], b = cs2[bj][i];
#pragma unroll
                        for (int o = 1; o < 16; o <<= 1) { a += __shfl_xor(a, o); b += __shfl_xor(b, o); }
                        cs1[bj][i] = a; cs2[bj][i] = b;
                    }
                if (fr == 0) {
#pragma unroll
                    for (int bj = 0; bj < 2; ++bj) { const int head = 4 * (pn & 1) + 2 * bj + (wc >> 1); float* p = kmp + (size_t)(u.pm * 2 + wr) * 512 + head * 64 + e;
                        *(f32x4*)p = (f32x4){cs1[bj][0], cs1[bj][1], cs1[bj][2], cs1[bj][3]}; *(f32x4*)(p + 32) = (f32x4){cs2[bj][0], cs2[bj][1], cs2[bj][2], cs2[bj][3]}; }
                }
            }
        } else if (pn < 6) {
            EPI_FOR_ROWS { const int row = EPI_ROW(u, ai, m); const float rs = rstd0[row];
#pragma unroll
                for (int bj = 0; bj < 2; ++bj) *(u32x4*)(VA + (size_t)row * 512 + (pn - 4) * 256 + bj * 128 + wc * 32 + 8 * fq) = pack8(acc[ai][bj][m][0] * rs, acc[ai][bj][m][1] * rs); }
        } else if (pn < 8) {
            float* ssq = (pn == 6) ? ssq_cq : ssq_kv;
            EPI_FOR_ROWS { const int row = EPI_ROW(u, ai, m); const float rs = rstd0[row];
                const f32x4 a0 = acc[ai][0][m][0] * rs, a1 = acc[ai][0][m][1] * rs, b0 = acc[ai][1][m][0] * rs, b1 = acc[ai][1][m][1] * rs;
                bf16_t* p = LAT + (size_t)row * 512 + (pn - 6) * 256 + wc * 32 + 8 * fq;
                *(u32x4*)p = pack8(a0, a1); *(u32x4*)(p + 128) = pack8(b0, b1);
                float q = sumsq8(a0, a1); if (pn == 6) q += sumsq8(b0, b1);
                q += __shfl_xor(q, 16); q += __shfl_xor(q, 32);
                if (fq == 0) ssq[(size_t)row * 4 + wc] = q;
                if (pn == 7 && wc == 0) {
                    const int t = row & (S - 1);
                    const f32x4 ca = *(const f32x4*)(rope32 + t * 16 + 4 * fq), cb = *(const f32x4*)(rope32 + t * 16 + 4 * fq + 2);
                    const float c[4] = {ca[0], ca[2], cb[0], cb[2]}, s[4] = {ca[1], ca[3], cb[1], cb[3]};
                    f32x4 y1, y2;
#pragma unroll
                    for (int i = 0; i < 4; ++i) { y1[i] = b0[i] * c[i] - b1[i] * s[i]; y2[i] = b1[i] * c[i] + b0[i] * s[i]; }
                    bf16_t* k = KR + (size_t)row * 32 + 4 * fq; *(u32x2*)k = pack4(y1); *(u32x2*)(k + 16) = pack4(y2);
                }
            }
        } else {
            bf16_t* dst = (pn < 12) ? GA : GB; const int c0 = ((pn - 8) & 3) * 256 + wc * 32 + 8 * fq;
            EPI_FOR_ROWS { const int row = EPI_ROW(u, ai, m); const float rs = rstd0[row];
#pragma unroll
                for (int bj = 0; bj < 2; ++bj) { f32x4 a = acc[ai][bj][m][0] * rs, b = acc[ai][bj][m][1] * rs;
#pragma unroll
                    for (int i = 0; i < 4; ++i) { a[i] = sigm(a[i]); b[i] = sigm(b[i]); }
                    *(u32x4*)(dst + (size_t)row * 1024 + c0 + bj * 128) = pack8(a, b); } }
        }
    }
};

struct EpiQb {
    static constexpr bool PERM = true, AFTER_DRAIN = false;
    const float* ssq_cq; const float2* rope32; bf16_t* QM;
    __device__ __forceinline__ void operator()(const f32x4 (&acc)[2][2][4][2], const Unit& u, int wr, int wc, int fr, int fq) const {
        EPI_FOR_ROWS { const int row = EPI_ROW(u, ai, m); const float rs = rstd_from4(ssq_cq + (size_t)row * 4, 1.0f / 256.0f) * C2B; const int t = row & (S - 1);
#pragma unroll
            for (int bj = 0; bj < 2; ++bj) {
                const int G = u.pn * 8 + bj * 4 + wc, head = G / 3, part = G - head * 3;
                const f32x4 a = acc[ai][bj][m][0] * rs, b = acc[ai][bj][m][1] * rs;
                if (part < 2) *(u32x4*)(QM + (size_t)row * 768 + head * 96 + part * 32 + 8 * fq) = pack8(a, b);
                else {
                    const f32x4 ca = *(const f32x4*)(rope32 + t * 16 + 4 * fq), cb = *(const f32x4*)(rope32 + t * 16 + 4 * fq + 2);
                    const float c[4] = {ca[0], ca[2], cb[0], cb[2]}, s[4] = {ca[1], ca[3], cb[1], cb[3]};
                    f32x4 y1, y2;
#pragma unroll
                    for (int i = 0; i < 4; ++i) { y1[i] = a[i] * c[i] - b[i] * s[i]; y2[i] = b[i] * c[i] + a[i] * s[i]; }
                    bf16_t* p = QM + (size_t)row * 768 + head * 96 + 64 + 4 * fq; *(u32x2*)p = pack4(y1); *(u32x2*)(p + 16) = pack4(y2);
                }
            } }
    }
};
struct EpiKvb {
    static constexpr bool PERM = true, AFTER_DRAIN = false;
    const float* ssq_kv; const bf16_t* KR; bf16_t *KM, *VM;
    __device__ __forceinline__ void operator()(const f32x4 (&acc)[2][2][4][2], const Unit& u, int wr, int wc, int fr, int fq) const {
        EPI_FOR_ROWS { const int row = EPI_ROW(u, ai, m); const float rs = rstd_from4(ssq_kv + (size_t)row * 4, 1.0f / 128.0f);
            u32x4 kr; if (wc == 0) kr = *(const u32x4*)(KR + (size_t)row * 32 + 8 * fq);
#pragma unroll
            for (int bj = 0; bj < 2; ++bj) {
                const int head = u.pn * 2 + bj; const u32x4 w = pack8(acc[ai][bj][m][0] * rs, acc[ai][bj][m][1] * rs);
                if (wc < 2) *(u32x4*)(KM + (size_t)row * 768 + head * 96 + wc * 32 + 8 * fq) = w;
                else *(u32x4*)(VM + (size_t)row * 512 + head * 64 + (wc - 2) * 32 + 8 * fq) = w;
                if (wc == 0) *(u32x4*)(KM + (size_t)row * 768 + head * 96 + 64 + 8 * fq) = kr;
            } }
    }
};
struct EpiBranchA {
    static constexpr bool PERM = true, AFTER_DRAIN = false;
    const bf16_t* GA; float* TMP;
    __device__ __forceinline__ void operator()(const f32x4 (&acc)[2][2][4][2], const Unit& u, int wr, int wc, int fr, int fq) const {
        EPI_FOR_ROWS { const int row = EPI_ROW(u, ai, m);
#pragma unroll
            for (int bj = 0; bj < 2; ++bj) { const size_t off = (size_t)row * 1024 + u.pn * 256 + bj * 128 + wc * 32 + 8 * fq; const u32x4 g = *(const u32x4*)(GA + off);
                const f32x4 g0 = {bflo(g.x), bfhi(g.x), bflo(g.y), bfhi(g.y)}, g1 = {bflo(g.z), bfhi(g.z), bflo(g.w), bfhi(g.w)};
                *(f32x4*)(TMP + off) = acc[ai][bj][m][0] * g0; *(f32x4*)(TMP + off + 4) = acc[ai][bj][m][1] * g1; } }
    }
};
struct EpiBranchB {
    static constexpr bool PERM = true, AFTER_DRAIN = false;
    const bf16_t* GB; const float* TMP; bf16_t* MIX;
    __device__ __forceinline__ void operator()(const f32x4 (&acc)[2][2][4][2], const Unit& u, int wr, int wc, int fr, int fq) const {
        EPI_FOR_ROWS { const int row = EPI_ROW(u, ai, m);
#pragma unroll
            for (int bj = 0; bj < 2; ++bj) { const size_t off = (size_t)row * 1024 + u.pn * 256 + bj * 128 + wc * 32 + 8 * fq; const u32x4 g = *(const u32x4*)(GB + off);
                const f32x4 g0 = {bflo(g.x), bfhi(g.x), bflo(g.y), bfhi(g.y)}, g1 = {bflo(g.z), bfhi(g.z), bflo(g.w), bfhi(g.w)};
                const f32x4 t0 = *(const f32x4*)(TMP + off), t1 = *(const f32x4*)(TMP + off + 4);
                *(u32x4*)(MIX + off) = pack8(t0 + acc[ai][bj][m][0] * g0, t1 + acc[ai][bj][m][1] * g1); } }
    }
};
struct EpiResid {
    static constexpr bool PERM = true, AFTER_DRAIN = false;
    const float* XI; float* XO; bf16_t* XBo; float* ssq;
    __device__ __forceinline__ void operator()(const f32x4 (&acc)[2][2][4][2], const Unit& u, int wr, int wc, int fr, int fq) const {
        EPI_FOR_ROWS { const int row = EPI_ROW(u, ai, m); float q = 0.f;
#pragma unroll
            for (int bj = 0; bj < 2; ++bj) { const size_t off = (size_t)row * 1024 + u.pn * 256 + bj * 128 + wc * 32 + 8 * fq;
                const f32x4 v0 = *(const f32x4*)(XI + off) + acc[ai][bj][m][0], v1 = *(const f32x4*)(XI + off + 4) + acc[ai][bj][m][1];
                *(f32x4*)(XO + off) = v0; *(f32x4*)(XO + off + 4) = v1; *(u32x4*)(XBo + off) = pack8(v0, v1); q += sumsq8(v0, v1); }
            q += __shfl_xor(q, 16); q += __shfl_xor(q, 32);
            if (fq == 0) ssq[(size_t)row * 16 + u.pn * 4 + wc] = q; }
    }
};
struct EpiGateUp {
    static constexpr bool PERM = true, AFTER_DRAIN = false;
    const float* ssq; bf16_t* ACT;
    __device__ __forceinline__ void operator()(const f32x4 (&acc)[2][2][4][2], const Unit& u, int wr, int wc, int fr, int fq) const {
        EPI_FOR_ROWS { const int row = EPI_ROW(u, ai, m); const float rs = rstd_from16(ssq + (size_t)row * 16);
            f32x4 o0, o1;
#pragma unroll
            for (int i = 0; i < 4; ++i) { const float g0 = acc[ai][0][m][0][i] * rs, g1 = acc[ai][0][m][1][i] * rs; o0[i] = g0 * sigm(g0) * (acc[ai][1][m][0][i] * rs); o1[i] = g1 * sigm(g1) * (acc[ai][1][m][1][i] * rs); }
            *(u32x4*)(ACT + (size_t)row * DFF + u.pn * 128 + wc * 32 + 8 * fq) = pack8(o0, o1); }
    }
};
struct EpiPleA {
    static constexpr bool PERM = true, AFTER_DRAIN = false;
    float* TMP;
    __device__ __forceinline__ void operator()(const f32x4 (&acc)[2][2][4][2], const Unit& u, int wr, int wc, int fr, int fq) const {
        EPI_FOR_ROWS { const int row = EPI_ROW(u, ai, m);
#pragma unroll
            for (int bj = 0; bj < 2; ++bj) { const size_t off = (size_t)row * 1024 + u.pn * 256 + bj * 128 + wc * 32 + 8 * fq; *(f32x4*)(TMP + off) = acc[ai][bj][m][0]; *(f32x4*)(TMP + off + 4) = acc[ai][bj][m][1]; } }
    }
};
struct EpiPleB {
    static constexpr bool PERM = true, AFTER_DRAIN = false;
    const float* ssq_in; const float* TMP; float* X; float* ssq_out;
    __device__ __forceinline__ void operator()(const f32x4 (&acc)[2][2][4][2], const Unit& u, int wr, int wc, int fr, int fq) const {
        EPI_FOR_ROWS { const int row = EPI_ROW(u, ai, m); const float rs = rstd_from16(ssq_in + (size_t)row * 16); float q = 0.f;
#pragma unroll
            for (int bj = 0; bj < 2; ++bj) { const size_t off = (size_t)row * 1024 + u.pn * 256 + bj * 128 + wc * 32 + 8 * fq;
                f32x4 v0 = *(const f32x4*)(X + off), v1 = *(const f32x4*)(X + off + 4); const f32x4 t0 = *(const f32x4*)(TMP + off), t1 = *(const f32x4*)(TMP + off + 4);
#pragma unroll
                for (int i = 0; i < 4; ++i) { v0[i] += sigm(acc[ai][bj][m][0][i] * rs) * t0[i]; v1[i] += sigm(acc[ai][bj][m][1][i] * rs) * t1[i]; }
                *(f32x4*)(X + off) = v0; *(f32x4*)(X + off + 4) = v1; q += sumsq8(v0, v1); }
            q += __shfl_xor(q, 16); q += __shfl_xor(q, 32);
            if (fq == 0) ssq_out[(size_t)row * 16 + u.pn * 4 + wc] = q; }
    }
};
}
namespace mk { namespace att {
constexpr int SLK = 12288, SLV = 8192, LDS_K = 0, LDS_V = 2 * SLK, LDS_WS = LDS_V + 2 * SLV, LDS_OST = LDS_WS + NWAVES * 256, ATT_LDS_BYTES = LDS_OST + NWAVES * 4096;
static_assert(ATT_LDS_BYTES <= RING_BYTES, "attention LDS");
#define SBAR() __builtin_amdgcn_sched_barrier(0)
#define MFMA32(a, b, c) __builtin_amdgcn_mfma_f32_32x32x16_bf16(a, b, c, 0, 0, 0)
#define MX3(a, b, c) __builtin_fmaxf(__builtin_fmaxf((a), (b)), (c))
__device__ __forceinline__ int crow(int r, int hi) { return (r & 3) + 8 * (r >> 2) + 4 * hi; }
__device__ __forceinline__ void glds16(const void* g, unsigned lds_base) {
    unsigned sv; asm volatile("s_mov_b32 %0, m0\n\ts_mov_b32 m0, %2\n\ts_nop 0\n\tglobal_load_lds_dwordx4 %1, off\n\ts_mov_b32 m0, %0" : "=&s"(sv) : "v"(g), "s"(lds_base) : "memory"); }
typedef float f32x2_t __attribute__((ext_vector_type(2))); typedef __bf16 bf16x2_t __attribute__((ext_vector_type(2)));
__device__ __forceinline__ unsigned cvtpk(float lo, float hi) { f32x2_t v = {lo, hi}; bf16x2_t b = __builtin_convertvector(v, bf16x2_t); return __builtin_bit_cast(unsigned, b); }
__device__ __forceinline__ float rowmax(const f32x16& p0, const f32x16& p1) {
    float a = MX3(p0[0], p0[1], p1[0]), b = MX3(p0[2], p0[3], p1[1]); a = MX3(a, p1[2], p1[3]);
#pragma unroll
    for (int r = 4; r < 16; r += 4) { a = MX3(a, p0[r], p0[r + 1]); b = MX3(b, p0[r + 2], p0[r + 3]); a = MX3(a, p1[r], p1[r + 1]); b = MX3(b, p1[r + 2], p1[r + 3]); }
    float m = __builtin_fmaxf(a, b); auto rr = __builtin_amdgcn_permlane32_swap(__float_as_uint(m), __float_as_uint(m), false, false);
    return __builtin_fmaxf(__uint_as_float(rr[0]), __uint_as_float(rr[1])); }
__device__ __forceinline__ void cmask(f32x16& p0, f32x16& p1, int jb, int qrel, int hi) {
    const int kb = 64 * jb + 4 * hi;
#pragma unroll
    for (int r = 0; r < 16; ++r) { const int kv = kb + (r & 3) + 8 * (r >> 2); if (kv > qrel) p0[r] = -INFINITY; if (kv + 32 > qrel) p1[r] = -INFINITY; } }
__device__ __forceinline__ void pv(f32x16* o, int vb, bf16x8 pa0, bf16x8 pa1, bf16x8 pa2, bf16x8 pa3) {
#pragma unroll
    for (int d0 = 0; d0 < 2; ++d0) { s16x4 lo[4], hi[4];
#pragma unroll
        for (int ks = 0; ks < 4; ++ks) {
            asm volatile("ds_read_b64_tr_b16 %0,%1 offset:%c2" : "=&v"(lo[ks]) : "v"(vb), "i"(d0 * 4096 + ks * 1024) : "memory");
            asm volatile("ds_read_b64_tr_b16 %0,%1 offset:%c2" : "=&v"(hi[ks]) : "v"(vb), "i"(d0 * 4096 + ks * 1024 + 512) : "memory"); }
        asm volatile("s_waitcnt lgkmcnt(0)" ::: "memory"); SBAR();
#define PK(k) (bf16x8){lo[k][0], lo[k][1], lo[k][2], lo[k][3], hi[k][0], hi[k][1], hi[k][2], hi[k][3]}
        o[d0] = MFMA32(pa0, PK(0), o[d0]); o[d0] = MFMA32(pa1, PK(1), o[d0]); o[d0] = MFMA32(pa2, PK(2), o[d0]); o[d0] = MFMA32(pa3, PK(3), o[d0]);
#undef PK
    } }

struct TopSel { float v0, v1, v2; int i0, i1, i2;
    __device__ __forceinline__ void init() { v0 = v1 = v2 = -3e38f; i0 = i1 = i2 = 99; }
    __device__ __forceinline__ void ins(float v, int i) {
        const bool b0 = v > v0 || (v == v0 && i < i0), b1 = v > v1 || (v == v1 && i < i1), b2 = v > v2 || (v == v2 && i < i2);
        if (b0) { v2 = v1; i2 = i1; v1 = v0; i1 = i0; v0 = v; i0 = i; } else if (b1) { v2 = v1; i2 = i1; v1 = v; i1 = i; } else if (b2) { v2 = v; i2 = i; } }
};

template <int DQK, bool MOBA, int THR>
__device__ __forceinline__ void unit1(int b, int h, int qb, const bf16_t* Q, int qp, int qo, const bf16_t* K, int kp, int ko, const bf16_t* V, int vp, int vo,
                                      bf16_t* O, int op, int oo, const float* kmp, char* lds) {
    constexpr int NKS = DQK / 16;
    const int tid = threadIdx.x, lane = tid & 63, r32 = lane & 31, hi = lane >> 5; const int wid = __builtin_amdgcn_readfirstlane(tid >> 6);
    const long rowbase = (long)b * S; const int q0 = qb * 256, NT = (q0 + 256) / 64;
    const unsigned lds0 = (unsigned)(uintptr_t)lds; float* wsf = (float*)(lds + LDS_WS) + wid * 64;
    const bf16_t* ksrc = K + (rowbase + lane) * kp + ko + wid * 8;
    const bf16_t* vsrc = V + (rowbase + 16 * (wid & 3) + (lane >> 2)) * vp + vo + (wid >> 2) * 32 + (lane & 3) * 8;
    const unsigned kdst = lds0 + LDS_K + wid * 1024, vdst = lds0 + LDS_V + wid * 1024;
#define DMA_T(t, buf) do { glds16(ksrc + (long)(t) * 64 * kp, (unsigned)__builtin_amdgcn_readfirstlane(kdst + (buf) * SLK)); \
        if (DQK == 96 && wid < 4) glds16(ksrc + (long)(t) * 64 * kp + 64, (unsigned)__builtin_amdgcn_readfirstlane(kdst + (buf) * SLK + 8192)); \
        glds16(vsrc + (long)(t) * 64 * vp, (unsigned)__builtin_amdgcn_readfirstlane(vdst + (buf) * SLV)); } while (0)
    bf16x8 qr[NKS];
    const bf16_t* Qw = Q + (rowbase + q0 + wid * 32 + r32) * qp + qo;
#pragma unroll
    for (int d0 = 0; d0 < NKS; ++d0) qr[d0] = *reinterpret_cast<const bf16x8*>(Qw + d0 * 16 + hi * 8);
    unsigned sel = 0u;
    if (MOBA && qb > 0) {
        f32x16 g = f32x16{};
        const float* kp0 = kmp + ((size_t)(b * 32 + r32) * 2) * 512 + h * 64 + hi * 8;
#pragma unroll
        for (int d0 = 0; d0 < 4; ++d0) {
            const f32x4 a0 = *(const f32x4*)(kp0 + d0 * 16), a1 = *(const f32x4*)(kp0 + d0 * 16 + 4), b0 = *(const f32x4*)(kp0 + 512 + d0 * 16), b1 = *(const f32x4*)(kp0 + 512 + d0 * 16 + 4);
            const f32x4 m0 = (a0 + b0) * (1.0f / 256.0f), m1 = (a1 + b1) * (1.0f / 256.0f);
            unsigned short hh[8], ll[8];
#pragma unroll
            for (int i = 0; i < 4; ++i) { hh[i] = (unsigned short)f2bf(m0[i]); ll[i] = (unsigned short)f2bf(m0[i] - bf2f(hh[i])); hh[4 + i] = (unsigned short)f2bf(m1[i]); ll[4 + i] = (unsigned short)f2bf(m1[i] - bf2f(hh[4 + i])); }
            const bf16x8 fh = {(short)hh[0], (short)hh[1], (short)hh[2], (short)hh[3], (short)hh[4], (short)hh[5], (short)hh[6], (short)hh[7]};
            const bf16x8 fl = {(short)ll[0], (short)ll[1], (short)ll[2], (short)ll[3], (short)ll[4], (short)ll[5], (short)ll[6], (short)ll[7]};
            g = MFMA32(fh, qr[d0], g); g = MFMA32(fl, qr[d0], g);
        }
        TopSel ts; ts.init();
#pragma unroll
        for (int r = 0; r < 16; ++r) { const int j = crow(r, hi); ts.ins(j < qb ? g[r] : -3e38f, j); }
        const float pv0 = __shfl_xor(ts.v0, 32), pv1 = __shfl_xor(ts.v1, 32), pv2 = __shfl_xor(ts.v2, 32);
        const int pi0 = __shfl_xor(ts.i0, 32), pi1 = __shfl_xor(ts.i1, 32), pi2 = __shfl_xor(ts.i2, 32);
        ts.ins(pv0, pi0); ts.ins(pv1, pi1); ts.ins(pv2, pi2);
        if (ts.v0 > -1e37f) sel |= 1u << (ts.i0 & 31); if (ts.v1 > -1e37f) sel |= 1u << (ts.i1 & 31); if (ts.v2 > -1e37f) sel |= 1u << (ts.i2 & 31);
    }
    asm volatile("s_waitcnt vmcnt(0)" ::: "memory");
    float mhat = 0.f, l_reg = 0.f; f32x16 o[2]; o[0] = f32x16{}; o[1] = f32x16{};
    const int qrel = wid * 32 + r32;
    const int vb0 = (int)(lds0 + LDS_V) + ((lane >> 4) & 1) * 32 + (lane & 3) * 8 + (4 * hi + ((lane & 15) >> 2)) * 64;
    DMA_T(0, 0);
    for (int t = 0; t < NT; ++t) {
        asm volatile("s_waitcnt vmcnt(0) lgkmcnt(0)\n\ts_barrier" ::: "memory");
        if (t + 1 < NT) DMA_T(t + 1, (t + 1) & 1);
        const int buf = t & 1;
        float msk = 0.f; if (MOBA && t < NT - 4) msk = ((sel >> (t >> 2)) & 1u) ? 0.f : -1e30f;
        f32x16 negm;
#pragma unroll
        for (int r = 0; r < 16; ++r) negm[r] = msk - mhat;
        f32x16 p0, p1;
        { const char* kb = lds + LDS_K + buf * SLK + hi * 1024 + r32 * 16;
#pragma unroll
          for (int d0 = 0; d0 < NKS; ++d0) { const bf16x8 k0 = *reinterpret_cast<const bf16x8*>(kb + d0 * 2048), k1 = *reinterpret_cast<const bf16x8*>(kb + d0 * 2048 + 512);
              if (d0 == 0) { p0 = MFMA32(k0, qr[0], negm); p1 = MFMA32(k1, qr[0], negm); } else { p0 = MFMA32(k0, qr[d0], p0); p1 = MFMA32(k1, qr[d0], p1); } } }
        if (t >= NT - 4) cmask(p0, p1, t - (NT - 4), qrel, hi);
        const float rm = rowmax(p0, p1);
        bool resc = false; float dl = 0.f;
        if (t == 0) { dl = (rm > -1e29f) ? rm : 0.f; }
        else if (__any(rm > (float)THR)) { dl = __builtin_fmaxf(rm, 0.f); resc = true; }
        if (t == 0 || resc) { mhat += dl;
#pragma unroll
            for (int r = 0; r < 16; ++r) { p0[r] -= dl; p1[r] -= dl; } }
        if (resc) { const float f = __builtin_amdgcn_exp2f(-dl); l_reg *= f; if (hi == 0) wsf[r32] = f; asm volatile("s_waitcnt lgkmcnt(0)" ::: "memory");
#pragma unroll
            for (int d_ = 0; d_ < 2; ++d_)
#pragma unroll
                for (int r = 0; r < 16; ++r) o[d_][r] *= wsf[crow(r, hi)];
            asm volatile("s_waitcnt lgkmcnt(0)" ::: "memory"); }
        float sacc = 0.f;
#pragma unroll
        for (int r = 0; r < 16; ++r) { p0[r] = __builtin_amdgcn_exp2f(p0[r]); p1[r] = __builtin_amdgcn_exp2f(p1[r]); sacc += p0[r] + p1[r]; }
        l_reg += sacc;
        u32x4 pw0 = {cvtpk(p0[0], p0[1]), cvtpk(p0[2], p0[3]), cvtpk(p0[4], p0[5]), cvtpk(p0[6], p0[7])}, pw1 = {cvtpk(p0[8], p0[9]), cvtpk(p0[10], p0[11]), cvtpk(p0[12], p0[13]), cvtpk(p0[14], p0[15])};
        u32x4 pw2 = {cvtpk(p1[0], p1[1]), cvtpk(p1[2], p1[3]), cvtpk(p1[4], p1[5]), cvtpk(p1[6], p1[7])}, pw3 = {cvtpk(p1[8], p1[9]), cvtpk(p1[10], p1[11]), cvtpk(p1[12], p1[13]), cvtpk(p1[14], p1[15])};
        SBAR();
        pv(o, vb0 + buf * SLV, __builtin_bit_cast(bf16x8, pw0), __builtin_bit_cast(bf16x8, pw1), __builtin_bit_cast(bf16x8, pw2), __builtin_bit_cast(bf16x8, pw3));
    }
    { auto rr = __builtin_amdgcn_permlane32_swap(__float_as_uint(l_reg), __float_as_uint(l_reg), false, false); l_reg = __uint_as_float(rr[0]) + __uint_as_float(rr[1]); }
    if (hi == 0) wsf[32 + r32] = l_reg; asm volatile("s_waitcnt lgkmcnt(0)" ::: "memory");
    float rli[16];
#pragma unroll
    for (int r = 0; r < 16; ++r) rli[r] = __builtin_amdgcn_rcpf(wsf[32 + crow(r, hi)]);
    bf16_t* Ow = O + (rowbase + q0 + wid * 32) * op + oo; bf16_t* stg = (bf16_t*)(lds + LDS_OST) + wid * 2048;
#pragma unroll
    for (int r = 0; r < 16; ++r) { const int orow = crow(r, hi);
#pragma unroll
        for (int d0 = 0; d0 < 2; ++d0) stg[orow * 64 + d0 * 32 + r32] = (bf16_t)f2bf(o[d0][r] * rli[r]); }
    asm volatile("s_waitcnt lgkmcnt(0)" ::: "memory");
#pragma unroll
    for (int i = 0; i < 4; ++i) { const int row = i * 8 + (lane >> 3), ch = lane & 7; *(u32x4*)(Ow + (long)row * op + ch * 8) = *(const u32x4*)(stg + row * 64 + ch * 8); }
    asm volatile("s_waitcnt vmcnt(0) lgkmcnt(0)\n\ts_barrier" ::: "memory");
#undef DMA_T
}
} }
#ifndef MK_PHMASK
#define MK_PHMASK 0x3ff
#endif
namespace mk {
struct Args { const float* in[18]; float* out; unsigned char* ws; int ph_lo, ph_hi; };

__device__ __forceinline__ int pair32(int rem, int half) { const int fq = rem >> 3, n = (rem >> 2) & 1, i = rem & 3; return n * half + fq * 4 + i; }
struct SrcWin { __device__ __forceinline__ int operator()(int j) const {
    const int pn = j >> 8, jl = j & 255;
    if (pn < 4) { const int hj = j & 511, head = hj >> 6, jj = hj & 63, w = jj >> 5, rem = jj & 31; const int fq = rem >> 3, n = (rem >> 2) & 1, i = rem & 3;
        return (pn < 2 ? 0 : 512) + head * 64 + n * 32 + w * 16 + fq * 4 + i; }
    if (pn < 7) return j;
    if (pn == 7) { if (jl < 128) return 1792 + jl; if (jl < 160) return 1920 + pair32(jl - 128, 16); return -1; }
    return 1952 + (j - 2048);
} };
struct SrcWqb { __device__ __forceinline__ int operator()(int j) const { const int G = j >> 5, head = G / 3, part = G - 3 * head, rem = j & 31; return head * 96 + (part < 2 ? part * 32 + rem : 64 + pair32(rem, 16)); } };
struct SrcWgu { __device__ __forceinline__ int operator()(int j) const { const int pn = j >> 8, bj = (j >> 7) & 1, jj = j & 127; return bj * DFF + 128 * pn + jj; } };
struct SrcId { __device__ __forceinline__ int operator()(int j) const { return j; } };

template <class F>
__device__ __forceinline__ void transpose_item(const float* W, int Ksrc, int Nsrc, const float* gain, bf16_t* WT, int Kd, F src, LAS float* scr, int item, int nblk, int lane) {
    const int kb = item / nblk, nb = item % nblk, k0 = 64 * kb, n0 = 32 * nb;
    const int sc = src(n0 + (lane & 31));
#pragma unroll 8
    for (int i = 0; i < 32; ++i) { const int kk = 2 * i + (lane >> 5), k = k0 + kk; float v = 0.f;
        if (sc >= 0 && k < Ksrc) { v = W[(size_t)k * Nsrc + sc]; if (gain) v *= gain[k]; }
        scr[kk * 33 + (lane & 31)] = v; }
    LDS_WAIT(); asm volatile("" ::: "memory");
    const int c = lane & 7;
#pragma unroll
    for (int j = 0; j < 4; ++j) { const int n = (lane >> 3) + 8 * j; const LAS float* s = scr + (8 * c) * 33 + n;
        u32x4 o; o.x = pk2(s[0 * 33], s[1 * 33]); o.y = pk2(s[2 * 33], s[3 * 33]); o.z = pk2(s[4 * 33], s[5 * 33]); o.w = pk2(s[6 * 33], s[7 * 33]);
        *(GAS u32x4*)(WT + (size_t)(n0 + n) * Kd + k0 + 8 * c) = o; }
    LDS_WAIT(); asm volatile("" ::: "memory");
}
__device__ __forceinline__ float wave_sum(float v) {
#pragma unroll
    for (int o = 1; o < 64; o <<= 1) v += __shfl_xor(v, o);
    return v;
}

struct Frame { LAS unsigned char* lds; int tid, lane, wave, vcu, G; };

__device__ __forceinline__ void p0_prologue(const Frame& F, const Args& A) {
    LAS float* scr = (LAS float*)(F.lds + F.wave * 16384);
    const int gw = F.vcu * NWAVES + F.wave, NGW = F.G * NWAVES;
    unsigned char* ws = A.ws;
    constexpr int I_WIN = 16 * 128, I_WGU = 16 * 176, I_WD = 44 * 32, I_WO = 16 * 32, I_WPG = 16 * 32, I_WMB = 8 * 32, I_WML = 8 * 32, I_WQB = 4 * 24, I_WKVB = 4 * 32, I_WPP = 4 * 32;
    constexpr int NITEMS = I_WIN + I_WGU + I_WD + I_WO + I_WPG + I_WMB + I_WML + I_WQB + I_WKVB + I_WPP;
    for (int it = gw; it < NITEMS; it += NGW) {
        int r = it;
        if (r < I_WIN) { transpose_item(A.in[3], 1024, 4000, A.in[2], (bf16_t*)(ws + WS_WIN), 1024, SrcWin(), scr, r, 128, F.lane); continue; } r -= I_WIN;
        if (r < I_WGU) { transpose_item(A.in[12], 1024, 2 * DFF, A.in[11], (bf16_t*)(ws + WS_WGU), 1024, SrcWgu(), scr, r, 176, F.lane); continue; } r -= I_WGU;
        if (r < I_WD) { transpose_item(A.in[13], DFF, 1024, nullptr, (bf16_t*)(ws + WS_WD), DFF, SrcId(), scr, r, 32, F.lane); continue; } r -= I_WD;
        if (r < I_WO) { transpose_item(A.in[10], 1024, 1024, nullptr, (bf16_t*)(ws + WS_WO), 1024, SrcId(), scr, r, 32, F.lane); continue; } r -= I_WO;
        if (r < I_WPG) { transpose_item(A.in[15], 1024, 1024, A.in[14], (bf16_t*)(ws + WS_WPG), 1024, SrcId(), scr, r, 32, F.lane); continue; } r -= I_WPG;
        if (r < I_WMB) { transpose_item(A.in[8], 512, 1024, nullptr, (bf16_t*)(ws + WS_WMB), 512, SrcId(), scr, r, 32, F.lane); continue; } r -= I_WMB;
        if (r < I_WML) { transpose_item(A.in[9], 512, 1024, nullptr, (bf16_t*)(ws + WS_WML), 512, SrcId(), scr, r, 32, F.lane); continue; } r -= I_WML;
        if (r < I_WQB) { transpose_item(A.in[5], 256, 768, A.in[4], (bf16_t*)(ws + WS_WQB), 256, SrcWqb(), scr, r, 24, F.lane); continue; } r -= I_WQB;
        if (r < I_WKVB) { transpose_item(A.in[7], 128, 1024, A.in[6], (bf16_t*)(ws + WS_WKVB), 256, SrcId(), scr, r, 32, F.lane); continue; } r -= I_WKVB;
        transpose_item(A.in[16], 256, 1024, nullptr, (bf16_t*)(ws + WS_WPP), 256, SrcId(), scr, r, 32, F.lane);
    }
    const float* x = A.in[0]; const float* p = A.in[1]; bf16_t* XB = (bf16_t*)(ws + WS_XB); bf16_t* PB = (bf16_t*)(ws + WS_PB); float* rstd0 = (float*)(ws + WS_RSTD0);
    for (int m = gw; m < T; m += NGW) {
        const GAS f32x4* xr = (const GAS f32x4*)(x + (size_t)m * D) + F.lane; f32x4 v[4]; float s = 0.f;
#pragma unroll
        for (int j = 0; j < 4; ++j) { v[j] = xr[64 * j]; s += (v[j][0] * v[j][0] + v[j][1] * v[j][1]) + (v[j][2] * v[j][2] + v[j][3] * v[j][3]); }
        s = wave_sum(s);
        GAS u32x2* o8 = (GAS u32x2*)(XB + (size_t)m * D) + F.lane;
#pragma unroll
        for (int j = 0; j < 4; ++j) o8[64 * j] = pack4(v[j]);
        if (F.lane == 0) rstd0[m] = 1.0f / sqrtf(s * (1.0f / 1024.0f) + EPS);
        const f32x4 pv_ = *((const GAS f32x4*)(p + (size_t)m * 256) + F.lane);
        *((GAS u32x2*)(PB + (size_t)m * 256) + F.lane) = pack4(pv_);
    }
    float2* tab64 = (float2*)(ws + WS_ROPE64); float2* tab32 = (float2*)(ws + WS_ROPE32);
    for (int idx = (F.vcu * NWAVES * 64) + F.tid; idx < S * 48; idx += F.G * NWAVES * 64) {
        const int t = idx / 48, j = idx % 48; const int half = (j < 32) ? 32 : 16, i = (j < 32) ? j : j - 32;
        const float e = (float)i * (2.0f / (float)(2 * half)); const float inv = 1.0f / powf(10000.0f, e); const float ang = (float)t * inv;
        float c, s; refp::sincos_acc(ang, c, s);
        if (j < 32) tab64[t * 32 + i] = make_float2(c, s); else tab32[t * 16 + i] = make_float2(c, s);
    }
}

__device__ __forceinline__ void p9_final(const Frame& F, const Args& A) {
    const int gw = F.vcu * NWAVES + F.wave, NGW = F.G * NWAVES; const float* ssq = (const float*)(A.ws + WS_SSQ_Y); const float* g = A.in[17];
    f32x4 gv[4];
#pragma unroll
    for (int j = 0; j < 4; ++j) gv[j] = *((const GAS f32x4*)g + F.lane + 64 * j);
    for (int m = gw; m < T; m += NGW) {
        const float rs = rstd_from16(ssq + (size_t)m * 16);
        GAS f32x4* xr = (GAS f32x4*)(A.out + (size_t)m * D) + F.lane;
#pragma unroll
        for (int j = 0; j < 4; ++j) xr[64 * j] = xr[64 * j] * rs * gv[j];
    }
}

__global__ void __launch_bounds__(NWAVES * 64, 2) mega_fwd(Args args) {
    extern __shared__ __attribute__((aligned(16))) unsigned char lds[];
    Frame F;
    F.lds = (LAS unsigned char*)lds;
    F.tid = threadIdx.x; F.lane = F.tid & 63; F.wave = __builtin_amdgcn_readfirstlane(F.tid >> 6);
    F.G = gridDim.x; { const int bx = blockIdx.x; F.vcu = (F.G % 8 == 0) ? (bx % 8) * (F.G / 8) + bx / 8 : bx; }
    unsigned char* ws = args.ws;
    volatile LAS unsigned* MISC = (volatile LAS unsigned*)(F.lds + MISC_OFF);
    for (int u = F.tid; u < 128; u += NWAVES * 64) MISC[u] = 0u;
    __syncthreads();
    XcdBarrier bar = xcd_barrier_post((unsigned*)(ws + WS_CTL) + CW_BAR, MISC + 8);
    const int lo = args.ph_lo, hi = args.ph_hi;
#define IN(k) (lo <= (k) && (k) < hi)
#define SEAM(k) do { if (IN(k) && IN((k) + 1)) xcd_barrier(bar); } while (0)
    bf16_t* XB = (bf16_t*)(ws + WS_XB); bf16_t* PB = (bf16_t*)(ws + WS_PB); bf16_t* QA = (bf16_t*)(ws + WS_QA); bf16_t* KA = (bf16_t*)(ws + WS_KA); bf16_t* VA = (bf16_t*)(ws + WS_VA);
    bf16_t* LAT = (bf16_t*)(ws + WS_LAT); bf16_t* KR = (bf16_t*)(ws + WS_KR); bf16_t* GA = (bf16_t*)(ws + WS_GA); bf16_t* GB = (bf16_t*)(ws + WS_GB);
    bf16_t* QM = (bf16_t*)(ws + WS_QM); bf16_t* KM = (bf16_t*)(ws + WS_KM); bf16_t* VM = (bf16_t*)(ws + WS_VM); bf16_t* MO = (bf16_t*)(ws + WS_MO); bf16_t* ML = (bf16_t*)(ws + WS_ML);
    bf16_t* MIX = (bf16_t*)(ws + WS_MIX); bf16_t* ACT = (bf16_t*)(ws + WS_ACT);
    float* rstd0 = (float*)(ws + WS_RSTD0); float* ssq_cq = (float*)(ws + WS_SSQ_CQ); float* ssq_kv = (float*)(ws + WS_SSQ_KV); float* kmp = (float*)(ws + WS_KMP);
    float* ssq_x = (float*)(ws + WS_SSQ_X); float* ssq_y = (float*)(ws + WS_SSQ_Y);
    const float2* rope64 = (const float2*)(ws + WS_ROPE64); const float2* rope32 = (const float2*)(ws + WS_ROPE32);
    const int bx = (int)blockIdx.x;

    if (((MK_PHMASK >> 0) & 1) && IN(0)) { p0_prologue(F, args); }
    SEAM(0);
    if (((MK_PHMASK >> 1) & 1) && IN(1)) {
        pg8::Gemm g{XB, (const bf16_t*)(ws + WS_WIN), T, 4096, 1024, 1024}; pg8::StaticOrder So; So.init(T, 4096, F.G, bx);
        EpiInProj E{rstd0, rope64, rope32, QA, KA, VA, LAT, KR, GA, GB, ssq_cq, ssq_kv, kmp};
        pg8::gemm_phase<EpiInProj, pg8::StaticOrder, true, true>(F.lds, g, So, E);
    }
    SEAM(1);
    if (((MK_PHMASK >> 2) & 1) && IN(2)) {
        { pg8::Gemm g{LAT, (const bf16_t*)(ws + WS_WQB), T, 768, 256, 512}; pg8::StaticOrder So; So.init(T, 768, F.G, bx);
          EpiQb E{ssq_cq, rope32, QM}; pg8::gemm_phase<EpiQb, pg8::StaticOrder, true, true>(F.lds, g, So, E); }
        { pg8::Gemm g{LAT + 256, (const bf16_t*)(ws + WS_WKVB), T, 1024, 256, 512}; pg8::StaticOrder So; So.init(T, 1024, F.G, bx);
          EpiKvb E{ssq_kv, KR, KM, VM}; pg8::gemm_phase<EpiKvb, pg8::StaticOrder, true, true>(F.lds, g, So, E); }
    }
    SEAM(2);
    if (((MK_PHMASK >> 3) & 1) && IN(3)) {
        const int bh = F.vcu >> 3, s = F.vcu & 7;
        if (bh < NB * 8 && F.G == 256) {
            const int b = bh >> 3, h = bh & 7;
            for (int i = 0; i < 4; ++i) { const int qb = (i == 0) ? s : (i == 1) ? 15 - s : (i == 2) ? 16 + s : 31 - s;
                att::unit1<64, true, 8>(b, h, qb, QA, 512, h * 64, KA, 512, h * 64, VA, 512, h * 64, MO, 512, h * 64, kmp, (char*)lds); }
            for (int i = 0; i < 4; ++i) { const int qb = (i == 0) ? s : (i == 1) ? 15 - s : (i == 2) ? 16 + s : 31 - s;
                att::unit1<96, false, 8>(b, h, qb, QM, 768, h * 96, KM, 768, h * 96, VM, 512, h * 64, ML, 512, h * 64, kmp, (char*)lds); }
        }
    }
    SEAM(3);
    if (((MK_PHMASK >> 4) & 1) && IN(4)) {
        float* TMP = (float*)(ws + WS_TMP4);
        { pg8::Gemm g{MO, (const bf16_t*)(ws + WS_WMB), T, 1024, 512, 512}; pg8::StaticOrder So; So.init(T, 1024, F.G, bx);
          EpiBranchA E{GA, TMP}; pg8::gemm_phase<EpiBranchA, pg8::StaticOrder, true, true>(F.lds, g, So, E); }
        { pg8::Gemm g{ML, (const bf16_t*)(ws + WS_WML), T, 1024, 512, 512}; pg8::StaticOrder So; So.init(T, 1024, F.G, bx);
          EpiBranchB E{GB, TMP, MIX}; pg8::gemm_phase<EpiBranchB, pg8::StaticOrder, true, true>(F.lds, g, So, E); }
    }
    SEAM(4);
    if (((MK_PHMASK >> 5) & 1) && IN(5)) {
        pg8::Gemm g{MIX, (const bf16_t*)(ws + WS_WO), T, 1024, 1024, 1024}; pg8::StaticOrder So; So.init(T, 1024, F.G, bx);
        EpiResid E{args.in[0], args.out, XB, ssq_x}; pg8::gemm_phase<EpiResid, pg8::StaticOrder, true, true>(F.lds, g, So, E);
    }
    SEAM(5);
    if (((MK_PHMASK >> 6) & 1) && IN(6)) {
        pg8::Gemm g{XB, (const bf16_t*)(ws + WS_WGU), T, 2 * DFF, 1024, 1024}; pg8::StaticOrder So; So.init(T, 2 * DFF, F.G, bx);
        EpiGateUp E{ssq_x, ACT}; pg8::gemm_phase<EpiGateUp, pg8::StaticOrder, true, true>(F.lds, g, So, E);
    }
    SEAM(6);
    if (((MK_PHMASK >> 7) & 1) && IN(7)) {
        pg8::Gemm g{ACT, (const bf16_t*)(ws + WS_WD), T, 1024, DFF, DFF}; pg8::StaticOrder So; So.init(T, 1024, F.G, bx);
        EpiResid E{args.out, args.out, XB, ssq_x}; pg8::gemm_phase<EpiResid, pg8::StaticOrder, true, true>(F.lds, g, So, E);
    }
    SEAM(7);
    if (((MK_PHMASK >> 8) & 1) && IN(8)) {
        float* TMP = (float*)(ws + WS_TMP8);
        { pg8::Gemm g{PB, (const bf16_t*)(ws + WS_WPP), T, 1024, 256, 256}; pg8::StaticOrder So; So.init(T, 1024, F.G, bx);
          EpiPleA E{TMP}; pg8::gemm_phase<EpiPleA, pg8::StaticOrder, true, true>(F.lds, g, So, E); }
        { pg8::Gemm g{XB, (const bf16_t*)(ws + WS_WPG), T, 1024, 1024, 1024}; pg8::StaticOrder So; So.init(T, 1024, F.G, bx);
          EpiPleB E{ssq_x, TMP, args.out, ssq_y}; pg8::gemm_phase<EpiPleB, pg8::StaticOrder, true, true>(F.lds, g, So, E); }
    }
    SEAM(8);
    if (((MK_PHMASK >> 9) & 1) && IN(9)) { p9_final(F, args); }
#undef IN
#undef SEAM
}

static inline bool launch(void* const* d_in, float* out, unsigned char* ws, hipStream_t stream, int ph_lo, int ph_hi) {
    static int grid = 0;
    if (grid == 0) {
        int dev = 0, cus = 0, per_cu = 0;
        if (hipGetDevice(&dev) != hipSuccess || hipDeviceGetAttribute(&cus, hipDeviceAttributeMultiprocessorCount, dev) != hipSuccess) { fprintf(stderr, "mk: device query failed\n"); grid = -1; return false; }
        if (hipFuncSetAttribute((const void*)mega_fwd, hipFuncAttributeMaxDynamicSharedMemorySize, LDS_BYTES) != hipSuccess) { fprintf(stderr, "mk: hipFuncSetAttribute failed\n"); grid = -1; return false; }
        if (hipOccupancyMaxActiveBlocksPerMultiprocessor(&per_cu, (const void*)mega_fwd, NWAVES * 64, LDS_BYTES) != hipSuccess || per_cu < 1) { fprintf(stderr, "mk: occupancy query says %d blocks per CU\n", per_cu); (void)hipGetLastError(); grid = -1; return false; }
        grid = cus;
        if (grid != 256) fprintf(stderr, "mk: %d CUs (expected 256)\n", grid);
    }
    if (grid < 0) return false;
    if (hipMemsetAsync(ws + WS_CTL, 0, CTL_ZERO_BYTES, stream) != hipSuccess) return false;
    Args a{};
    for (int i = 0; i < 18; ++i) a.in[i] = (const float*)d_in[i];
    a.out = out; a.ws = ws; a.ph_lo = ph_lo; a.ph_hi = ph_hi;
    hipLaunchKernelGGL(mega_fwd, dim3(grid), dim3(NWAVES * 64), LDS_BYTES, stream, a);
    return hipPeekAtLastError() == hipSuccess;
}
}
extern "C" void kernel_launch(void* const* d_in, const int* in_sizes, int n_in, void* d_out, int out_size, void* d_ws, size_t ws_size, hipStream_t stream) {
    if (n_in != 18 || out_size != 4 * 8192 * 1024 || ws_size < mk::WS_MEGA_END) { fprintf(stderr, "kernel_launch: unexpected sizes n_in %d out %d ws %zu\n", n_in, out_size, ws_size); return; }
    mk::launch(d_in, (float*)d_out, (unsigned char*)d_ws, stream, 0, 10);
}
```

```cpp
#include <hip/hip_runtime.h>
#include <cstdio>
#include <cstdint>
namespace pg8 {
#define PG8_LAS __attribute__((address_space(3)))
typedef unsigned short bf16_t;
typedef short bf16x8 __attribute__((ext_vector_type(8)));
typedef float f32x4 __attribute__((ext_vector_type(4)));
typedef unsigned u32x4 __attribute__((ext_vector_type(4)));
constexpr int BM = 256, BK = 64, HALF = 128, HTB = HALF * BK * 2  , STAGE_BYTES = 8 * HTB, NXCD = 8, WGM = 8;

__host__ __device__ __forceinline__ int lds_byte(int r, int c) { const int st = (r >> 4) * 2 + (c >> 5), rr = r & 15, cc = c & 31, ob = rr * 64 + cc * 2; return st * 1024 + (ob ^ (((ob >> 9) & 1) << 5)); }
__host__ __device__ __forceinline__ void stage_rc(int b, int& R, int& C) { const int st = b / 1024, sb = b % 1024, swz = sb ^ (((sb >> 9) & 1) << 5); R = (st >> 1) * 16 + swz / 64; C = (st & 1) * 32 + (swz % 64) / 2; }
__host__ __device__ __forceinline__ int perm32(int rho) { const int n = rho >> 4, i = rho & 15; return 8 * (i >> 2) + 4 * n + (i & 3); }

struct Unit { int pm, pn, koff, sub, koffa; };
struct Gemm { const bf16_t* A; const bf16_t* Bt; int M, N, K, lda, ldb; };

struct StaticOrder {
    int nM, nN, nwg, G, c;
    __host__ __device__ void init(int M, int N, int G_, int c_) { nM = M / BM; nN = N / BM; nwg = nM * nN; G = G_; c = c_; }
    __host__ __device__ bool next(int i, Unit& u) const {
        const long L = (long)i * G + c; if (L >= nwg) return false;
        int wgid = (int)L; { const int q = nwg / NXCD, r = nwg % NXCD, xcd = wgid % NXCD, off = wgid / NXCD; wgid = (xcd < r ? xcd * (q + 1) : r * (q + 1) + (xcd - r) * q) + off; }
        const int nig = WGM * nN, gid = wgid / nig, fm = gid * WGM, gsz = (nM - fm) < WGM ? (nM - fm) : WGM;
        u.pm = fm + ((wgid % nig) % gsz); u.pn = (wgid % nig) / gsz; u.koff = 0; u.koffa = 0; u.sub = 0; return true;
    }
    __device__ __forceinline__ void a_ready(const Unit&) const {}
    __device__ __forceinline__ void done(const Unit&) const {}
};
struct PairOrder : StaticOrder { int ksub, adelta;
    __host__ __device__ bool next(int i, Unit& u) const { if (!StaticOrder::next(i >> 1, u)) return false; u.sub = i & 1; u.koff = (i & 1) * ksub; u.koffa = (i & 1) * adelta; return true; } };


typedef float f32x2 __attribute__((ext_vector_type(2)));
template <class Epi, class Sched, bool ALIGN_EPI = false, bool SP2 = false>
__device__ __forceinline__ void gemm_phase(PG8_LAS unsigned char* lds, const Gemm g, const Sched& S, const Epi& E, const int tid0) {
    int tid_ = tid0; asm volatile("" : "+v"(tid_));
    const int tid = tid_, wid = __builtin_amdgcn_readfirstlane(tid >> 6), lane = tid & 63, wr = wid >> 2, wc = wid & 3, fr = lane & 15, fq = lane >> 4;
    int K_ = g.K; asm volatile("" : "+s"(K_));
    const int K = K_, nt = K / BK;
    unsigned voffA[2], voffB[2];
#pragma unroll
    for (int i = 0; i < 2; ++i) { int R, C; stage_rc(tid * 16 + i * 8192, R, C); const int Rb = Epi::PERM ? ((R & ~31) + perm32(R & 31)) : R;
        voffA[i] = (unsigned)(R * g.lda + C) * 2u; voffB[i] = (unsigned)(Rb * g.ldb + C) * 2u; }
    const size_t kstep = (size_t)(BK * 2);
    const size_t hstep = (size_t)HALF * g.ldb * 2, hstepA = (size_t)HALF * g.lda * 2;
    const size_t tstep = 2 * hstep, tstepA = 2 * hstepA;
    const unsigned ldsw = (unsigned)wid * 1024u;
    const int aoff = lds_byte(wr * 64 + fr, fq * 8), boff = lds_byte(wc * 32 + fr, fq * 8);
#define PG8_SA(b, h) (((b) * 2 + (h)) * HTB)
#define PG8_SB(b, h) ((4 + (b) * 2 + (h)) * HTB)
#define PG8_STAGE(bufoff, gbase, voff) do { _Pragma("unroll") for (int _i = 0; _i < 2; ++_i) \
        __builtin_amdgcn_global_load_lds((const unsigned*)((const char*)(gbase) + (voff)[_i]), (PG8_LAS unsigned*)(lds + (bufoff) + ldsw + _i * 8192), 16, 0, 0); } while (0)
#define PG8_LDA(dst, b, h) do { _Pragma("unroll") for (int m = 0; m < 4; ++m) _Pragma("unroll") for (int k = 0; k < 2; ++k) dst[m][k] = *(const PG8_LAS bf16x8*)(lds + PG8_SA(b, h) + aoff + m * 2048 + k * 1024); } while (0)
#define PG8_LDB(dst, b, h) do { _Pragma("unroll") for (int n = 0; n < 2; ++n) _Pragma("unroll") for (int k = 0; k < 2; ++k) dst[n][k] = *(const PG8_LAS bf16x8*)(lds + PG8_SB(b, h) + boff + n * 2048 + k * 1024); } while (0)
#define PG8_MMA(ai, bj, At, Bt) do { __builtin_amdgcn_s_setprio(1); _Pragma("unroll") for (int m = 0; m < 4; ++m) _Pragma("unroll") for (int n = 0; n < 2; ++n) _Pragma("unroll") for (int k = 0; k < 2; ++k) \
        acc[ai][bj][m][n] = __builtin_amdgcn_mfma_f32_16x16x32_bf16(Bt[n][k], At[m][k], acc[ai][bj][m][n], 0, 0, 0); __builtin_amdgcn_s_setprio(0); } while (0)
#define PG8_WAIT_V(n) asm volatile("s_waitcnt vmcnt(" #n ")" ::: "memory")
#define PG8_WAIT_L(n) asm volatile("s_waitcnt lgkmcnt(" #n ")" ::: "memory")
#define PG8_BAR __builtin_amdgcn_s_barrier()
#define PG8_SCHED __builtin_amdgcn_sched_barrier(0)
    Unit cur, nxt; int ui = 0;
    if (!S.next(0, cur)) return;
    f32x4 acc[2][2][4][2];
#pragma unroll
    for (int a = 0; a < 2; ++a)
#pragma unroll
        for (int b = 0; b < 2; ++b)
#pragma unroll
            for (int m = 0; m < 4; ++m)
#pragma unroll
                for (int n = 0; n < 2; ++n) acc[a][b][m][n] = (f32x4){0.f, 0.f, 0.f, 0.f};
    bf16x8 At[4][2], B0[2][2], B1[2][2];
    const char* cA = (const char*)g.A + (size_t)cur.pm * tstepA + (size_t)cur.koffa * 2; const char* cB = (const char*)g.Bt + (size_t)cur.pn * tstep + (size_t)cur.koff * 2;
    S.a_ready(cur);
    if constexpr (SP2) {
        PG8_STAGE(PG8_SB(0, 0), cB, voffB); PG8_STAGE(PG8_SB(0, 1), cB + hstep, voffB); PG8_STAGE(PG8_SA(0, 0), cA, voffA); PG8_STAGE(PG8_SA(0, 1), cA + hstepA, voffA);
        if (wr == 1) PG8_BAR;
        PG8_WAIT_V(2); PG8_BAR;
        PG8_STAGE(PG8_SB(1, 0), cB + kstep, voffB); PG8_STAGE(PG8_SA(1, 0), cA + kstep, voffA); PG8_STAGE(PG8_SB(1, 1), cB + hstep + kstep, voffB);
        PG8_WAIT_V(6); PG8_BAR;
    } else {
        PG8_STAGE(PG8_SB(0, 0), cB, voffB); PG8_STAGE(PG8_SA(0, 0), cA, voffA); PG8_STAGE(PG8_SB(0, 1), cB + hstep, voffB); PG8_STAGE(PG8_SA(0, 1), cA + hstepA, voffA);
        if (wr == 1) PG8_BAR;
        PG8_WAIT_V(4); PG8_BAR;
        PG8_STAGE(PG8_SB(1, 0), cB + kstep, voffB); PG8_STAGE(PG8_SA(1, 0), cA + kstep, voffA); PG8_STAGE(PG8_SB(1, 1), cB + hstep + kstep, voffB);
        PG8_WAIT_V(6); PG8_BAR;
    }
    for (;;) {
        const bool has_next = S.next(ui + 1, nxt);
        const char* nA = has_next ? (const char*)g.A + (size_t)nxt.pm * tstepA + (size_t)nxt.koffa * 2 : cA; const char* nB = has_next ? (const char*)g.Bt + (size_t)nxt.pn * tstep + (size_t)nxt.koff * 2 : cB;
        for (int t = 0; t < nt; t += 2) {
            const bool last = (t == nt - 2);
            const char* a1 = cA + (size_t)(t + 1) * kstep;
            const char* a2 = last ? nA : cA + (size_t)(t + 2) * kstep; const char* b2 = last ? nB : cB + (size_t)(t + 2) * kstep;
            const char* a3 = a2 + kstep; const char* b3 = b2 + kstep;
            if (last && has_next) S.a_ready(nxt);
            if constexpr (SP2) {
            PG8_LDB(B0, 0, 0); PG8_LDB(B1, 0, 1); PG8_SCHED; PG8_LDA(At, 0, 0); PG8_STAGE(PG8_SA(1, 1), a1 + hstepA, voffA);
            PG8_WAIT_V(8); PG8_WAIT_L(0); PG8_BAR; PG8_MMA(0, 0, At, B0); PG8_MMA(0, 1, At, B1); PG8_BAR; PG8_SCHED;
            PG8_LDA(At, 0, 1); PG8_STAGE(PG8_SB(0, 0), b2, voffB); PG8_STAGE(PG8_SB(0, 1), b2 + hstep, voffB); PG8_STAGE(PG8_SA(0, 0), a2, voffA);
            PG8_WAIT_V(8); PG8_WAIT_L(0); PG8_BAR; PG8_MMA(1, 0, At, B0); PG8_MMA(1, 1, At, B1); PG8_BAR; PG8_SCHED;
            PG8_LDB(B0, 1, 0); PG8_LDB(B1, 1, 1); PG8_SCHED; PG8_LDA(At, 1, 0); PG8_STAGE(PG8_SA(0, 1), a2 + hstepA, voffA);
            PG8_WAIT_V(8); PG8_WAIT_L(0); PG8_BAR; PG8_MMA(0, 0, At, B0); PG8_MMA(0, 1, At, B1); PG8_BAR; PG8_SCHED;
            PG8_LDA(At, 1, 1); PG8_STAGE(PG8_SB(1, 0), b3, voffB); PG8_STAGE(PG8_SB(1, 1), b3 + hstep, voffB); PG8_STAGE(PG8_SA(1, 0), a3, voffA);
            PG8_WAIT_V(8); PG8_WAIT_L(0); PG8_BAR; PG8_MMA(1, 0, At, B0); PG8_MMA(1, 1, At, B1); PG8_BAR; PG8_SCHED;
            } else {
            PG8_LDB(B0, 0, 0); PG8_SCHED; PG8_LDA(At, 0, 0); PG8_STAGE(PG8_SA(1, 1), a1 + hstepA, voffA);
            PG8_WAIT_L(8); PG8_BAR; PG8_WAIT_L(0); PG8_MMA(0, 0, At, B0); PG8_BAR; PG8_SCHED;
            PG8_LDB(B1, 0, 1); PG8_STAGE(PG8_SB(0, 0), b2, voffB);
            PG8_BAR; PG8_WAIT_L(0); PG8_MMA(0, 1, At, B1); PG8_BAR;
            PG8_LDA(At, 0, 1); PG8_STAGE(PG8_SA(0, 0), a2, voffA);
            PG8_BAR; PG8_WAIT_L(0); PG8_MMA(1, 0, At, B0); PG8_BAR; PG8_SCHED;
            PG8_STAGE(PG8_SB(0, 1), b2 + hstep, voffB);
            PG8_WAIT_V(6); PG8_BAR; PG8_MMA(1, 1, At, B1); PG8_BAR;
            PG8_LDB(B0, 1, 0); PG8_SCHED; PG8_LDA(At, 1, 0); PG8_STAGE(PG8_SA(0, 1), a2 + hstepA, voffA);
            PG8_WAIT_L(8); PG8_BAR; PG8_WAIT_L(0); PG8_MMA(0, 0, At, B0); PG8_BAR; PG8_SCHED;
            PG8_LDB(B1, 1, 1); PG8_STAGE(PG8_SB(1, 0), b3, voffB);
            PG8_BAR; PG8_WAIT_L(0); PG8_MMA(0, 1, At, B1); PG8_BAR;
            PG8_LDA(At, 1, 1); PG8_STAGE(PG8_SA(1, 0), a3, voffA);
            PG8_BAR; PG8_WAIT_L(0); PG8_MMA(1, 0, At, B0); PG8_BAR; PG8_SCHED;
            PG8_STAGE(PG8_SB(1, 1), b3 + hstep, voffB);
            PG8_WAIT_V(6); PG8_BAR; PG8_MMA(1, 1, At, B1); PG8_BAR;
            }
        }
        if constexpr (ALIGN_EPI) { if (wr == 0) PG8_BAR; }
        if constexpr (!Epi::AFTER_DRAIN) { E(acc, cur, wr, wc, fr, fq); S.done(cur); }
        if (!has_next) break;
        if (!(Epi::HAS_MID && cur.sub == 0))
#pragma unroll
        for (int a = 0; a < 2; ++a)
#pragma unroll
            for (int b = 0; b < 2; ++b)
#pragma unroll
                for (int m = 0; m < 4; ++m)
#pragma unroll
                    for (int n = 0; n < 2; ++n) acc[a][b][m][n] = (f32x4){0.f, 0.f, 0.f, 0.f};
        cur = nxt; cA = nA; cB = nB; ++ui;
        if constexpr (ALIGN_EPI) { if (wr == 1) PG8_BAR; }
    }
    PG8_WAIT_V(0);
    if constexpr (!ALIGN_EPI) { if (wr == 0) PG8_BAR; }
    PG8_BAR;
    if constexpr (Epi::AFTER_DRAIN) { E.fused(acc, cur, wr, wc, fr, fq, lds, wid, lane); S.done(cur); }
#undef PG8_SA
#undef PG8_SB
#undef PG8_STAGE
#undef PG8_LDA
#undef PG8_LDB
#undef PG8_MMA
#undef PG8_WAIT_V
#undef PG8_WAIT_L
#undef PG8_BAR
#undef PG8_SCHED
}
}
#ifndef MK_NB
#define MK_NB 4
#endif
namespace mk {
using pg8::bf16_t; using pg8::f32x4; using pg8::u32x4; using pg8::bf16x8;
typedef unsigned u32x2 __attribute__((ext_vector_type(2)));
typedef float f32x16 __attribute__((ext_vector_type(16)));
typedef short s16x4 __attribute__((ext_vector_type(4)));
constexpr int NB = MK_NB, S = 8192, T = NB * S, D = 1024, DFF = 2816, NWAVES = 8;
constexpr float EPS = 1e-6f;
constexpr float LOG2E = 1.4426950408889634f;
constexpr float C2A = 0.125f * LOG2E;
constexpr float C2B = 0.10206207261596577f * LOG2E;

constexpr size_t MiB = (size_t)1 << 20;
constexpr size_t WS_CTL = 0, CTL_ZERO_BYTES = 1 * MiB;
constexpr size_t WS_ROPE64 = 1 * MiB, WS_ROPE32 = 3 * MiB;
constexpr size_t WS_RSTD0 = 4 * MiB;
constexpr size_t WS_SSQ_CQ = WS_RSTD0 + 256 * 1024;
constexpr size_t WS_SSQ_KV = WS_SSQ_CQ + 512 * 1024;
constexpr size_t WS_KMP = WS_SSQ_KV + 512 * 1024;
constexpr size_t WS_SSQ_X = 6 * MiB;
constexpr size_t WS_SSQ_Y = 8 * MiB;
constexpr size_t WS_W = 10 * MiB;
constexpr size_t WS_WIN = WS_W, WS_WGU = WS_WIN + (size_t)4096 * 1024 * 2, WS_WD = WS_WGU + (size_t)5632 * 1024 * 2, WS_WO = WS_WD + (size_t)1024 * 2816 * 2,
                 WS_WPG = WS_WO + 2 * MiB, WS_WBR = WS_WPG + 2 * MiB  , WS_WQB = WS_WBR + 2 * MiB, WS_WKVB = WS_WQB + (size_t)768 * 256 * 2,
                 WS_WPP = WS_WKVB + (size_t)1024 * 256 * 2, WS_WEND = WS_WPP + (size_t)1024 * 256 * 2;
constexpr size_t WS_ACT0 = 44 * MiB;
static_assert(WS_WEND <= WS_ACT0, "weights fit");
constexpr size_t TB = (size_t)T;
constexpr size_t WS_XB = WS_ACT0;
constexpr size_t WS_PB = WS_XB + TB * 1024 * 2;
constexpr size_t WS_QA = WS_PB + TB * 256 * 2;
constexpr size_t WS_KA = WS_QA + TB * 512 * 2;
constexpr size_t WS_VA = WS_KA + TB * 512 * 2;
constexpr size_t WS_LAT = WS_VA + TB * 512 * 2;
constexpr size_t WS_KR = WS_LAT + TB * 512 * 2;
constexpr size_t WS_GA = WS_KR + TB * 64;
constexpr size_t WS_GB = WS_GA + TB * 1024 * 2;
constexpr size_t WS_QM = WS_GB + TB * 1024 * 2;
constexpr size_t WS_KM = WS_QM + TB * 768 * 2;
constexpr size_t WS_VM = WS_KM + TB * 768 * 2;
constexpr size_t WS_MEGA_END = WS_VM + TB * 512 * 2;
constexpr size_t WS_MOML = WS_XB;
constexpr size_t WS_MIX = WS_KA;
constexpr size_t WS_ACT = WS_QA;
constexpr size_t WS_TMP8 = WS_QA;
static_assert(WS_ACT + TB * 2816 * 2 <= WS_MEGA_END, "ACT overlay");
static_assert(NB != 4 || WS_MEGA_END <= 512 * MiB, "workspace map fits 512 MiB");
constexpr int CW_BAR = 4096, CW_MOBA = 32768, CW_PNL = 65536;

constexpr int LDS_BYTES = 163840;
constexpr int RING_BYTES = 131072, XL_OFF = 131072  , MISC_OFF = 163840 - 512;

#define GAS __attribute__((address_space(1)))
#define LAS __attribute__((address_space(3)))
typedef GAS unsigned gu32;
#define LDS_WAIT() asm volatile("s_waitcnt lgkmcnt(0)" ::: "memory")
#define VM_WAIT() asm volatile("s_waitcnt vmcnt(0)" ::: "memory")
__device__ __forceinline__ unsigned f2bf(float f) { unsigned u = __builtin_bit_cast(unsigned, f); return (u + 0x7fffu + ((u >> 16) & 1u)) >> 16; }
typedef float f32x2_c __attribute__((ext_vector_type(2))); typedef __bf16 bf16x2_c __attribute__((ext_vector_type(2)));
__device__ __forceinline__ unsigned pk2(float lo, float hi) { f32x2_c v = {lo, hi}; bf16x2_c b = __builtin_convertvector(v, bf16x2_c); return __builtin_bit_cast(unsigned, b); }
__device__ __forceinline__ float bf2f(unsigned short b) { return __builtin_bit_cast(float, (unsigned)b << 16); }
__device__ __forceinline__ float bflo(unsigned w) { return __builtin_bit_cast(float, w << 16); }
__device__ __forceinline__ float bfhi(unsigned w) { return __builtin_bit_cast(float, w & 0xffff0000u); }
__device__ __forceinline__ float sigm(float v) { return __builtin_amdgcn_rcpf(1.0f + __builtin_amdgcn_exp2f(-LOG2E * v)); }
__device__ __forceinline__ u32x4 pack8(const f32x4& a, const f32x4& b) { u32x4 w; w.x = pk2(a[0], a[1]); w.y = pk2(a[2], a[3]); w.z = pk2(b[0], b[1]); w.w = pk2(b[2], b[3]); return w; }
__device__ __forceinline__ u32x2 pack4(const f32x4& a) { u32x2 w; w.x = pk2(a[0], a[1]); w.y = pk2(a[2], a[3]); return w; }

__device__ __forceinline__ void sincos_acc(float ang, float& c, float& s) {
    const double x = (double)ang;
    const double k = __builtin_rint(x * 0.63661977236758134308);
    const double r = __builtin_fma(-k, 1.5707963267948966192, x) - k * 6.123233995736766036e-17;
    const double r2 = r * r;
    double sp = -2.5052108385441718775e-08; sp = sp * r2 + 2.7557319223985890653e-06; sp = sp * r2 - 1.9841269841269841270e-04; sp = sp * r2 + 8.3333333333333333333e-03; sp = sp * r2 - 1.6666666666666666667e-01;
    const double sn = r + r * r2 * sp;
    double cp = 2.0876756987868098979e-09; cp = cp * r2 - 2.7557319223985890653e-07; cp = cp * r2 + 2.4801587301587301587e-05; cp = cp * r2 - 1.3888888888888888889e-03; cp = cp * r2 + 4.1666666666666666667e-02; cp = cp * r2 - 0.5;
    const double cs = 1.0 + r2 * cp;
    const int q = (int)((long long)k & 3);
    const double cc = (q == 0) ? cs : (q == 1) ? -sn : (q == 2) ? -cs : sn;
    const double ss = (q == 0) ? sn : (q == 1) ? cs : (q == 2) ? -sn : -cs;
    c = (float)cc; s = (float)ss;
}

#define XB_TMO      128
#define XB_XCNT(j)  (256  + 64 * (j))
#define XB_XSUB(j)  (1280 + 64 * (j))
#define XB_XGEN(j)  (2304 + 64 * (j))
#define XB_TOP      3328
#define XB_TOPGEN   3392
#define XCD_BAR_WORDS 3456
#define XB_SPIN_CAP (1u << 18)
__device__ __forceinline__ unsigned xb_ld(unsigned* p)              { return __hip_atomic_load(p, __ATOMIC_RELAXED, __HIP_MEMORY_SCOPE_AGENT); }
__device__ __forceinline__ unsigned xb_add(unsigned* p, unsigned v) { return __hip_atomic_fetch_add(p, v, __ATOMIC_RELAXED, __HIP_MEMORY_SCOPE_AGENT); }
__device__ __forceinline__ unsigned xb_xcc_id() { return (unsigned)__builtin_amdgcn_s_getreg((3 << 11) | 20) & 0xFu; }
#define XB_SPIN(cond, bar) do { unsigned _sp = 0; while (cond) { __builtin_amdgcn_s_sleep(1); \
    if ((++_sp & 255u) == 0u) { if (xb_ld(&(bar)[XB_TMO])) break; if (_sp > XB_SPIN_CAP) { atomicAdd(&(bar)[XB_TMO], 1u); break; } } } } while (0)
struct XcdBarrier { unsigned* bar; unsigned x; volatile LAS unsigned* st; };
__device__ __forceinline__ XcdBarrier xcd_barrier_post(unsigned* bar, volatile LAS unsigned* st, const int tid0) {
    XcdBarrier b; b.bar = bar; b.x = xb_xcc_id(); b.st = st;
    if (tid0 == 0) (void)xb_add(&bar[XB_XCNT(b.x)], 1u);
    return b;
}
__device__ __forceinline__ void xcd_barrier_complete(unsigned* bar, unsigned x, unsigned& nloc, unsigned& nx) {
    const unsigned G = gridDim.x * gridDim.y * gridDim.z;
    unsigned sum, cnt, mine, sp = 0u;
    for (;;) {
        sum = 0u; cnt = 0u; mine = 0u;
#pragma unroll
        for (unsigned j = 0; j < 16; ++j) { const unsigned c = xb_ld(&bar[XB_XCNT(j)]); sum += c; cnt += (c > 0u) ? 1u : 0u; mine = (j == x) ? c : mine; }
        if (sum == G) break;
        __builtin_amdgcn_s_sleep(1);
        if ((++sp & 255u) == 0u) { if (xb_ld(&bar[XB_TMO])) break; if (sp > XB_SPIN_CAP) { atomicAdd(&bar[XB_TMO], 1u); break; } }
    }
    nloc = mine > 0u ? mine : 1u; nx = cnt > 0u ? cnt : 1u;
}
__device__ __forceinline__ void xcd_barrier(const XcdBarrier& b, const int tid0) {
    asm volatile("s_waitcnt vmcnt(0)" ::: "memory");
    __syncthreads();
    if (tid0 == 0) {
        unsigned* bar = b.bar;
        __builtin_amdgcn_s_waitcnt(0);
        unsigned nloc = b.st[0], nx = b.st[1];
        if (nloc == 0u) { xcd_barrier_complete(bar, b.x, nloc, nx); b.st[0] = nloc; b.st[1] = nx; }
        const unsigned old = xb_add(&bar[XB_XSUB(b.x)], 1u);
        const unsigned gen = old / nloc;
        if (old + 1u == (gen + 1u) * nloc) {
            __builtin_amdgcn_fence(__ATOMIC_RELEASE, "agent");
            asm volatile("s_waitcnt vmcnt(0)" ::: "memory");
            const unsigned og = xb_add(&bar[XB_TOP], 1u);
            const unsigned tg = og / nx;
            if (og + 1u == (tg + 1u) * nx) xb_add(&bar[XB_TOPGEN], 1u);
            else XB_SPIN(xb_ld(&bar[XB_TOPGEN]) == tg, bar);
            __builtin_amdgcn_fence(__ATOMIC_ACQUIRE, "agent");
            xb_add(&bar[XB_XGEN(b.x)], 1u);
            asm volatile("s_waitcnt vmcnt(0)" ::: "memory");
        } else {
            XB_SPIN(xb_ld(&bar[XB_XGEN(b.x)]) == gen, bar);
            __builtin_amdgcn_fence(__ATOMIC_ACQUIRE, "agent");
            asm volatile("s_waitcnt vmcnt(0)" ::: "memory");
        }
    }
    __syncthreads();
}
}
namespace mk {
using pg8::Unit;
#define EPI_ROW(u, ai, m) ((u).pm * 256 + (ai) * 128 + wr * 64 + (m) * 16 + fr)
#define EPI_FOR_ROWS _Pragma("unroll") for (int ai = 0; ai < 2; ++ai) _Pragma("unroll") for (int m = 0; m < 4; ++m)
__device__ __forceinline__ bool epi_fence() { asm volatile("" ::: "memory"); return true; }

__device__ __forceinline__ float rstd_from16(const float* p) {
    const f32x4 a = *(const f32x4*)p, b = *(const f32x4*)(p + 4), c = *(const f32x4*)(p + 8), d = *(const f32x4*)(p + 12);
    const float s = (((a[0] + a[1]) + (a[2] + a[3])) + ((b[0] + b[1]) + (b[2] + b[3]))) + (((c[0] + c[1]) + (c[2] + c[3])) + ((d[0] + d[1]) + (d[2] + d[3])));
    return __builtin_amdgcn_rsqf(s * (1.0f / 1024.0f) + EPS);
}
__device__ __forceinline__ float rstd_from4(const float* p, float invn) {
    const f32x4 a = *(const f32x4*)p; return __builtin_amdgcn_rsqf(((a[0] + a[1]) + (a[2] + a[3])) * invn + EPS);
}
#define EPI_RSTD8(rsv, ssqp) do { f32x4 sq_[2][4]; \
    _Pragma("unroll") for (int ai = 0; ai < 2; ++ai) _Pragma("unroll") for (int m = 0; m < 4; ++m) sq_[ai][m] = *(const f32x4*)((ssqp) + (size_t)EPI_ROW(u, ai, m) * 16 + 4 * fq); \
    _Pragma("unroll") for (int ai = 0; ai < 2; ++ai) _Pragma("unroll") for (int m = 0; m < 4; ++m) { float s_ = (sq_[ai][m][0] + sq_[ai][m][1]) + (sq_[ai][m][2] + sq_[ai][m][3]); \
        s_ += __shfl_xor(s_, 16); s_ += __shfl_xor(s_, 32); rsv[ai][m] = __builtin_amdgcn_rsqf(s_ * (1.0f / 1024.0f) + EPS); } } while (0)
#define EPI_PRELOAD_RS(expr) float rsv[2][4]; _Pragma("unroll") for (int ai = 0; ai < 2; ++ai) _Pragma("unroll") for (int m = 0; m < 4; ++m) { const int row = EPI_ROW(u, ai, m); rsv[ai][m] = (expr); }
__device__ __forceinline__ float sumsq8(const f32x4& a, const f32x4& b) { return ((a[0] * a[0] + a[1] * a[1]) + (a[2] * a[2] + a[3] * a[3])) + ((b[0] * b[0] + b[1] * b[1]) + (b[2] * b[2] + b[3] * b[3])); }

struct EpiInProj {
    static constexpr bool PERM = true, AFTER_DRAIN = false, HAS_MID = false;
    unsigned char* ws;
    __device__ __forceinline__ void operator()(const f32x4 (&acc)[2][2][4][2], const Unit& u, int wr, int wc, int fr, int fq) const {
        const int pn = u.pn;
        const float* rstd0 = (const float*)(ws + WS_RSTD0); const float2* rope64 = (const float2*)(ws + WS_ROPE64); const float2* rope32 = (const float2*)(ws + WS_ROPE32);
        bf16_t* QA = (bf16_t*)(ws + WS_QA); bf16_t* KA = (bf16_t*)(ws + WS_KA); bf16_t* VA = (bf16_t*)(ws + WS_VA); bf16_t* LAT = (bf16_t*)(ws + WS_LAT); bf16_t* KR = (bf16_t*)(ws + WS_KR);
        bf16_t* GA = (bf16_t*)(ws + WS_GA); bf16_t* GB = (bf16_t*)(ws + WS_GB); float* ssq_cq = (float*)(ws + WS_SSQ_CQ); float* ssq_kv = (float*)(ws + WS_SSQ_KV); float* kmp = (float*)(ws + WS_KMP);
        if (pn < 4) {
            const bool isk = pn >= 2; bf16_t* dst = isk ? KA : QA; const float sc = isk ? 1.0f : C2A;
            const int e = (wc & 1) * 16 + fq * 4;
            float cs1[2][4], cs2[2][4];
#pragma unroll
            for (int bj = 0; bj < 2; ++bj)
#pragma unroll
                for (int i = 0; i < 4; ++i) { cs1[bj][i] = 0.f; cs2[bj][i] = 0.f; }
            EPI_PRELOAD_RS(rstd0[row])
#pragma unroll
            for (int ai = 0; ai < 2; ++ai) {
#pragma unroll
            for (int m = 0; m < 4; ++m) {
                const int row = EPI_ROW(u, ai, m); const float rs = rsv[ai][m]; const int t = row & (S - 1);
                const f32x4 ca = *(const f32x4*)(rope64 + t * 32 + e), cb = *(const f32x4*)(rope64 + t * 32 + e + 2);
                const float c[4] = {ca[0], ca[2], cb[0], cb[2]}, s[4] = {ca[1], ca[3], cb[1], cb[3]};
#pragma unroll
                for (int bj = 0; bj < 2; ++bj) {
                    const int head = 4 * (pn & 1) + 2 * bj + (wc >> 1);
                    f32x4 y1, y2;
#pragma unroll
                    for (int i = 0; i < 4; ++i) { const float x1 = acc[ai][bj][m][0][i] * rs, x2 = acc[ai][bj][m][1][i] * rs; y1[i] = x1 * c[i] - x2 * s[i]; y2[i] = x2 * c[i] + x1 * s[i]; }
                    if (isk) {
#pragma unroll
                        for (int i = 0; i < 4; ++i) { cs1[bj][i] += y1[i]; cs2[bj][i] += y2[i]; } }
                    bf16_t* p = dst + (size_t)row * 512 + head * 64 + e;
                    *(u32x2*)p = pack4(y1 * sc); *(u32x2*)(p + 32) = pack4(y2 * sc);
                }
            }
            }
            if (isk) {
#pragma unroll
                for (int bj = 0; bj < 2; ++bj)
#pragma unroll
                    for (int i = 0; i < 4; ++i) {
                        float a = cs1[bj][i], b = cs2[bj][i];
#pragma unroll
                        for (int o = 1; o < 16; o <<= 1) { a += __shfl_xor(a, o); b += __shfl_xor(b, o); }
                        cs1[bj][i] = a; cs2[bj][i] = b;
                    }
                if (fr == 0) {
#pragma unroll
                    for (int bj = 0; bj < 2; ++bj) { const int head = 4 * (pn & 1) + 2 * bj + (wc >> 1); float* p = kmp + (size_t)(u.pm * 2 + wr) * 512 + head * 64 + e;
                        *(f32x4*)p = (f32x4){cs1[bj][0], cs1[bj][1], cs1[bj][2], cs1[bj][3]}; *(f32x4*)(p + 32) = (f32x4){cs2[bj][0], cs2[bj][1], cs2[bj][2], cs2[bj][3]}; }
                }
            }
        } else if (pn < 6) {
            EPI_PRELOAD_RS(rstd0[row])
            EPI_FOR_ROWS { const int row = EPI_ROW(u, ai, m); const float rs = rsv[ai][m];
#pragma unroll
                for (int bj = 0; bj < 2; ++bj) *(u32x4*)(VA + (size_t)row * 512 + (pn - 4) * 256 + bj * 128 + wc * 32 + 8 * fq) = pack8(acc[ai][bj][m][0] * rs, acc[ai][bj][m][1] * rs); }
        } else if (pn < 8) {
            float* ssq = (pn == 6) ? ssq_cq : ssq_kv;
            EPI_PRELOAD_RS(rstd0[row])
#pragma unroll
            for (int ai = 0; ai < 2; ++ai) {
#pragma unroll
            for (int m = 0; m < 4; ++m) { const int row = EPI_ROW(u, ai, m); const float rs = rsv[ai][m];
                const f32x4 a0 = acc[ai][0][m][0] * rs, a1 = acc[ai][0][m][1] * rs, b0 = acc[ai][1][m][0] * rs, b1 = acc[ai][1][m][1] * rs;
                bf16_t* p = LAT + (size_t)row * 512 + (pn - 6) * 256 + wc * 32 + 8 * fq;
                *(u32x4*)p = pack8(a0, a1); *(u32x4*)(p + 128) = pack8(b0, b1);
                float q = sumsq8(a0, a1); if (pn == 6) q += sumsq8(b0, b1);
                q += __shfl_xor(q, 16); q += __shfl_xor(q, 32);
                if (fq == 0) ssq[(size_t)row * 4 + wc] = q;
                if (pn == 7 && wc == 0) {
                    const int t = row & (S - 1);
                    const f32x4 ca = *(const f32x4*)(rope32 + t * 16 + 4 * fq), cb = *(const f32x4*)(rope32 + t * 16 + 4 * fq + 2);
                    const float c[4] = {ca[0], ca[2], cb[0], cb[2]}, s[4] = {ca[1], ca[3], cb[1], cb[3]};
                    f32x4 y1, y2;
#pragma unroll
                    for (int i = 0; i < 4; ++i) { y1[i] = b0[i] * c[i] - b1[i] * s[i]; y2[i] = b1[i] * c[i] + b0[i] * s[i]; }
                    bf16_t* k = KR + (size_t)row * 32 + 4 * fq; *(u32x2*)k = pack4(y1); *(u32x2*)(k + 16) = pack4(y2);
                }
            }
            }
        } else {
            unsigned char* dst = (unsigned char*)((pn < 12) ? GA : GB) + ((pn - 8) & 3) * 256 + wc * 64 + fq * 16;
            EPI_PRELOAD_RS(rstd0[row])
            EPI_FOR_ROWS { const int row = EPI_ROW(u, ai, m); const float rs = rsv[ai][m];
                u32x4 w = {0u, 0u, 0u, 0u};
#pragma unroll
                for (int bj = 0; bj < 2; ++bj)
#pragma unroll
                    for (int n = 0; n < 2; ++n) { const f32x4 a = acc[ai][bj][m][n] * rs; unsigned q = 0u;
                        q = __builtin_amdgcn_cvt_pk_u8_f32(sigm(a[0]) * 255.0f, 0, q); q = __builtin_amdgcn_cvt_pk_u8_f32(sigm(a[1]) * 255.0f, 1, q);
                        q = __builtin_amdgcn_cvt_pk_u8_f32(sigm(a[2]) * 255.0f, 2, q); q = __builtin_amdgcn_cvt_pk_u8_f32(sigm(a[3]) * 255.0f, 3, q);
                        w[bj * 2 + n] = q; }
                *(u32x4*)(dst + (size_t)row * 1024) = w; }
        }
    }
};

struct EpiQb {
    static constexpr bool PERM = true, AFTER_DRAIN = false, HAS_MID = false;
    unsigned char* ws;
    __device__ __forceinline__ void operator()(const f32x4 (&acc)[2][2][4][2], const Unit& u, int wr, int wc, int fr, int fq) const {
        const float* ssq_cq = (const float*)(ws + WS_SSQ_CQ); const float2* rope32 = (const float2*)(ws + WS_ROPE32); bf16_t* QM = (bf16_t*)(ws + WS_QM);
        EPI_PRELOAD_RS(rstd_from4(ssq_cq + (size_t)row * 4, 1.0f / 256.0f) * C2B)
#pragma unroll
        for (int ai = 0; ai < 2; ++ai) {
#pragma unroll
        for (int m = 0; m < 4; ++m) { const int row = EPI_ROW(u, ai, m); const float rs = rsv[ai][m]; const int t = row & (S - 1);
#pragma unroll
            for (int bj = 0; bj < 2; ++bj) {
                const int G = u.pn * 8 + bj * 4 + wc, head = G / 3, part = G - head * 3;
                const f32x4 a = acc[ai][bj][m][0] * rs, b = acc[ai][bj][m][1] * rs;
                if (part < 2) *(u32x4*)(QM + (size_t)row * 768 + head * 96 + part * 32 + 8 * fq) = pack8(a, b);
                else {
                    const f32x4 ca = *(const f32x4*)(rope32 + t * 16 + 4 * fq), cb = *(const f32x4*)(rope32 + t * 16 + 4 * fq + 2);
                    const float c[4] = {ca[0], ca[2], cb[0], cb[2]}, s[4] = {ca[1], ca[3], cb[1], cb[3]};
                    f32x4 y1, y2;
#pragma unroll
                    for (int i = 0; i < 4; ++i) { y1[i] = a[i] * c[i] - b[i] * s[i]; y2[i] = b[i] * c[i] + a[i] * s[i]; }
                    bf16_t* p = QM + (size_t)row * 768 + head * 96 + 64 + 4 * fq; *(u32x2*)p = pack4(y1); *(u32x2*)(p + 16) = pack4(y2);
                }
            } }
        }
    }
};
struct EpiKvb {
    static constexpr bool PERM = true, AFTER_DRAIN = false, HAS_MID = false;
    unsigned char* ws;
    __device__ __forceinline__ void operator()(const f32x4 (&acc)[2][2][4][2], const Unit& u, int wr, int wc, int fr, int fq) const {
        const float* ssq_kv = (const float*)(ws + WS_SSQ_KV); const bf16_t* KR = (const bf16_t*)(ws + WS_KR); bf16_t* KM = (bf16_t*)(ws + WS_KM); bf16_t* VM = (bf16_t*)(ws + WS_VM);
        EPI_PRELOAD_RS(rstd_from4(ssq_kv + (size_t)row * 4, 1.0f / 128.0f))
        u32x4 krv[2][4];
        if (wc == 0) {
#pragma unroll
            for (int ai = 0; ai < 2; ++ai)
#pragma unroll
                for (int m = 0; m < 4; ++m) krv[ai][m] = *(const u32x4*)(KR + (size_t)EPI_ROW(u, ai, m) * 32 + 8 * fq); }
        EPI_FOR_ROWS { const int row = EPI_ROW(u, ai, m); const float rs = rsv[ai][m];
            u32x4 kr; if (wc == 0) kr = krv[ai][m];
#pragma unroll
            for (int bj = 0; bj < 2; ++bj) {
                const int head = u.pn * 2 + bj; const u32x4 w = pack8(acc[ai][bj][m][0] * rs, acc[ai][bj][m][1] * rs);
                if (wc < 2) *(u32x4*)(KM + (size_t)row * 768 + head * 96 + wc * 32 + 8 * fq) = w;
                else *(u32x4*)(VM + (size_t)row * 512 + head * 64 + (wc - 2) * 32 + 8 * fq) = w;
                if (wc == 0) *(u32x4*)(KM + (size_t)row * 768 + head * 96 + 64 + 8 * fq) = kr;
            } }
    }
};
struct EpiBranch {
    static constexpr bool PERM = true, AFTER_DRAIN = false, HAS_MID = true;
    const unsigned char* GA; const unsigned char* GB; bf16_t* MIX;
    static __device__ __forceinline__ f32x4 ub4(unsigned w) { return (f32x4){(float)(w & 255u), (float)((w >> 8) & 255u), (float)((w >> 16) & 255u), (float)(w >> 24)}; }
    static constexpr float TINY8 = 2.2117724e-16f;
    __device__ __forceinline__ void mid(f32x4 (&acc)[2][2][4][2], const Unit& u, int wr, int wc, int fr, int fq) const {
#pragma unroll
        for (int ai = 0; ai < 2; ++ai) {
        u32x4 ga[4], gb[4];
#pragma unroll
        for (int m = 0; m < 4; ++m) { const size_t off = (size_t)EPI_ROW(u, ai, m) * 1024 + u.pn * 256 + wc * 64 + fq * 16; ga[m] = *(const u32x4*)(GA + off); gb[m] = *(const u32x4*)(GB + off); }
#pragma unroll
        for (int m = 0; m < 4; ++m)
#pragma unroll
            for (int bj = 0; bj < 2; ++bj)
#pragma unroll
                for (int n = 0; n < 2; ++n) { const f32x4 av = ub4(ga[m][bj * 2 + n]), bv = ub4(gb[m][bj * 2 + n]);
#pragma unroll
                    for (int i = 0; i < 4; ++i) acc[ai][bj][m][n][i] *= av[i] * __builtin_amdgcn_rcpf(__builtin_fmaxf(bv[i], TINY8)); }
        asm volatile("" ::: "memory");
        }
    }
    __device__ __forceinline__ void operator()(f32x4 (&acc)[2][2][4][2], const Unit& u, int wr, int wc, int fr, int fq) const {
        if (u.sub == 0) { mid(acc, u, wr, wc, fr, fq); return; }
#pragma unroll
        for (int ai = 0; ai < 2; ++ai) {
        u32x4 gb[4];
#pragma unroll
        for (int m = 0; m < 4; ++m) gb[m] = *(const u32x4*)(GB + (size_t)EPI_ROW(u, ai, m) * 1024 + u.pn * 256 + wc * 64 + fq * 16);
#pragma unroll
        for (int m = 0; m < 4; ++m)
#pragma unroll
            for (int bj = 0; bj < 2; ++bj) { const size_t off = (size_t)EPI_ROW(u, ai, m) * 1024 + u.pn * 256 + bj * 128 + wc * 32 + 8 * fq;
                f32x4 g0 = ub4(gb[m][bj * 2]), g1 = ub4(gb[m][bj * 2 + 1]);
#pragma unroll
                for (int i = 0; i < 4; ++i) { g0[i] = __builtin_fmaxf(g0[i], TINY8) * (1.0f / 255.0f); g1[i] = __builtin_fmaxf(g1[i], TINY8) * (1.0f / 255.0f); }
                *(u32x4*)(MIX + off) = pack8(acc[ai][bj][m][0] * g0, acc[ai][bj][m][1] * g1); }
        }
    }
};
template <bool F32IN> struct EpiResidT {
    static constexpr bool PERM = true, AFTER_DRAIN = false, HAS_MID = false;
    const void* XI; bf16_t* XBo; float* ssq;
    __device__ __forceinline__ void operator()(const f32x4 (&acc)[2][2][4][2], const Unit& u, int wr, int wc, int fr, int fq) const {
#pragma unroll
        for (int ai = 0; ai < 2; ++ai) {
        f32x4 xr[4][2][2];
#pragma unroll
        for (int m = 0; m < 4; ++m)
#pragma unroll
            for (int bj = 0; bj < 2; ++bj) { const size_t off = (size_t)EPI_ROW(u, ai, m) * 1024 + u.pn * 256 + bj * 128 + wc * 32 + 8 * fq;
                if (F32IN) { xr[m][bj][0] = *(const f32x4*)((const float*)XI + off); xr[m][bj][1] = *(const f32x4*)((const float*)XI + off + 4); }
                else { const u32x4 g = *(const u32x4*)((const bf16_t*)XI + off); xr[m][bj][0] = (f32x4){bflo(g.x), bfhi(g.x), bflo(g.y), bfhi(g.y)}; xr[m][bj][1] = (f32x4){bflo(g.z), bfhi(g.z), bflo(g.w), bfhi(g.w)}; } }
#pragma unroll
        for (int m = 0; m < 4; ++m) { const int row = EPI_ROW(u, ai, m); float q = 0.f;
#pragma unroll
            for (int bj = 0; bj < 2; ++bj) { const size_t off = (size_t)row * 1024 + u.pn * 256 + bj * 128 + wc * 32 + 8 * fq;
                const f32x4 v0 = xr[m][bj][0] + acc[ai][bj][m][0], v1 = xr[m][bj][1] + acc[ai][bj][m][1];
                *(u32x4*)(XBo + off) = pack8(v0, v1); q += sumsq8(v0, v1); }
            q += __shfl_xor(q, 16); q += __shfl_xor(q, 32);
            if (fq == 0) ssq[(size_t)row * 16 + u.pn * 4 + wc] = q; }
        }
    }
};
template <int MODE  > struct EpiGateUpT {
    static constexpr bool PERM = true, AFTER_DRAIN = false, HAS_MID = false;
    const float* ssq; bf16_t* ACT;
    __device__ __forceinline__ void operator()(const f32x4 (&acc)[2][2][4][2], const Unit& u, int wr, int wc, int fr, int fq) const {
        if (MODE == 2) {
#pragma unroll
            for (int a = 0; a < 2; ++a)
#pragma unroll
                for (int b = 0; b < 2; ++b)
#pragma unroll
                    for (int m = 0; m < 4; ++m)
#pragma unroll
                        for (int n = 0; n < 2; ++n) asm volatile("" :: "v"(acc[a][b][m][n]));
            return; }
        float rsv[2][4];
        if (MODE == 3) {
#pragma unroll
            for (int ai = 0; ai < 2; ++ai)
#pragma unroll
                for (int m = 0; m < 4; ++m) { rsv[ai][m] = 1.0f + 0.001f * (float)(fr + m); asm volatile("" : "+v"(rsv[ai][m])); }
        } else {
        EPI_RSTD8(rsv, ssq);
        }
        EPI_FOR_ROWS { const int row = EPI_ROW(u, ai, m); const float rs = rsv[ai][m];
            f32x4 o0, o1;
#pragma unroll
            for (int n = 0; n < 2; ++n) {
                const f32x4 g4 = acc[ai][0][m][n], u4 = acc[ai][1][m][n]; const f32x4 t4 = g4 * (-LOG2E * rs);
                f32x4 d4 = {__builtin_amdgcn_exp2f(t4[0]), __builtin_amdgcn_exp2f(t4[1]), __builtin_amdgcn_exp2f(t4[2]), __builtin_amdgcn_exp2f(t4[3])};
                d4 = d4 + 1.0f;
                const f32x4 r4 = {__builtin_amdgcn_rcpf(d4[0]), __builtin_amdgcn_rcpf(d4[1]), __builtin_amdgcn_rcpf(d4[2]), __builtin_amdgcn_rcpf(d4[3])};
                const f32x4 o4 = (g4 * u4) * r4 * (rs * rs);
                if (n == 0) o0 = o4; else o1 = o4; }
            const u32x4 w = pack8(o0, o1);
            if (MODE == 0) *(u32x4*)(ACT + (size_t)row * DFF + u.pn * 128 + wc * 32 + 8 * fq) = w; else asm volatile("" :: "v"(w.x), "v"(w.y), "v"(w.z), "v"(w.w)); }
    }
};
typedef EpiGateUpT<0> EpiGateUp;
struct EpiPleA {
    static constexpr bool PERM = true, AFTER_DRAIN = false, HAS_MID = false;
    const float* ssq_in; unsigned char* S8;
    __device__ __forceinline__ void operator()(const f32x4 (&acc)[2][2][4][2], const Unit& u, int wr, int wc, int fr, int fq) const {
        float rsv8[2][4]; EPI_RSTD8(rsv8, ssq_in);
#pragma unroll
        for (int ai = 0; ai < 2; ++ai) {
#pragma unroll
            for (int m = 0; m < 4; ++m) { const int row = EPI_ROW(u, ai, m); const float rs = rsv8[ai][m]; u32x4 w = {0u, 0u, 0u, 0u};
#pragma unroll
                for (int bj = 0; bj < 2; ++bj)
#pragma unroll
                    for (int n = 0; n < 2; ++n) { const f32x4 a = acc[ai][bj][m][n] * rs; unsigned q = 0u;
                        q = __builtin_amdgcn_cvt_pk_u8_f32(sigm(a[0]) * 255.0f, 0, q); q = __builtin_amdgcn_cvt_pk_u8_f32(sigm(a[1]) * 255.0f, 1, q);
                        q = __builtin_amdgcn_cvt_pk_u8_f32(sigm(a[2]) * 255.0f, 2, q); q = __builtin_amdgcn_cvt_pk_u8_f32(sigm(a[3]) * 255.0f, 3, q);
                        w[bj * 2 + n] = q; }
                *(u32x4*)(S8 + (size_t)row * 1024 + u.pn * 256 + wc * 64 + fq * 16) = w; } }
    }
};
struct EpiPleB {
    static constexpr bool PERM = true, AFTER_DRAIN = false, HAS_MID = false;
    const unsigned char* S8; const bf16_t* XBi; float* OUT; const float* gain; float* xslot; unsigned* cnt; LAS unsigned char* xl;
    __device__ __forceinline__ void operator()(f32x4 (&acc)[2][2][4][2], const Unit& u, int wr, int wc, int fr, int fq) const {
        LAS float* P = (LAS float*)xl;
        LAS float* Sx = (LAS float*)(xl + 4096);
        const int wid = wr * 4 + wc, lane = fq * 16 + fr;
#pragma unroll
        for (int ai = 0; ai < 2; ++ai) {
#pragma unroll
        for (int mh = 0; mh < 2; ++mh) {
        u32x4 xg[2][2], sg[2];
#pragma unroll
        for (int mm = 0; mm < 2; ++mm) { const size_t r_ = (size_t)EPI_ROW(u, ai, mh * 2 + mm) * 1024; sg[mm] = *(const u32x4*)(S8 + r_ + u.pn * 256 + wc * 64 + fq * 16);
#pragma unroll
            for (int bj = 0; bj < 2; ++bj) xg[mm][bj] = *(const u32x4*)(XBi + r_ + u.pn * 256 + bj * 128 + wc * 32 + 8 * fq); }
#pragma unroll
        for (int mm = 0; mm < 2; ++mm) { const int m = mh * 2 + mm; float q = 0.f;
#pragma unroll
            for (int bj = 0; bj < 2; ++bj) { const u32x4 g = xg[mm][bj];
                f32x4 v0 = {bflo(g.x), bfhi(g.x), bflo(g.y), bfhi(g.y)}, v1 = {bflo(g.z), bfhi(g.z), bflo(g.w), bfhi(g.w)};
                const f32x4 s0 = EpiBranch::ub4(sg[mm][bj * 2]) * (1.0f / 255.0f), s1 = EpiBranch::ub4(sg[mm][bj * 2 + 1]) * (1.0f / 255.0f);
                v0 += s0 * acc[ai][bj][m][0]; v1 += s1 * acc[ai][bj][m][1];
                acc[ai][bj][m][0] = v0; acc[ai][bj][m][1] = v1; q += sumsq8(v0, v1); }
            q += __shfl_xor(q, 16); q += __shfl_xor(q, 32);
            if (fq == 0) P[(ai * 128 + wr * 64 + m * 16 + fr) * 4 + wc] = q; }
        }
        }
        asm volatile("s_waitcnt lgkmcnt(0)\n\ts_barrier" ::: "memory");
        const int row = wid * 32 + (lane & 31);
        if (lane < 32) { const float s4 = (P[row * 4 + 0] + P[row * 4 + 1]) + (P[row * 4 + 2] + P[row * 4 + 3]);
            __hip_atomic_store(xslot + ((size_t)(u.pm * 256 + row) * 4 + u.pn), s4, __ATOMIC_RELAXED, __HIP_MEMORY_SCOPE_AGENT); }
        asm volatile("s_waitcnt vmcnt(0)" ::: "memory");
        if (lane == 0) __hip_atomic_fetch_add(cnt + 64 * u.pm, 1u, __ATOMIC_RELAXED, __HIP_MEMORY_SCOPE_AGENT);
        if (wid == 0) { unsigned sp_ = 0;
            while ((unsigned)__builtin_amdgcn_readfirstlane(__hip_atomic_load(cnt + 64 * u.pm, __ATOMIC_RELAXED, __HIP_MEMORY_SCOPE_AGENT)) < 32u) { __builtin_amdgcn_s_sleep(2); if (++sp_ > (1u << 20)) break; }
            __builtin_amdgcn_fence(__ATOMIC_ACQUIRE, "agent"); }
        asm volatile("s_waitcnt vmcnt(0) lgkmcnt(0)\n\ts_barrier" ::: "memory");
        if (lane < 32) { const float* sl = xslot + (size_t)(u.pm * 256 + row) * 4; float tot = 0.f;
#pragma unroll
            for (int t = 0; t < 4; ++t) tot += __hip_atomic_load(sl + t, __ATOMIC_RELAXED, __HIP_MEMORY_SCOPE_AGENT);
            Sx[row] = __builtin_amdgcn_rsqf(tot * (1.0f / 1024.0f) + EPS); }
        asm volatile("s_waitcnt lgkmcnt(0)\n\ts_barrier" ::: "memory");
        f32x4 gv[2][2];
#pragma unroll
        for (int bj = 0; bj < 2; ++bj) { gv[bj][0] = *(const f32x4*)(gain + u.pn * 256 + bj * 128 + wc * 32 + 8 * fq); gv[bj][1] = *(const f32x4*)(gain + u.pn * 256 + bj * 128 + wc * 32 + 8 * fq + 4); }
        EPI_FOR_ROWS { const int row2 = EPI_ROW(u, ai, m); const float rs3 = Sx[ai * 128 + wr * 64 + m * 16 + fr];
#pragma unroll
            for (int bj = 0; bj < 2; ++bj) { const size_t off = (size_t)row2 * 1024 + u.pn * 256 + bj * 128 + wc * 32 + 8 * fq;
                *(f32x4*)(OUT + off) = acc[ai][bj][m][0] * rs3 * gv[bj][0]; *(f32x4*)(OUT + off + 4) = acc[ai][bj][m][1] * rs3 * gv[bj][1]; } }
        asm volatile("s_waitcnt lgkmcnt(0)\n\ts_barrier" ::: "memory");
    }
};
}
#define ATT_UNIT unit2
namespace mk { namespace att {
constexpr size_t moba_SC_PART = 0, moba_SC_ML = (size_t)T * 8 * 3 * 128;
#define SBAR() __builtin_amdgcn_sched_barrier(0)
#define MFMA32(a, b, c) __builtin_amdgcn_mfma_f32_32x32x16_bf16(a, b, c, 0, 0, 0)
#define MX3(a, b, c) __builtin_fmaxf(__builtin_fmaxf((a), (b)), (c))
__device__ __forceinline__ int crow(int r, int hi) { return (r & 3) + 8 * (r >> 2) + 4 * hi; }
__device__ __forceinline__ void glds16(const void* g, unsigned lds_base) {
    unsigned sv; asm volatile("s_mov_b32 %0, m0\n\ts_mov_b32 m0, %2\n\ts_nop 0\n\tglobal_load_lds_dwordx4 %1, off\n\ts_mov_b32 m0, %0" : "=&s"(sv) : "v"(g), "s"(lds_base) : "memory"); }
typedef float f32x2_t __attribute__((ext_vector_type(2))); typedef __bf16 bf16x2_t __attribute__((ext_vector_type(2)));
__device__ __forceinline__ unsigned cvtpk(float lo, float hi) { f32x2_t v = {lo, hi}; bf16x2_t b = __builtin_convertvector(v, bf16x2_t); return __builtin_bit_cast(unsigned, b); }
__device__ __forceinline__ float fadd_s(float a, float b) { float r; asm("v_add_f32_e32 %0, %1, %2" : "=v"(r) : "v"(a), "v"(b)); return r; }
__device__ __forceinline__ float fsub_s(float a, float b) { float r; asm("v_sub_f32_e32 %0, %1, %2" : "=v"(r) : "v"(a), "v"(b)); return r; }
__device__ __forceinline__ float rowmax(const f32x16& p0, const f32x16& p1) {
    float a = MX3(p0[0], p0[1], p1[0]), b = MX3(p0[2], p0[3], p1[1]); a = MX3(a, p1[2], p1[3]);
#pragma unroll
    for (int r = 4; r < 16; r += 4) { a = MX3(a, p0[r], p0[r + 1]); b = MX3(b, p0[r + 2], p0[r + 3]); a = MX3(a, p1[r], p1[r + 1]); b = MX3(b, p1[r + 2], p1[r + 3]); }
    float m = __builtin_fmaxf(a, b); auto rr = __builtin_amdgcn_permlane32_swap(__float_as_uint(m), __float_as_uint(m), false, false);
    return __builtin_fmaxf(__uint_as_float(rr[0]), __uint_as_float(rr[1])); }
__device__ __forceinline__ void cmask(f32x16& p0, f32x16& p1, int jb, int qrel, int hi) {
    const int kb = 64 * jb + 4 * hi;
#pragma unroll
    for (int r = 0; r < 16; ++r) { const int kv = kb + (r & 3) + 8 * (r >> 2); if (kv > qrel) p0[r] = -INFINITY; if (kv + 32 > qrel) p1[r] = -INFINITY; } }
typedef __attribute__((address_space(3))) const char* lds_cptr;
typedef short v4i16_t __attribute__((ext_vector_type(4)));
__device__ __forceinline__ bf16x8 ldsfrag(lds_cptr p) { return *(const __attribute__((address_space(3))) bf16x8*)(p); }
__device__ __forceinline__ void kload2(bf16x8* kf, lds_cptr kp, int j) { kf[2 * j] = ldsfrag(kp + j * 2048); kf[2 * j + 1] = ldsfrag(kp + j * 2048 + 512); }
__device__ __forceinline__ s16x4 vtr(lds_cptr p) { return __builtin_bit_cast(s16x4, __builtin_amdgcn_ds_read_tr16_b64_v4i16((__attribute__((address_space(3))) v4i16_t*)p)); }
__device__ __forceinline__ void pv(f32x16* o, int vb, bf16x8 pa0, bf16x8 pa1, bf16x8 pa2, bf16x8 pa3) {
#pragma unroll
    for (int d0 = 0; d0 < 2; ++d0) { s16x4 lo[4], hi[4];
#pragma unroll
        for (int ks = 0; ks < 4; ++ks) {
            asm volatile("ds_read_b64_tr_b16 %0,%1 offset:%c2" : "=&v"(lo[ks]) : "v"(vb), "i"(d0 * 4096 + ks * 1024) : "memory");
            asm volatile("ds_read_b64_tr_b16 %0,%1 offset:%c2" : "=&v"(hi[ks]) : "v"(vb), "i"(d0 * 4096 + ks * 1024 + 512) : "memory"); }
        asm volatile("s_waitcnt lgkmcnt(0)" ::: "memory"); SBAR();
#define PK(k) (bf16x8){lo[k][0], lo[k][1], lo[k][2], lo[k][3], hi[k][0], hi[k][1], hi[k][2], hi[k][3]}
        o[d0] = MFMA32(pa0, PK(0), o[d0]); o[d0] = MFMA32(pa1, PK(1), o[d0]); o[d0] = MFMA32(pa2, PK(2), o[d0]); o[d0] = MFMA32(pa3, PK(3), o[d0]);
#undef PK
    } }
struct TopSel { float v0, v1, v2; int i0, i1, i2;
    __device__ __forceinline__ void init() { v0 = v1 = v2 = -3e38f; i0 = i1 = i2 = 99; }
    __device__ __forceinline__ void ins(float v, int i) {
        const bool b0 = v > v0 || (v == v0 && i < i0), b1 = v > v1 || (v == v1 && i < i1), b2 = v > v2 || (v == v2 && i < i2);
        if (b0) { v2 = v1; i2 = i1; v1 = v0; i1 = i0; v0 = v; i0 = i; } else if (b1) { v2 = v1; i2 = i1; v1 = v; i1 = i; } else if (b2) { v2 = v; i2 = i; } }
    __device__ __forceinline__ void ins_up(float v, int i) {
        const bool b0 = v > v0, b1 = v > v1, b2 = v > v2;
        if (b0) { v2 = v1; i2 = i1; v1 = v0; i1 = i0; v0 = v; i0 = i; } else if (b1) { v2 = v1; i2 = i1; v1 = v; i1 = i; } else if (b2) { v2 = v; i2 = i; } }
};
template <int N> __device__ __forceinline__ void wait_bar() { asm volatile("s_waitcnt vmcnt(%0) lgkmcnt(0)\n\ts_barrier" :: "n"(N) : "memory"); }

constexpr int ATT_LDS_MAX = 4 * 8192 + 8 * 4096 + 4 * 8192 + NWAVES * 256 + NWAVES * 6144;
static_assert(ATT_LDS_MAX <= MISC_OFF, "attention LDS");

template <int DQK, bool MOBA, int THRL, int qp, int kp, int vp, int op, bool BAND = false>
__device__ __forceinline__ void unit2(int b, int h, int qb, const bf16_t* Q, int qo, const bf16_t* K, int ko, const bf16_t* V, int vo,
                                      bf16_t* O, int oo, const float* kmp, char* shm, const int tid0, const unsigned char* sc = nullptr) {
    constexpr int NKS = DQK / 16, SLOTK = 8192, SLOTV = 8192, SLOTR = 4096;
    constexpr int LDS_K = 0, LDS_KR = 4 * SLOTK, LDS_V = LDS_KR + ((DQK == 96) ? 8 * SLOTR : 0), LDS_WS = LDS_V + 4 * SLOTV, LDS_OST = LDS_WS + NWAVES * 256;
    int tid_ = tid0; asm volatile("" : "+v"(tid_));
    const int tid = tid_, lane = tid & 63, r32 = lane & 31, hi = lane >> 5; const int wid = __builtin_amdgcn_readfirstlane(tid >> 6);
    const bool two = (DQK == 96) && (wid >= 4);
    if (wid >= 4) __builtin_amdgcn_s_setprio(1);
    const long rowbase = (long)b * S; const int q0 = qb * 256;
    const bf16_t* Qw = Q + (rowbase + q0 + wid * 32) * qp + qo;
    const unsigned lds0 = (unsigned)(uintptr_t)shm;
    float* wsf = (float*)(shm + LDS_WS) + wid * 64;
    const long kv0 = rowbase + (BAND ? q0 : 0);
    const bf16_t* ksrc = K + (kv0 + lane) * kp + ko + wid * 8;
    const bf16_t* vsrc = V + (kv0 + 16 * (wid & 3) + (lane >> 2)) * vp + vo + (wid >> 2) * 32 + (lane & 3) * 8;
    const unsigned kdst = lds0 + LDS_K + wid * 1024, vdst = lds0 + LDS_V + wid * 1024, kdstr = lds0 + LDS_KR + (wid & 3) * 1024;
#define DMA_K(t, slot) do { if (DQK != 96 || two) { glds16(ksrc + (long)(t) * 64 * kp, (unsigned)__builtin_amdgcn_readfirstlane(kdst + (slot))); } \
        if (two) { glds16(ksrc + (long)(t) * 64 * kp - 32  , (unsigned)__builtin_amdgcn_readfirstlane(kdst - 4096 + (slot))); \
                   glds16(ksrc + (long)(t) * 64 * kp + 32  , (unsigned)__builtin_amdgcn_readfirstlane(kdstr + ((t) & 7) * SLOTR)); } } while (0)
#define DMA_V(t, slot) glds16(vsrc + (long)(t) * 64 * vp, (unsigned)__builtin_amdgcn_readfirstlane(vdst + (slot)))
#define WB_PRO() do { if (DQK != 96) wait_bar<3>(); else if (two) wait_bar<7>(); else wait_bar<1>(); } while (0)
#define WB_STD() do { if (DQK != 96) wait_bar<4>(); else if (two) wait_bar<8>(); else wait_bar<2>(); } while (0)
    const int vb0 = (int)(lds0 + LDS_V) + ((lane >> 4) & 1) * 32 + (lane & 3) * 8 + (4 * hi + ((lane & 15) >> 2)) * 64;
    const lds_cptr shm3 = (lds_cptr)shm; const lds_cptr kp0 = shm3 + LDS_K + hi * 1024 + r32 * 16; const lds_cptr vp0 = shm3 + LDS_V + ((lane >> 4) & 1) * 32 + (lane & 3) * 8 + (4 * hi + ((lane & 15) >> 2)) * 64;
    const lds_cptr qlds = shm3 + LDS_OST + wid * 6144 + lane * 16;
    const int NT = BAND ? 4 : (q0 + 256) / 64;
    bf16x8 kf[8];
    DMA_K(0, 0); DMA_V(0, 0); DMA_K(1, SLOTK);
    bf16x8 qr[NKS];
#pragma unroll
    for (int d0 = 0; d0 < NKS; ++d0) qr[d0] = *reinterpret_cast<const bf16x8*>(&Qw[(long)r32 * qp + d0 * 16 + hi * 8]);
    unsigned sel = 0u;
    if (MOBA && qb > 0) {
        f32x16 g = f32x16{};
        const float* kq0 = kmp + ((size_t)(b * 32 + r32) * 2) * 512 + h * 64 + hi * 8;
#pragma unroll
        for (int d0 = 0; d0 < 4; ++d0) {
            const f32x4 a0 = *(const f32x4*)(kq0 + d0 * 16), a1 = *(const f32x4*)(kq0 + d0 * 16 + 4), b0 = *(const f32x4*)(kq0 + 512 + d0 * 16), b1 = *(const f32x4*)(kq0 + 512 + d0 * 16 + 4);
            const f32x4 m0 = (a0 + b0) * (1.0f / 256.0f), m1 = (a1 + b1) * (1.0f / 256.0f);
            unsigned short hh[8], ll[8];
#pragma unroll
            for (int i = 0; i < 4; ++i) { hh[i] = (unsigned short)f2bf(m0[i]); ll[i] = (unsigned short)f2bf(m0[i] - bf2f(hh[i])); hh[4 + i] = (unsigned short)f2bf(m1[i]); ll[4 + i] = (unsigned short)f2bf(m1[i] - bf2f(hh[4 + i])); }
            const bf16x8 fh = {(short)hh[0], (short)hh[1], (short)hh[2], (short)hh[3], (short)hh[4], (short)hh[5], (short)hh[6], (short)hh[7]};
            const bf16x8 fl = {(short)ll[0], (short)ll[1], (short)ll[2], (short)ll[3], (short)ll[4], (short)ll[5], (short)ll[6], (short)ll[7]};
            g = MFMA32(fh, qr[d0], g); g = MFMA32(fl, qr[d0], g);
        }
        TopSel ts; ts.init();
#pragma unroll
        for (int r = 0; r < 16; ++r) { const int j = crow(r, hi); ts.ins(j < qb ? g[r] : -3e38f, j); }
        const float pv0 = __shfl_xor(ts.v0, 32), pv1 = __shfl_xor(ts.v1, 32), pv2 = __shfl_xor(ts.v2, 32);
        const int pi0 = __shfl_xor(ts.i0, 32), pi1 = __shfl_xor(ts.i1, 32), pi2 = __shfl_xor(ts.i2, 32);
        ts.ins(pv0, pi0); ts.ins(pv1, pi1); ts.ins(pv2, pi2);
        if (ts.v0 > -1e37f) sel |= 1u << (ts.i0 & 31); if (ts.v1 > -1e37f) sel |= 1u << (ts.i1 & 31); if (ts.v2 > -1e37f) sel |= 1u << (ts.i2 & 31);
    }
    if (MOBA) sel |= 1u << qb;
    {
#pragma unroll
        for (int d0 = 0; d0 < NKS; ++d0) *(__attribute__((address_space(3))) bf16x8*)(qlds + d0 * 1024) = qr[d0];
    }
#ifndef ATT_PARKQ
#define ATT_PARKQ (DQK == 96)
#endif
#ifndef ATT_QREG
#define ATT_QREG 5
#endif
#define QF(d0) (((ATT_PARKQ) && (d0) >= ATT_QREG) ? ldsfrag(qlds + (((d0) < NKS) ? (d0) : 0) * 1024) : qr[((d0) < NKS) ? (d0) : 0])
    constexpr bool NEGM = true;
    constexpr bool VLATE = false;
    float mhat = 0.f, l_reg = 0.f; f32x16 o[2]; o[0] = f32x16{}; o[1] = f32x16{};
    const float msk0 = (MOBA && !(sel & 1u)) ? -1e30f : 0.f;
    f32x16 negm;
#pragma unroll
    for (int r = 0; r < 16; ++r) negm[r] = msk0;
    asm volatile("" : "+v"(negm));
#define CINIT (NEGM ? negm : f32x16{})
#define SUBM(x) (NEGM ? (x) : ((x) - mhat))
#define CMASK(P0, P1, t) do { int jb_ = (t) - (NT - 4); if (jb_ >= 0) cmask(P0, P1, jb_, wid * 32 + r32, hi); } while (0)
#define SETBLK(t) do { if (MOBA && (((t) & 3) == 0)) { const float msk_ = ((sel >> ((t) >> 2)) & 1u) ? 0.f : -1e30f; \
        _Pragma("unroll") for (int r = 0; r < 16; ++r) negm[r] = msk_ - mhat; asm volatile("" : "+v"(negm)); } } while (0)
    bool resc = false;
#define RESC() do { if (resc) { asm volatile("s_waitcnt lgkmcnt(0)" ::: "memory"); \
        _Pragma("unroll") for (int d_ = 0; d_ < 2; ++d_) _Pragma("unroll") for (int r = 0; r < 16; ++r) o[d_][r] *= wsf[crow(r, hi)]; } } while (0)
    f32x16 pA0, pA1, pB0, pB1;
#define KSLOT(t) ((((t)) & 3) * SLOTK)
#define VSLOT(t) ((((t)) & 3) * SLOTV)
#define ROT() do { } while (0)
    DMA_K(2, 2 * SLOTK);
    WB_PRO();
    { lds_cptr kb = kp0;
#pragma unroll
      for (int d0 = 0; d0 < NKS; ++d0) { const int ko_ = (d0 < 4) ? d0 * 2048 : (LDS_KR - LDS_K) + (d0 - 4) * 2048; const bf16x8 k0 = ldsfrag(kb + ko_), k1 = ldsfrag(kb + ko_ + 512); const bf16x8 qf = QF(d0);
          if (d0 == 0) { pA0 = MFMA32(k0, qf, CINIT); pA1 = MFMA32(k1, qf, CINIT); } else { pA0 = MFMA32(k0, qf, pA0); pA1 = MFMA32(k1, qf, pA1); } } }
    asm volatile("s_nop 15\n\ts_nop 7" : "+v"(pA0), "+v"(pA1)); CMASK(pA0, pA1, 0);
    { const float rm = rowmax(pA0, pA1); const float dl = (rm > -1e29f) ? rm : 0.f; mhat = dl;
#pragma unroll
      for (int r = 0; r < 16; ++r) { pA0[r] = fsub_s(pA0[r], dl); pA1[r] = fsub_s(pA1[r], dl); }
      if (NEGM) {
#pragma unroll
          for (int r = 0; r < 16; ++r) negm[r] = msk0 - mhat;
          asm volatile("" : "+v"(negm)); }
#pragma unroll
      for (int r = 0; r < 16; ++r) { pA0[r] = __builtin_amdgcn_exp2f(pA0[r]); pA1[r] = __builtin_amdgcn_exp2f(pA1[r]); } }
    wait_bar<0>();
    DMA_K(3, 3 * SLOTK); DMA_V(1, SLOTV); if (4 < NT) { DMA_K(4, 0); } DMA_V(2, 2 * SLOTV);
#pragma unroll
    for (int j = 0; j < 4; ++j) kload2(kf, kp0 + SLOTK, j);
    wait_bar<63>();
    constexpr int NVS = VLATE ? 4 : 8;
    s16x4 vlo[NVS], vhi[NVS]; u32x4 pw0, pw1, pw2, pw3;
#define VS(i) (VLATE ? (((i) & 3) * 2 + (((i) >> 2) & 1)) & 3 : (i))
#define PKW(P, B) cvtpk(P[B], P[B + 1])
#define PAF(k) __builtin_bit_cast(bf16x8, pw##k)
#define VFR(i) (bf16x8){vlo[VS(i)][0], vlo[VS(i)][1], vlo[VS(i)][2], vlo[VS(i)][3], vhi[VS(i)][0], vhi[VS(i)][1], vhi[VS(i)][2], vhi[VS(i)][3]}
#define PIN(x) asm volatile("" : "+v"(x))
#define GAPA(MF, A0, A1, A2, A3, W0, W1, PW) do { MF; sacc += A0; sacc += A1; sacc += A2; sacc += A3; PIN(sacc); W0; W1; PIN(PW); SBAR(); } while (0)
#define EX(v) __builtin_amdgcn_exp2f(v)
#define GAPB(MF, X, B) do { MF; X[B] = EX(SUBM(X[B])); X[B + 1] = EX(SUBM(X[B + 1])); X[B + 2] = EX(SUBM(X[B + 2])); X[B + 3] = EX(SUBM(X[B + 3])); PIN(X); SBAR(); } while (0)
#define VRD(i) do { vlo[VS(i)] = vtr(vp_ + (((i) >> 2) * 4096 + ((i) & 3) * 1024)); vhi[VS(i)] = vtr(vp_ + (((i) >> 2) * 4096 + ((i) & 3) * 1024 + 512)); } while (0)
#define VRDA(i) do { if (!VLATE) { VRD(i); } } while (0)
#define VRDL(i) do { if (VLATE) { VRD(i); SBAR(); } } while (0)
#define KRD(G, j) do { if (G) { kload2(kf, kp0 + knx_, j); SBAR(); } } while (0)
#define STEP(C0, C1, P0, P1, t, GK, GV, GL) do { SBAR(); \
    const lds_cptr vp_ = vp0 + VSLOT((t) - 1); const int knx_ = KSLOT((t) + 1); \
    bf16x8 qa_ = QF(0); \
    VRD(0); SBAR(); float sacc = (P0[0] + P0[1]); \
    GAPA(C0 = MFMA32(kf[0], qa_, CINIT), P0[2], P0[3], P0[4], P0[5],     pw0[0] = PKW(P0, 0),  pw0[1] = PKW(P0, 2),  pw0); \
    bf16x8 qb_ = QF(1); \
    VRD(4); SBAR(); GAPA(C1 = MFMA32(kf[1], qa_, CINIT), P0[6], P0[7], P0[8], P0[9],     pw0[2] = PKW(P0, 4),  pw0[3] = PKW(P0, 6),  pw0); \
    VRD(1); SBAR(); GAPA(C0 = MFMA32(kf[2], qb_, C0),   P0[10], P0[11], P0[12], P0[13], pw1[0] = PKW(P0, 8),  pw1[1] = PKW(P0, 10), pw1); \
    qa_ = QF(2); \
    VRD(5); SBAR(); GAPA(C1 = MFMA32(kf[3], qb_, C1),   P0[14], P0[15], P1[0], P1[1],   pw1[2] = PKW(P0, 12), pw1[3] = PKW(P0, 14), pw1); \
    bf16x8 kr0_, kr1_, kr2_, kr3_; const lds_cptr krp_ = kp0 + (LDS_KR - LDS_K) + ((t) & 7) * SLOTR; \
    if (DQK == 96) { kr0_ = ldsfrag(krp_); kr1_ = ldsfrag(krp_ + 512); } \
    VRDA(2); SBAR(); GAPA(C0 = MFMA32(kf[4], qa_, C0),   P1[2], P1[3], P1[4], P1[5],     pw2[0] = PKW(P1, 0),  pw2[1] = PKW(P1, 2),  pw2); \
    qb_ = QF(3); \
    VRDA(6); SBAR(); GAPA(C1 = MFMA32(kf[5], qa_, C1),   P1[6], P1[7], P1[8], P1[9],     pw2[2] = PKW(P1, 4),  pw2[3] = PKW(P1, 6),  pw2); \
    if (DQK == 96) { kr2_ = ldsfrag(krp_ + 2048); kr3_ = ldsfrag(krp_ + 2048 + 512); } \
    VRDA(3); SBAR(); GAPA(C0 = MFMA32(kf[6], qb_, C0),   P1[10], P1[11], P1[12], P1[13], pw3[0] = PKW(P1, 8),  pw3[1] = PKW(P1, 10), pw3); \
    if (DQK == 96) qa_ = QF(4); \
    VRDA(7); SBAR(); GAPA(C1 = MFMA32(kf[7], qb_, C1),   P1[14], P1[15], 0.f, 0.f,       pw3[2] = PKW(P1, 12), pw3[3] = PKW(P1, 14), pw3); \
    if (DQK == 96) { \
        C0 = MFMA32(kr0_, qa_, C0); SBAR(); qb_ = QF(5); C1 = MFMA32(kr1_, qa_, C1); SBAR(); \
        C0 = MFMA32(kr2_, qb_, C0); SBAR(); C1 = MFMA32(kr3_, qb_, C1); SBAR(); } \
    l_reg += sacc; \
    if (GK) { DMA_K((t) + 4, KSLOT((t) + 4)); } if (GV) { DMA_V((t) + 2, VSLOT((t) + 2)); } \
    CMASK(C0, C1, t); \
    { float a = MX3(C0[0], C0[1], C1[0]), b_ = MX3(C0[2], C0[3], C1[1]); a = MX3(a, C1[2], C1[3]); \
      _Pragma("unroll") for (int r = 4; r < 16; r += 4) { a = MX3(a, C0[r], C0[r + 1]); b_ = MX3(b_, C0[r + 2], C0[r + 3]); a = MX3(a, C1[r], C1[r + 1]); b_ = MX3(b_, C1[r + 2], C1[r + 3]); } \
      float rm = __builtin_fmaxf(a, b_); { auto rr = __builtin_amdgcn_permlane32_swap(__float_as_uint(rm), __float_as_uint(rm), false, false); rm = __builtin_fmaxf(__uint_as_float(rr[0]), __uint_as_float(rr[1])); } \
      if (!NEGM) rm -= mhat; \
      resc = false; \
      if (__builtin_expect(__any(rm > (float)THRL), 0)) { const float dl = __builtin_fmaxf(rm, 0.f); mhat += dl; \
        if (NEGM) { _Pragma("unroll") for (int r = 0; r < 16; ++r) { C0[r] -= dl; C1[r] -= dl; } \
                    _Pragma("unroll") for (int r = 0; r < 16; ++r) negm[r] -= dl; asm volatile("" : "+v"(negm)); } \
        const float f = __builtin_amdgcn_exp2f(-dl); l_reg *= f; if (hi == 0) wsf[r32] = f; resc = true; } } \
    SBAR(); \
    GAPB(o[0] = MFMA32(PAF(0), VFR(0), o[0]), C0, 0);  VRDL(2); \
    GAPB(o[1] = MFMA32(PAF(0), VFR(4), o[1]), C0, 4);  VRDL(6); \
    KRD(GL, 0); GAPB(o[0] = MFMA32(PAF(1), VFR(1), o[0]), C0, 8);  VRDL(3); \
    KRD(GL, 1); GAPB(o[1] = MFMA32(PAF(1), VFR(5), o[1]), C0, 12); VRDL(7); \
    KRD(GL, 2); GAPB(o[0] = MFMA32(PAF(2), VFR(2), o[0]), C1, 0); \
    KRD(GL, 3); GAPB(o[1] = MFMA32(PAF(2), VFR(6), o[1]), C1, 4); \
    GAPB(o[0] = MFMA32(PAF(3), VFR(3), o[0]), C1, 8); \
    GAPB(o[1] = MFMA32(PAF(3), VFR(7), o[1]), C1, 12); \
    } while (0)
    int t = 1;
#undef CMASK
#define CMASK(P0, P1, t) do { } while (0)
    for (; t + 5 < NT; t += 2) {
        STEP(pB0, pB1, pA0, pA1, t, true, true, true);     WB_STD(); RESC(); ROT(); SETBLK(t + 1);
        STEP(pA0, pA1, pB0, pB1, t + 1, true, true, true); WB_STD(); RESC(); ROT();
    }
#undef CMASK
#define CMASK(P0, P1, t) do { int jb_ = (t) - (NT - 4); if (jb_ >= 0) cmask(P0, P1, jb_, wid * 32 + r32, hi); } while (0)
#define ENDW(tt) do { wait_bar<0>(); } while (0)
    for (; t + 1 < NT; t += 2) {
        STEP(pB0, pB1, pA0, pA1, t, (t + 4 < NT), (t + 2 < NT), (t + 1 < NT));       ENDW(t);     RESC(); ROT(); SETBLK(t + 1);
        STEP(pA0, pA1, pB0, pB1, t + 1, (t + 5 < NT), (t + 3 < NT), (t + 2 < NT));   ENDW(t + 1); RESC(); ROT();
    }
    STEP(pB0, pB1, pA0, pA1, NT - 1, false, false, false); RESC();
    { float sacc = pB0[0] + pB0[1];
#pragma unroll
      for (int r = 2; r < 16; ++r) sacc += pB0[r];
#pragma unroll
      for (int r = 0; r < 16; ++r) sacc += pB1[r];
      l_reg += sacc;
      pw0 = (u32x4){PKW(pB0, 0), PKW(pB0, 2), PKW(pB0, 4), PKW(pB0, 6)}; pw1 = (u32x4){PKW(pB0, 8), PKW(pB0, 10), PKW(pB0, 12), PKW(pB0, 14)};
      pw2 = (u32x4){PKW(pB1, 0), PKW(pB1, 2), PKW(pB1, 4), PKW(pB1, 6)}; pw3 = (u32x4){PKW(pB1, 8), PKW(pB1, 10), PKW(pB1, 12), PKW(pB1, 14)};
      SBAR(); pv(o, vb0 + VSLOT(NT - 1), PAF(0), PAF(1), PAF(2), PAF(3)); }
    { auto rr = __builtin_amdgcn_permlane32_swap(__float_as_uint(l_reg), __float_as_uint(l_reg), false, false); l_reg = __uint_as_float(rr[0]) + __uint_as_float(rr[1]); }
    if (hi == 0) { wsf[32 + r32] = l_reg; if (BAND) wsf[r32] = mhat; } asm volatile("s_waitcnt lgkmcnt(0)" ::: "memory");
    float rli[16];
#pragma unroll
    for (int r = 0; r < 16; ++r) rli[r] = __builtin_amdgcn_rcpf(wsf[32 + crow(r, hi)]);
    bf16_t* Ow = O + (rowbase + q0 + wid * 32) * op + oo;
    { bf16_t* stg = (bf16_t*)(shm + LDS_OST + wid * 6144);
#pragma unroll
      for (int r = 0; r < 16; ++r) { const int orow = crow(r, hi);
#pragma unroll
          for (int d0 = 0; d0 < 2; ++d0) stg[orow * 64 + d0 * 32 + r32] = (bf16_t)f2bf(o[d0][r] * rli[r]); }
      asm volatile("s_waitcnt lgkmcnt(0)" ::: "memory");
      if (!BAND) {
#pragma unroll
      for (int i = 0; i < 4; ++i) { const int row = i * 8 + (lane >> 3), ch = lane & 7; const u32x4 v = *(const u32x4*)(stg + row * 64 + ch * 8); *(u32x4*)(Ow + (long)row * op + ch * 8) = v; }
      } else {
      const bf16_t* PART = (const bf16_t*)(sc + moba_SC_PART); const float* ML = (const float*)(sc + moba_SC_ML);
      u32x4 pp[4][3]; f32x4 mlv[4]; float m2v[4], l2v[4];
#pragma unroll
      for (int i = 0; i < 4; ++i) { const int row = i * 8 + (lane >> 3), ch = lane & 7; const size_t th = (size_t)(rowbase + q0 + wid * 32 + row) * 8 + h;
          mlv[i] = *(const f32x4*)(ML + th * 8); m2v[i] = ML[th * 8 + 4]; l2v[i] = ML[th * 8 + 5];
#pragma unroll
          for (int k = 0; k < 3; ++k) pp[i][k] = *(const u32x4*)(PART + (th * 3 + k) * 64 + ch * 8); }
#pragma unroll
      for (int i = 0; i < 4; ++i) { const int row = i * 8 + (lane >> 3), ch = lane & 7;
          const u32x4 vb_ = *(const u32x4*)(stg + row * 64 + ch * 8); const float mb = wsf[row], lb = wsf[32 + row];
          const f32x4 ml01 = mlv[i]; const float m2 = m2v[i], l2 = l2v[i];
          const u32x4 p0 = pp[i][0], p1 = pp[i][1], p2 = pp[i][2];
          const float M = __builtin_fmaxf(__builtin_fmaxf(mb, ml01[0]), __builtin_fmaxf(ml01[2], m2));
          const float wb = lb * __builtin_amdgcn_exp2f(mb - M), w0 = ml01[1] * __builtin_amdgcn_exp2f(ml01[0] - M), w1 = ml01[3] * __builtin_amdgcn_exp2f(ml01[2] - M), w2 = l2 * __builtin_amdgcn_exp2f(m2 - M);
          const float inv = __builtin_amdgcn_rcpf((wb + w0) + (w1 + w2));
          const bool u0 = ml01[1] > 0.f, u1 = ml01[3] > 0.f, u2 = l2 > 0.f;
          unsigned ow[4];
#pragma unroll
          for (int c = 0; c < 4; ++c) { const unsigned xb = vb_[c], x0 = p0[c], x1 = p1[c], x2 = p2[c];
              float lo = wb * bflo(xb), hi_ = wb * bfhi(xb);
              if (u0) { lo += w0 * bflo(x0); hi_ += w0 * bfhi(x0); } if (u1) { lo += w1 * bflo(x1); hi_ += w1 * bfhi(x1); } if (u2) { lo += w2 * bflo(x2); hi_ += w2 * bfhi(x2); }
              ow[c] = pk2(lo * inv, hi_ * inv); }
          *(u32x4*)(Ow + (long)row * op + ch * 8) = (u32x4){ow[0], ow[1], ow[2], ow[3]}; } } }
    __builtin_amdgcn_s_setprio(0);
    asm volatile("s_waitcnt vmcnt(0) lgkmcnt(0)\n\ts_barrier" ::: "memory");
#undef DMA_K
#undef DMA_V
#undef WB_PRO
#undef WB_STD
#undef QF
#undef CINIT
#undef SUBM
#undef VS
#undef VRDA
#undef VRDL
#undef CMASK
#undef SETBLK
#undef RESC
#undef ROT
#undef PKW
#undef PAF
#undef VFR
#undef PIN
#undef GAPA
#undef EX
#undef GAPB
#undef VRD
#undef KRD
#undef STEP
#undef ENDW
#undef KSLOT
#undef VSLOT
}
} }
namespace mk { namespace moba {
using namespace att;
constexpr size_t SC_PART = 0;
constexpr size_t SC_ML = SC_PART + (size_t)T * 8 * 3 * 128;
constexpr size_t SC_LIST = SC_ML + (size_t)T * 8 * 32;
constexpr size_t SC_CNT = SC_LIST + (size_t)NB * 8 * 32 * 32 * 512;
constexpr size_t SC_END = SC_CNT + (size_t)NB * 8 * 32 * 32 * 4;
static_assert(SC_END <= (size_t)T * 1024 * 4, "MoBA scratch fits d_out");
static_assert(SC_PART == att::moba_SC_PART && SC_ML == att::moba_SC_ML, "scratch map shared with the band epilogue");
typedef unsigned short u16;

constexpr int S1_STRIDE = 256 + 32 * 256 * 2;
__device__ __forceinline__ void select_units4(int b, int h, int s, const bf16_t* QA, const float* kmp, unsigned char* sc, char* shm, const int tid0) {
    int tid_ = tid0; asm volatile("" : "+v"(tid_));
    const int tid = tid_, lane = tid & 63, r32 = lane & 31, hi = lane >> 5; const int wid = __builtin_amdgcn_readfirstlane(tid >> 6);
    const int bh = b * 8 + h;
    if (tid < 128) ((LAS unsigned*)(shm + (tid >> 5) * S1_STRIDE))[tid & 31] = 0u;
    bf16x8 fh[4], fl[4];
    { const float* kq0 = kmp + ((size_t)(b * 32 + r32) * 2) * 512 + h * 64 + hi * 8;
#pragma unroll
      for (int d0 = 0; d0 < 4; ++d0) {
          const f32x4 a0 = *(const f32x4*)(kq0 + d0 * 16), a1 = *(const f32x4*)(kq0 + d0 * 16 + 4), b0 = *(const f32x4*)(kq0 + 512 + d0 * 16), b1 = *(const f32x4*)(kq0 + 512 + d0 * 16 + 4);
          const f32x4 m0 = (a0 + b0) * (1.0f / 256.0f), m1 = (a1 + b1) * (1.0f / 256.0f);
          unsigned short hh[8], ll[8];
#pragma unroll
          for (int i = 0; i < 4; ++i) { hh[i] = (unsigned short)f2bf(m0[i]); ll[i] = (unsigned short)f2bf(m0[i] - bf2f(hh[i])); hh[4 + i] = (unsigned short)f2bf(m1[i]); ll[4 + i] = (unsigned short)f2bf(m1[i] - bf2f(hh[4 + i])); }
          fh[d0] = (bf16x8){(short)hh[0], (short)hh[1], (short)hh[2], (short)hh[3], (short)hh[4], (short)hh[5], (short)hh[6], (short)hh[7]};
          fl[d0] = (bf16x8){(short)ll[0], (short)ll[1], (short)ll[2], (short)ll[3], (short)ll[4], (short)ll[5], (short)ll[6], (short)ll[7]}; } }
    bf16x8 qr[4][4];
#pragma unroll
    for (int u = 0; u < 4; ++u) { const int qb = (u == 0) ? s : (u == 1) ? 15 - s : (u == 2) ? 16 + s : 31 - s; const bf16_t* Qw = QA + ((size_t)b * S + qb * 256 + wid * 32 + r32) * 512 + h * 64;
#pragma unroll
        for (int d0 = 0; d0 < 4; ++d0) qr[u][d0] = *reinterpret_cast<const bf16x8*>(Qw + d0 * 16 + hi * 8); }
    asm volatile("s_waitcnt lgkmcnt(0)\n\ts_barrier" ::: "memory");
#pragma unroll
    for (int u = 0; u < 4; ++u) { const int qb = (u == 0) ? s : (u == 1) ? 15 - s : (u == 2) ? 16 + s : 31 - s;
        LAS unsigned* cnt = (LAS unsigned*)(shm + u * S1_STRIDE); LAS u16* lst = (LAS u16*)(shm + u * S1_STRIDE + 256);
        const int q = qb * 256 + wid * 32 + r32;
        float* ML = (float*)(sc + SC_ML) + ((size_t)(b * S + q) * 8 + h) * 8;
        TopSel ts; ts.init();
        if (qb > 0) {
            f32x16 g = f32x16{};
#pragma unroll
            for (int d0 = 0; d0 < 4; ++d0) { g = MFMA32(fh[d0], qr[u][d0], g); g = MFMA32(fl[d0], qr[u][d0], g); }
#pragma unroll
            for (int r = 0; r < 16; ++r) { const int j = crow(r, hi); ts.ins_up(j < qb ? g[r] : -3e38f, j); }
            const float pv0 = __shfl_xor(ts.v0, 32), pv1 = __shfl_xor(ts.v1, 32), pv2 = __shfl_xor(ts.v2, 32);
            const int pi0 = __shfl_xor(ts.i0, 32), pi1 = __shfl_xor(ts.i1, 32), pi2 = __shfl_xor(ts.i2, 32);
            ts.ins(pv0, pi0); ts.ins(pv1, pi1); ts.ins(pv2, pi2);
        }
        if (hi == 0) {
            const float vv[3] = {ts.v0, ts.v1, ts.v2}; const int ii[3] = {ts.i0, ts.i1, ts.i2};
#pragma unroll
            for (int k = 0; k < 3; ++k) {
                if (vv[k] > -1e37f) { const int j = ii[k] & 31; const unsigned pos = __hip_atomic_fetch_add(cnt + j, 1u, __ATOMIC_RELAXED, __HIP_MEMORY_SCOPE_WORKGROUP); lst[j * 256 + pos] = (u16)(q | (k << 13)); }
                else { ML[2 * k] = -1e30f; ML[2 * k + 1] = 0.f; }
            }
        }
    }
    asm volatile("s_waitcnt lgkmcnt(0)\n\ts_barrier" ::: "memory");
    unsigned* CNT = (unsigned*)(sc + SC_CNT); u16* LIST = (u16*)(sc + SC_LIST);
#pragma unroll 1
    for (int u = 0; u < 4; ++u) { const int qb = (u == 0) ? s : (u == 1) ? 15 - s : (u == 2) ? 16 + s : 31 - s;
        LAS unsigned* cnt = (LAS unsigned*)(shm + u * S1_STRIDE); LAS u16* lst = (LAS u16*)(shm + u * S1_STRIDE + 256);
        for (int j = wid; j < qb; j += NWAVES) {
            const unsigned c = cnt[j];
            if (lane == 0) CNT[(bh * 32 + j) * 32 + qb] = c;
            u16* dst = LIST + ((size_t)(bh * 32 + j) * 32 + qb) * 256;
            for (unsigned i = lane; i < c; i += 64) dst[i] = lst[j * 256 + i];
        } }
    asm volatile("s_waitcnt vmcnt(0) lgkmcnt(0)\n\ts_barrier" ::: "memory");
}

constexpr int S2_K = 0, S2_V = 32768, S2_LIST = 65536, S2_WS = S2_LIST + 16384, S2_STG = S2_WS + NWAVES * 256, S2_QP = S2_STG + NWAVES * 4096  , S2_END = S2_QP + NWAVES * 4096;
static_assert(S2_END <= MISC_OFF, "S2 LDS");

template <int NZ, int THR>
__device__ __forceinline__ void s2_pass(int r, int N, int b, int h, long rowbase, const bf16_t* QA, LAS u16* listc, char* shm, float* wsf, bf16_t* stg, bf16_t* PART, float* ML, int lane, int r32, int hi) {
    bf16x8 qr[NZ][4]; int qiv[NZ], slv[NZ]; bool vav[NZ];
#pragma unroll
    for (int z = 0; z < NZ; ++z) { const int e = 32 * (r + z * NWAVES) + r32; vav[z] = e < N; const unsigned ent = vav[z] ? (unsigned)listc[e] : 0u; qiv[z] = ent & 0x1fff; slv[z] = ent >> 13;
        const bf16_t* Qw = QA + (rowbase + qiv[z]) * 512 + h * 64;
#pragma unroll
        for (int d0 = 0; d0 < 4; ++d0) qr[z][d0] = *reinterpret_cast<const bf16x8*>(Qw + d0 * 16 + hi * 8); }
    float mhat[NZ], l_reg[NZ]; f32x16 o[NZ][2];
#pragma unroll
    for (int z = 0; z < NZ; ++z) { mhat[z] = 0.f; l_reg[z] = 0.f; o[z][0] = f32x16{}; o[z][1] = f32x16{}; }
#pragma unroll 1
    for (int t = 0; t < 4; ++t) {
        f32x16 p[NZ][2];
        { const char* kb = shm + S2_K + t * 8192 + hi * 1024 + r32 * 16;
#pragma unroll
          for (int d0 = 0; d0 < 4; ++d0) { const bf16x8 k0 = *reinterpret_cast<const bf16x8*>(kb + d0 * 2048), k1 = *reinterpret_cast<const bf16x8*>(kb + d0 * 2048 + 512);
#pragma unroll
              for (int z = 0; z < NZ; ++z) {
                  if (d0 == 0) { p[z][0] = MFMA32(k0, qr[z][0], f32x16{}); p[z][1] = MFMA32(k1, qr[z][0], f32x16{}); } else { p[z][0] = MFMA32(k0, qr[z][d0], p[z][0]); p[z][1] = MFMA32(k1, qr[z][d0], p[z][1]); } } } }
        float rm[NZ]; bool any = false;
#pragma unroll
        for (int z = 0; z < NZ; ++z) { rm[z] = rowmax(p[z][0], p[z][1]) - mhat[z]; any = any || (rm[z] > (float)THR); }
        if (t == 0) {
#pragma unroll
            for (int z = 0; z < NZ; ++z) mhat[z] = rm[z];
        } else if (__builtin_expect(__any(any), 0)) {
#pragma unroll
            for (int z = 0; z < NZ; ++z) { const float dl = __builtin_fmaxf(rm[z], 0.f); mhat[z] += dl; const float f = __builtin_amdgcn_exp2f(-dl); l_reg[z] *= f;
                if (hi == 0) wsf[r32] = f; asm volatile("s_waitcnt lgkmcnt(0)" ::: "memory");
#pragma unroll
                for (int d_ = 0; d_ < 2; ++d_)
#pragma unroll
                    for (int rr = 0; rr < 16; ++rr) o[z][d_][rr] *= wsf[crow(rr, hi)];
                asm volatile("s_waitcnt lgkmcnt(0)" ::: "memory"); }
        }
        u32x4 pw[NZ][4]; float sa[NZ][4];
#pragma unroll
        for (int z = 0; z < NZ; ++z) { sa[z][0] = 0.f; sa[z][1] = 0.f; sa[z][2] = 0.f; sa[z][3] = 0.f; }
#pragma unroll
        for (int rr = 0; rr < 16; ++rr)
#pragma unroll
            for (int z = 0; z < NZ; ++z) { const float mh = mhat[z]; p[z][0][rr] = __builtin_amdgcn_exp2f(p[z][0][rr] - mh); p[z][1][rr] = __builtin_amdgcn_exp2f(p[z][1][rr] - mh); sa[z][rr & 3] += p[z][0][rr] + p[z][1][rr]; }
#pragma unroll
        for (int z = 0; z < NZ; ++z) { l_reg[z] += (sa[z][0] + sa[z][1]) + (sa[z][2] + sa[z][3]);
            pw[z][0] = (u32x4){cvtpk(p[z][0][0], p[z][0][1]), cvtpk(p[z][0][2], p[z][0][3]), cvtpk(p[z][0][4], p[z][0][5]), cvtpk(p[z][0][6], p[z][0][7])};
            pw[z][1] = (u32x4){cvtpk(p[z][0][8], p[z][0][9]), cvtpk(p[z][0][10], p[z][0][11]), cvtpk(p[z][0][12], p[z][0][13]), cvtpk(p[z][0][14], p[z][0][15])};
            pw[z][2] = (u32x4){cvtpk(p[z][1][0], p[z][1][1]), cvtpk(p[z][1][2], p[z][1][3]), cvtpk(p[z][1][4], p[z][1][5]), cvtpk(p[z][1][6], p[z][1][7])};
            pw[z][3] = (u32x4){cvtpk(p[z][1][8], p[z][1][9]), cvtpk(p[z][1][10], p[z][1][11]), cvtpk(p[z][1][12], p[z][1][13]), cvtpk(p[z][1][14], p[z][1][15])}; }
        { const lds_cptr vp_ = (lds_cptr)shm + S2_V + t * 8192 + ((lane >> 4) & 1) * 32 + (lane & 3) * 8 + (4 * hi + ((lane & 15) >> 2)) * 64;
#pragma unroll
          for (int d0 = 0; d0 < 2; ++d0)
#pragma unroll
              for (int ks = 0; ks < 4; ++ks) { const s16x4 lo = vtr(vp_ + d0 * 4096 + ks * 1024), hh = vtr(vp_ + d0 * 4096 + ks * 1024 + 512);
                  const bf16x8 vf = {lo[0], lo[1], lo[2], lo[3], hh[0], hh[1], hh[2], hh[3]};
#pragma unroll
                  for (int z = 0; z < NZ; ++z) o[z][d0] = MFMA32(__builtin_bit_cast(bf16x8, pw[z][ks]), vf, o[z][d0]); } }
    }
#pragma unroll
    for (int z = 0; z < NZ; ++z) {
        float lz = l_reg[z];
        { auto rr = __builtin_amdgcn_permlane32_swap(__float_as_uint(lz), __float_as_uint(lz), false, false); lz = __uint_as_float(rr[0]) + __uint_as_float(rr[1]); }
        if (hi == 0) wsf[32 + r32] = lz; asm volatile("s_waitcnt lgkmcnt(0)" ::: "memory");
        float rli[16];
#pragma unroll
        for (int rr = 0; rr < 16; ++rr) rli[rr] = __builtin_amdgcn_rcpf(wsf[32 + crow(rr, hi)]);
#pragma unroll
        for (int rr = 0; rr < 16; ++rr) { const int orow = crow(rr, hi);
#pragma unroll
            for (int d0 = 0; d0 < 2; ++d0) stg[orow * 64 + d0 * 32 + r32] = (bf16_t)f2bf(o[z][d0][rr] * rli[rr]); }
        if (hi == 0 && vav[z]) { float* mlp = ML + ((size_t)(rowbase + qiv[z]) * 8 + h) * 8 + 2 * slv[z]; mlp[0] = mhat[z]; mlp[1] = lz; }
        asm volatile("s_waitcnt lgkmcnt(0)" ::: "memory");
#pragma unroll
        for (int i = 0; i < 4; ++i) { const int row = i * 8 + (lane >> 3), ch = lane & 7; const int e2 = 32 * (r + z * NWAVES) + row;
            if (e2 < N) { const unsigned en = (unsigned)listc[e2]; const int q2 = en & 0x1fff, s2 = en >> 13;
                *(u32x4*)(PART + (((size_t)(rowbase + q2) * 8 + h) * 3 + s2) * 64 + ch * 8) = *(const u32x4*)(stg + row * 64 + ch * 8); } }
        asm volatile("s_waitcnt lgkmcnt(0)" ::: "memory");
    }
}

template <int THRL>
__device__ __forceinline__ void s2_chain(int N, int ntile, int wid, int h, long rowbase, const bf16_t* QA, LAS u16* listc, char* shm, float* wsf, bf16_t* stg, bf16_t* PART, float* ML, int lane, int r32, int hi) {
    if (wid >= ntile) return;
    const lds_cptr shm3 = (lds_cptr)shm; const lds_cptr kp0 = shm3 + S2_K + hi * 1024 + r32 * 16;
    const lds_cptr vp0 = shm3 + S2_V + ((lane >> 4) & 1) * 32 + (lane & 3) * 8 + (4 * hi + ((lane & 15) >> 2)) * 64;
    const int vb0 = (int)((unsigned)(uintptr_t)shm + S2_V) + ((lane >> 4) & 1) * 32 + (lane & 3) * 8 + (4 * hi + ((lane & 15) >> 2)) * 64;
    bf16x8 kf[8], qr[4]; f32x16 o[2], negm, pA0, pA1, pB0, pB1; s16x4 vlo[8], vhi[8]; u32x4 pw0, pw1, pw2, pw3;
    float mhat = 0.f, l_reg = 0.f; bool resc = false;
    int r = wid; unsigned ent, entn = 0u;
    const unsigned qpd = (unsigned)(uintptr_t)shm + S2_QP + wid * 4096; const lds_cptr qpr = shm3 + S2_QP + wid * 4096 + lane * 16;
#define S2C_DMAQ(R_, E_) do { const int e_ = 32 * (R_) + r32; E_ = (e_ < N) ? (0x8000u | (unsigned)listc[e_]) : 0u; const bf16_t* Qw_ = QA + (rowbase + ((E_) & 0x1fff)) * 512 + h * 64 + hi * 8; \
        _Pragma("unroll") for (int d0 = 0; d0 < 4; ++d0) glds16(Qw_ + d0 * 16, (unsigned)__builtin_amdgcn_readfirstlane(qpd + d0 * 1024)); } while (0)
#define S2C_TAKEQ() do { asm volatile("s_waitcnt vmcnt(0)" ::: "memory"); _Pragma("unroll") for (int d0 = 0; d0 < 4; ++d0) qr[d0] = ldsfrag(qpr + d0 * 1024); } while (0)
#define S2C_FINAL(R_, E_, MH_) do { float lz = l_reg; \
        { auto rr = __builtin_amdgcn_permlane32_swap(__float_as_uint(lz), __float_as_uint(lz), false, false); lz = __uint_as_float(rr[0]) + __uint_as_float(rr[1]); } \
        if (hi == 0) wsf[32 + r32] = lz; asm volatile("s_waitcnt lgkmcnt(0)" ::: "memory"); \
        float rli[16]; _Pragma("unroll") for (int rr = 0; rr < 16; ++rr) rli[rr] = __builtin_amdgcn_rcpf(wsf[32 + crow(rr, hi)]); \
        _Pragma("unroll") for (int rr = 0; rr < 16; ++rr) { const int orow = crow(rr, hi); _Pragma("unroll") for (int d0 = 0; d0 < 2; ++d0) stg[orow * 64 + d0 * 32 + r32] = (bf16_t)f2bf(o[d0][rr] * rli[rr]); } \
        if (hi == 0 && ((E_) & 0x8000u)) { float* mlp = ML + ((size_t)(rowbase + ((E_) & 0x1fff)) * 8 + h) * 8 + 2 * (((E_) >> 13) & 3); mlp[0] = (MH_); mlp[1] = lz; } \
        asm volatile("s_waitcnt lgkmcnt(0)" ::: "memory"); \
        _Pragma("unroll") for (int i = 0; i < 4; ++i) { const int row = i * 8 + (lane >> 3), ch = lane & 7; const int e2 = 32 * (R_) + row; \
            if (e2 < N) { const unsigned en = (unsigned)listc[e2]; const int q2 = en & 0x1fff, s2 = en >> 13; \
                *(u32x4*)(PART + (((size_t)(rowbase + q2) * 8 + h) * 3 + s2) * 64 + ch * 8) = *(const u32x4*)(stg + row * 64 + ch * 8); } } \
        asm volatile("s_waitcnt lgkmcnt(0)" ::: "memory"); } while (0)
#define S2C_PKW(P, B) cvtpk(P[B], P[B + 1])
#define S2C_PAF(k) __builtin_bit_cast(bf16x8, pw##k)
#define S2C_VFR(i) (bf16x8){vlo[i][0], vlo[i][1], vlo[i][2], vlo[i][3], vhi[i][0], vhi[i][1], vhi[i][2], vhi[i][3]}
#define S2C_PIN(x) asm volatile("" : "+v"(x))
#define S2C_GAPA(MF, A0, A1, A2, A3, W0, W1, PW) do { MF; sacc += A0; sacc += A1; sacc += A2; sacc += A3; S2C_PIN(sacc); W0; W1; S2C_PIN(PW); SBAR(); } while (0)
#define S2C_EX(v) __builtin_amdgcn_exp2f(v)
#define S2C_GAPB(MF, X, B) do { MF; X[B] = S2C_EX(X[B]); X[B + 1] = S2C_EX(X[B + 1]); X[B + 2] = S2C_EX(X[B + 2]); X[B + 3] = S2C_EX(X[B + 3]); S2C_PIN(X); SBAR(); } while (0)
#define S2C_VRD(i) do { vlo[i] = vtr(vp_ + (((i) >> 2) * 4096 + ((i) & 3) * 1024)); vhi[i] = vtr(vp_ + (((i) >> 2) * 4096 + ((i) & 3) * 1024 + 512)); } while (0)
#define S2C_KRD(j) do { kload2(kf, kp0 + KN_, j); SBAR(); } while (0)
#define S2C_STEP(C0, C1, P0, P1, T_, BND) do { SBAR(); \
    const lds_cptr vp_ = vp0 + (((T_) + 3) & 3) * 8192; constexpr int KN_ = (((T_) + 1) & 3) * 8192; \
    S2C_VRD(0); SBAR(); float sacc = (P0[0] + P0[1]); \
    S2C_GAPA(C0 = MFMA32(kf[0], qr[0], negm), P0[2], P0[3], P0[4], P0[5],     pw0[0] = S2C_PKW(P0, 0),  pw0[1] = S2C_PKW(P0, 2),  pw0); \
    S2C_VRD(4); SBAR(); S2C_GAPA(C1 = MFMA32(kf[1], qr[0], negm), P0[6], P0[7], P0[8], P0[9],     pw0[2] = S2C_PKW(P0, 4),  pw0[3] = S2C_PKW(P0, 6),  pw0); \
    S2C_VRD(1); SBAR(); S2C_GAPA(C0 = MFMA32(kf[2], qr[1], C0),   P0[10], P0[11], P0[12], P0[13], pw1[0] = S2C_PKW(P0, 8),  pw1[1] = S2C_PKW(P0, 10), pw1); \
    S2C_VRD(5); SBAR(); S2C_GAPA(C1 = MFMA32(kf[3], qr[1], C1),   P0[14], P0[15], P1[0], P1[1],   pw1[2] = S2C_PKW(P0, 12), pw1[3] = S2C_PKW(P0, 14), pw1); \
    S2C_VRD(2); SBAR(); S2C_GAPA(C0 = MFMA32(kf[4], qr[2], C0),   P1[2], P1[3], P1[4], P1[5],     pw2[0] = S2C_PKW(P1, 0),  pw2[1] = S2C_PKW(P1, 2),  pw2); \
    S2C_VRD(6); SBAR(); S2C_GAPA(C1 = MFMA32(kf[5], qr[2], C1),   P1[6], P1[7], P1[8], P1[9],     pw2[2] = S2C_PKW(P1, 4),  pw2[3] = S2C_PKW(P1, 6),  pw2); \
    S2C_VRD(3); SBAR(); S2C_GAPA(C0 = MFMA32(kf[6], qr[3], C0),   P1[10], P1[11], P1[12], P1[13], pw3[0] = S2C_PKW(P1, 8),  pw3[1] = S2C_PKW(P1, 10), pw3); \
    S2C_VRD(7); SBAR(); S2C_GAPA(C1 = MFMA32(kf[7], qr[3], C1),   P1[14], P1[15], 0.f, 0.f,       pw3[2] = S2C_PKW(P1, 12), pw3[3] = S2C_PKW(P1, 14), pw3); \
    l_reg += sacc; \
    { float a = MX3(C0[0], C0[1], C1[0]), b_ = MX3(C0[2], C0[3], C1[1]); a = MX3(a, C1[2], C1[3]); \
      _Pragma("unroll") for (int rr = 4; rr < 16; rr += 4) { a = MX3(a, C0[rr], C0[rr + 1]); b_ = MX3(b_, C0[rr + 2], C0[rr + 3]); a = MX3(a, C1[rr], C1[rr + 1]); b_ = MX3(b_, C1[rr + 2], C1[rr + 3]); } \
      float rm = __builtin_fmaxf(a, b_); { auto rr = __builtin_amdgcn_permlane32_swap(__float_as_uint(rm), __float_as_uint(rm), false, false); rm = __builtin_fmaxf(__uint_as_float(rr[0]), __uint_as_float(rr[1])); } \
      resc = false; \
      if (BND) { mhat = rm;                                             \
        _Pragma("unroll") for (int rr = 0; rr < 16; ++rr) { C0[rr] -= rm; C1[rr] -= rm; } \
        _Pragma("unroll") for (int rr = 0; rr < 16; ++rr) negm[rr] = -rm; asm volatile("" : "+v"(negm)); } \
      else if (__builtin_expect(__any(rm > (float)THRL), 0)) { const float dl = __builtin_fmaxf(rm, 0.f); mhat += dl; \
        _Pragma("unroll") for (int rr = 0; rr < 16; ++rr) { C0[rr] -= dl; C1[rr] -= dl; } \
        _Pragma("unroll") for (int rr = 0; rr < 16; ++rr) negm[rr] -= dl; asm volatile("" : "+v"(negm)); \
        const float f = __builtin_amdgcn_exp2f(-dl); l_reg *= f; if (hi == 0) wsf[r32] = f; resc = true; } } \
    SBAR(); \
    S2C_GAPB(o[0] = MFMA32(S2C_PAF(0), S2C_VFR(0), o[0]), C0, 0); \
    S2C_GAPB(o[1] = MFMA32(S2C_PAF(0), S2C_VFR(4), o[1]), C0, 4); \
    S2C_KRD(0); S2C_GAPB(o[0] = MFMA32(S2C_PAF(1), S2C_VFR(1), o[0]), C0, 8); \
    S2C_KRD(1); S2C_GAPB(o[1] = MFMA32(S2C_PAF(1), S2C_VFR(5), o[1]), C0, 12); \
    S2C_KRD(2); S2C_GAPB(o[0] = MFMA32(S2C_PAF(2), S2C_VFR(2), o[0]), C1, 0); \
    S2C_KRD(3); S2C_GAPB(o[1] = MFMA32(S2C_PAF(2), S2C_VFR(6), o[1]), C1, 4); \
    S2C_GAPB(o[0] = MFMA32(S2C_PAF(3), S2C_VFR(3), o[0]), C1, 8); \
    S2C_GAPB(o[1] = MFMA32(S2C_PAF(3), S2C_VFR(7), o[1]), C1, 12); \
    } while (0)
#define S2C_RESC() do { if (resc) { asm volatile("s_waitcnt lgkmcnt(0)" ::: "memory"); \
        _Pragma("unroll") for (int d_ = 0; d_ < 2; ++d_) _Pragma("unroll") for (int rr = 0; rr < 16; ++rr) o[d_][rr] *= wsf[crow(rr, hi)]; } } while (0)
    S2C_DMAQ(r, ent); S2C_TAKEQ();
    o[0] = f32x16{}; o[1] = f32x16{};
#pragma unroll
    for (int rr = 0; rr < 16; ++rr) negm[rr] = 0.f;
    asm volatile("" : "+v"(negm));
    {
#pragma unroll
      for (int d0 = 0; d0 < 4; ++d0) { const bf16x8 k0 = ldsfrag(kp0 + d0 * 2048), k1 = ldsfrag(kp0 + d0 * 2048 + 512);
          if (d0 == 0) { pA0 = MFMA32(k0, qr[0], negm); pA1 = MFMA32(k1, qr[0], negm); } else { pA0 = MFMA32(k0, qr[d0], pA0); pA1 = MFMA32(k1, qr[d0], pA1); } } }
    { const float rm = rowmax(pA0, pA1); mhat = rm;
#pragma unroll
      for (int rr = 0; rr < 16; ++rr) { pA0[rr] -= rm; pA1[rr] -= rm; negm[rr] = -rm; }
      asm volatile("" : "+v"(negm));
#pragma unroll
      for (int rr = 0; rr < 16; ++rr) { pA0[rr] = __builtin_amdgcn_exp2f(pA0[rr]); pA1[rr] = __builtin_amdgcn_exp2f(pA1[rr]); } }
#pragma unroll
    for (int j = 0; j < 4; ++j) kload2(kf, kp0 + 8192, j);
    for (;;) {
        S2C_STEP(pB0, pB1, pA0, pA1, 1, false); S2C_RESC();
        const int rn = r + NWAVES; const bool more = rn < ntile;
        if (more) S2C_DMAQ(rn, entn);
        S2C_STEP(pA0, pA1, pB0, pB1, 2, false); S2C_RESC();
        S2C_STEP(pB0, pB1, pA0, pA1, 3, false); S2C_RESC();
        if (!more) break;
        S2C_TAKEQ();
#pragma unroll
        for (int rr = 0; rr < 16; ++rr) negm[rr] = 0.f;
        asm volatile("" : "+v"(negm));
        const float mh_old = mhat;
        S2C_STEP(pA0, pA1, pB0, pB1, 0, true);
        S2C_FINAL(r, ent, mh_old);
        o[0] = f32x16{}; o[1] = f32x16{}; l_reg = 0.f;
        r = rn; ent = entn;
    }
    { float sacc = pB0[0] + pB0[1];
#pragma unroll
      for (int rr = 2; rr < 16; ++rr) sacc += pB0[rr];
#pragma unroll
      for (int rr = 0; rr < 16; ++rr) sacc += pB1[rr];
      l_reg += sacc;
      pw0 = (u32x4){S2C_PKW(pB0, 0), S2C_PKW(pB0, 2), S2C_PKW(pB0, 4), S2C_PKW(pB0, 6)}; pw1 = (u32x4){S2C_PKW(pB0, 8), S2C_PKW(pB0, 10), S2C_PKW(pB0, 12), S2C_PKW(pB0, 14)};
      pw2 = (u32x4){S2C_PKW(pB1, 0), S2C_PKW(pB1, 2), S2C_PKW(pB1, 4), S2C_PKW(pB1, 6)}; pw3 = (u32x4){S2C_PKW(pB1, 8), S2C_PKW(pB1, 10), S2C_PKW(pB1, 12), S2C_PKW(pB1, 14)};
      SBAR(); pv(o, vb0 + 3 * 8192, S2C_PAF(0), S2C_PAF(1), S2C_PAF(2), S2C_PAF(3)); }
    S2C_FINAL(r, ent, mhat);
#undef S2C_DMAQ
#undef S2C_TAKEQ
#undef S2C_FINAL
#undef S2C_PKW
#undef S2C_PAF
#undef S2C_VFR
#undef S2C_PIN
#undef S2C_GAPA
#undef S2C_EX
#undef S2C_GAPB
#undef S2C_VRD
#undef S2C_KRD
#undef S2C_STEP
#undef S2C_RESC
}


__device__ __forceinline__ void merge_block(int b, int h, int qb, bf16_t* MO, const unsigned char* sc, const bf16_t* PARTO, const int tid0) {
    int tid_ = tid0; asm volatile("" : "+v"(tid_));
    const int tid = tid_, lane = tid & 63; const int wid = __builtin_amdgcn_readfirstlane(tid >> 6);
    const bf16_t* PART = (const bf16_t*)(sc + SC_PART); const float* ML = (const float*)(sc + SC_ML);
    const long row0 = (long)b * S + qb * 256 + wid * 32;
    u32x4 pp[4][4]; f32x4 mla[4], mlb[4];
#pragma unroll
    for (int i = 0; i < 4; ++i) { const int row = i * 8 + (lane >> 3), ch = lane & 7; const size_t th = (size_t)(row0 + row) * 8 + h;
        mla[i] = *(const f32x4*)(ML + th * 8); mlb[i] = *(const f32x4*)(ML + th * 8 + 4);
#pragma unroll
        for (int k = 0; k < 3; ++k) pp[i][k] = *(const u32x4*)(PART + (th * 3 + k) * 64 + ch * 8);
        pp[i][3] = *(const u32x4*)(PARTO + th * 64 + ch * 8); }
#pragma unroll
    for (int i = 0; i < 4; ++i) { const int row = i * 8 + (lane >> 3), ch = lane & 7;
        const float m0 = mla[i][0], l0 = mla[i][1], m1 = mla[i][2], l1 = mla[i][3], m2 = mlb[i][0], l2 = mlb[i][1], m3 = mlb[i][2], l3 = mlb[i][3];
        const float M = __builtin_fmaxf(__builtin_fmaxf(m3, m0), __builtin_fmaxf(m1, m2));
        const float w3 = l3 * __builtin_amdgcn_exp2f(m3 - M), w0 = l0 * __builtin_amdgcn_exp2f(m0 - M), w1 = l1 * __builtin_amdgcn_exp2f(m1 - M), w2 = l2 * __builtin_amdgcn_exp2f(m2 - M);
        const float inv = __builtin_amdgcn_rcpf((w3 + w0) + (w1 + w2));
        const bool u0 = l0 > 0.f, u1 = l1 > 0.f, u2 = l2 > 0.f;
        const u32x4 p0 = pp[i][0], p1 = pp[i][1], p2 = pp[i][2], p3 = pp[i][3];
        unsigned ow[4];
#pragma unroll
        for (int c = 0; c < 4; ++c) { float lo = w3 * bflo(p3[c]), hi_ = w3 * bfhi(p3[c]);
            if (u0) { lo += w0 * bflo(p0[c]); hi_ += w0 * bfhi(p0[c]); } if (u1) { lo += w1 * bflo(p1[c]); hi_ += w1 * bfhi(p1[c]); } if (u2) { lo += w2 * bflo(p2[c]); hi_ += w2 * bfhi(p2[c]); }
            ow[c] = pk2(lo * inv, hi_ * inv); }
        *(u32x4*)(MO + (size_t)(row0 + row) * 512 + h * 64 + ch * 8) = (u32x4){ow[0], ow[1], ow[2], ow[3]}; }
}
template <int THR>
__device__ __forceinline__ void own_pass(int j, int rt, int h, long rowbase, const bf16_t* QA, char* shm, float* wsf, bf16_t* stg, bf16_t* PARTO, float* ML, int lane, int r32, int hi) {
    const int qrel = rt * 32 + r32, q = j * 256 + qrel;
    bf16x8 qr[4];
    { const bf16_t* Qw = QA + (rowbase + q) * 512 + h * 64;
#pragma unroll
      for (int d0 = 0; d0 < 4; ++d0) qr[d0] = *reinterpret_cast<const bf16x8*>(Qw + d0 * 16 + hi * 8); }
    float mhat = 0.f, l_reg = 0.f; f32x16 o[2]; o[0] = f32x16{}; o[1] = f32x16{};
    const int tlast = rt >> 1;
#pragma unroll 1
    for (int t = 0; t <= tlast; ++t) {
        f32x16 p0, p1;
        { const char* kb = shm + S2_K + t * 8192 + hi * 1024 + r32 * 16;
#pragma unroll
          for (int d0 = 0; d0 < 4; ++d0) { const bf16x8 k0 = *reinterpret_cast<const bf16x8*>(kb + d0 * 2048), k1 = *reinterpret_cast<const bf16x8*>(kb + d0 * 2048 + 512);
              if (d0 == 0) { p0 = MFMA32(k0, qr[0], f32x16{}); p1 = MFMA32(k1, qr[0], f32x16{}); } else { p0 = MFMA32(k0, qr[d0], p0); p1 = MFMA32(k1, qr[d0], p1); } } }
        if (t == tlast) cmask(p0, p1, t, qrel, hi);
        const float rm = rowmax(p0, p1) - mhat;
        if (t == 0) mhat = rm;
        else if (__builtin_expect(__any(rm > (float)THR), 0)) { const float dl = __builtin_fmaxf(rm, 0.f); mhat += dl; const float f = __builtin_amdgcn_exp2f(-dl); l_reg *= f;
            if (hi == 0) wsf[r32] = f; asm volatile("s_waitcnt lgkmcnt(0)" ::: "memory");
#pragma unroll
            for (int d_ = 0; d_ < 2; ++d_)
#pragma unroll
                for (int rr = 0; rr < 16; ++rr) o[d_][rr] *= wsf[crow(rr, hi)];
            asm volatile("s_waitcnt lgkmcnt(0)" ::: "memory"); }
        u32x4 pw[4]; float sa[4] = {0.f, 0.f, 0.f, 0.f};
#pragma unroll
        for (int rr = 0; rr < 16; ++rr) { p0[rr] = __builtin_amdgcn_exp2f(p0[rr] - mhat); p1[rr] = __builtin_amdgcn_exp2f(p1[rr] - mhat); sa[rr & 3] += p0[rr] + p1[rr]; }
        l_reg += (sa[0] + sa[1]) + (sa[2] + sa[3]);
        pw[0] = (u32x4){cvtpk(p0[0], p0[1]), cvtpk(p0[2], p0[3]), cvtpk(p0[4], p0[5]), cvtpk(p0[6], p0[7])};
        pw[1] = (u32x4){cvtpk(p0[8], p0[9]), cvtpk(p0[10], p0[11]), cvtpk(p0[12], p0[13]), cvtpk(p0[14], p0[15])};
        pw[2] = (u32x4){cvtpk(p1[0], p1[1]), cvtpk(p1[2], p1[3]), cvtpk(p1[4], p1[5]), cvtpk(p1[6], p1[7])};
        pw[3] = (u32x4){cvtpk(p1[8], p1[9]), cvtpk(p1[10], p1[11]), cvtpk(p1[12], p1[13]), cvtpk(p1[14], p1[15])};
        { const lds_cptr vp_ = (lds_cptr)shm + S2_V + t * 8192 + ((lane >> 4) & 1) * 32 + (lane & 3) * 8 + (4 * hi + ((lane & 15) >> 2)) * 64;
#pragma unroll
          for (int d0 = 0; d0 < 2; ++d0)
#pragma unroll
              for (int ks = 0; ks < 4; ++ks) { const s16x4 lo = vtr(vp_ + d0 * 4096 + ks * 1024), hh = vtr(vp_ + d0 * 4096 + ks * 1024 + 512);
                  const bf16x8 vf = {lo[0], lo[1], lo[2], lo[3], hh[0], hh[1], hh[2], hh[3]};
                  o[d0] = MFMA32(__builtin_bit_cast(bf16x8, pw[ks]), vf, o[d0]); } }
    }
    float lz = l_reg;
    { auto rr = __builtin_amdgcn_permlane32_swap(__float_as_uint(lz), __float_as_uint(lz), false, false); lz = __uint_as_float(rr[0]) + __uint_as_float(rr[1]); }
    if (hi == 0) wsf[32 + r32] = lz; asm volatile("s_waitcnt lgkmcnt(0)" ::: "memory");
    float rli[16];
#pragma unroll
    for (int rr = 0; rr < 16; ++rr) rli[rr] = __builtin_amdgcn_rcpf(wsf[32 + crow(rr, hi)]);
#pragma unroll
    for (int rr = 0; rr < 16; ++rr) { const int orow = crow(rr, hi);
#pragma unroll
        for (int d0 = 0; d0 < 2; ++d0) stg[orow * 64 + d0 * 32 + r32] = (bf16_t)f2bf(o[d0][rr] * rli[rr]); }
    if (hi == 0) { float* mlp = ML + ((size_t)(rowbase + q) * 8 + h) * 8 + 6; mlp[0] = mhat; mlp[1] = lz; }
    asm volatile("s_waitcnt lgkmcnt(0)" ::: "memory");
#pragma unroll
    for (int i = 0; i < 4; ++i) { const int row = i * 8 + (lane >> 3), ch = lane & 7;
        *(u32x4*)(PARTO + ((size_t)(rowbase + j * 256 + rt * 32 + row) * 8 + h) * 64 + ch * 8) = *(const u32x4*)(stg + row * 64 + ch * 8); }
    asm volatile("s_waitcnt lgkmcnt(0)" ::: "memory");
}
template <int THR>
__device__ __forceinline__ void sparse_item(int b, int h, int j, const bf16_t* QA, const bf16_t* KA, const bf16_t* VA, unsigned char* sc, bf16_t* PARTO, char* shm, const int tid0) {
    int tid_ = tid0; asm volatile("" : "+v"(tid_));
    const int tid = tid_, lane = tid & 63, r32 = lane & 31, hi = lane >> 5; const int wid = __builtin_amdgcn_readfirstlane(tid >> 6);
    const int bh = b * 8 + h; const long rowbase = (long)b * S;
    const unsigned lds0 = (unsigned)(uintptr_t)shm;
    { const bf16_t* ksrc = KA + (rowbase + j * 256 + lane) * 512 + h * 64 + wid * 8;
      const bf16_t* vsrc = VA + (rowbase + j * 256 + 16 * (wid & 3) + (lane >> 2)) * 512 + h * 64 + (wid >> 2) * 32 + (lane & 3) * 8;
#pragma unroll
      for (int t = 0; t < 4; ++t) { glds16(ksrc + (long)t * 64 * 512, (unsigned)__builtin_amdgcn_readfirstlane(lds0 + S2_K + t * 8192 + wid * 1024));
                                    glds16(vsrc + (long)t * 64 * 512, (unsigned)__builtin_amdgcn_readfirstlane(lds0 + S2_V + t * 8192 + wid * 1024)); } }
    const unsigned* CNT = (const unsigned*)(sc + SC_CNT) + (bh * 32 + j) * 32; const u16* LIST = (const u16*)(sc + SC_LIST) + (size_t)(bh * 32 + j) * 32 * 256;
    LAS u16* listc = (LAS u16*)(shm + S2_LIST);
    unsigned c_ = (r32 > j) ? CNT[r32] : 0u;
    unsigned inc = c_;
#pragma unroll
    for (int o = 1; o < 32; o <<= 1) { const unsigned v = __shfl_up(inc, o, 32); if (r32 >= o) inc += v; }
    const unsigned pre = inc - c_; const int N = (int)__shfl(inc, 31, 32);
    for (int qq = j + 1 + wid; qq < 32; qq += NWAVES) {
        const unsigned c = __shfl(c_, qq, 32), base = __shfl(pre, qq, 32);
        for (unsigned i = lane; i < c; i += 64) listc[base + i] = LIST[(size_t)qq * 256 + i];
    }
    asm volatile("s_waitcnt vmcnt(0) lgkmcnt(0)\n\ts_barrier" ::: "memory");
    const int ntile = (N + 31) >> 5;
    float* wsf = (float*)(shm + S2_WS) + wid * 64;
    bf16_t* stg = (bf16_t*)(shm + S2_STG + wid * 4096);
    bf16_t* PART = (bf16_t*)(sc + SC_PART); float* ML = (float*)(sc + SC_ML);
#ifndef S2_SIMPLE
    own_pass<THR>(j, wid, h, rowbase, QA, shm, wsf, stg, PARTO, ML, lane, r32, hi);
    s2_chain<THR>(N, ntile, wid, h, rowbase, QA, listc, shm, wsf, stg, PART, ML, lane, r32, hi);
#else
    for (int r = wid; r < ntile; r += 2 * NWAVES) {
        if (r + NWAVES < ntile) s2_pass<2, THR>(r, N, b, h, rowbase, QA, listc, shm, wsf, stg, PART, ML, lane, r32, hi);
        else s2_pass<1, THR>(r, N, b, h, rowbase, QA, listc, shm, wsf, stg, PART, ML, lane, r32, hi);
    }
#endif
    asm volatile("s_waitcnt vmcnt(0) lgkmcnt(0)\n\ts_barrier" ::: "memory");
}

} }
#ifndef MK_PHMASK
#define MK_PHMASK 0x3ff
#endif
#ifndef MK_DUP
#define MK_DUP -1
#endif
#define NREP(k) ((MK_DUP == (k)) ? 2 : 1)
#ifndef MLA_UNIT
#define MLA_UNIT att::ATT_UNIT
#endif
namespace mk {
struct Args { const float* in[18]; float* out; unsigned char* ws; int ph_lo, ph_hi; };

__device__ __forceinline__ int pair32(int rem, int half) { const int fq = rem >> 3, n = (rem >> 2) & 1, i = rem & 3; return n * half + fq * 4 + i; }
struct SrcWin { __device__ __forceinline__ int operator()(int j) const {
    const int pn = j >> 8, jl = j & 255;
    if (pn < 4) { const int hj = j & 511, head = hj >> 6, jj = hj & 63, w = jj >> 5, rem = jj & 31; const int fq = rem >> 3, n = (rem >> 2) & 1, i = rem & 3;
        return (pn < 2 ? 0 : 512) + head * 64 + n * 32 + w * 16 + fq * 4 + i; }
    if (pn < 7) return j;
    if (pn == 7) { if (jl < 128) return 1792 + jl; if (jl < 160) return 1920 + pair32(jl - 128, 16); return -1; }
    return 1952 + (j - 2048);
} };
struct SrcWqb { __device__ __forceinline__ int operator()(int j) const { const int G = j >> 5, head = G / 3, part = G - 3 * head, rem = j & 31; return head * 96 + (part < 2 ? part * 32 + rem : 64 + pair32(rem, 16)); } };
struct SrcWgu { __device__ __forceinline__ int operator()(int j) const { const int pn = j >> 8, bj = (j >> 7) & 1, jj = j & 127; return bj * DFF + 128 * pn + jj; } };
struct SrcId { __device__ __forceinline__ int operator()(int j) const { return j; } };

template <class F>
__device__ __forceinline__ void transpose_item(const float* W, int Ksrc, int Nsrc, const float* gain, bf16_t* WT, int Kd, F src, LAS float* scr, int item, int nblk, int lane, int koff = 0) {
    const int kb = item / nblk, nb = item % nblk, k0 = 64 * kb, n0 = 32 * nb;
    const int kr = lane >> 3, jb = lane & 7;
    const int sc = src(n0 + 4 * jb);
    f32x4 v[8]; float gk[8];
#pragma unroll
    for (int i = 0; i < 8; ++i) { const int k = k0 + 8 * i + kr; v[i] = (f32x4){0.f, 0.f, 0.f, 0.f}; gk[i] = 1.f;
        if (sc >= 0 && k < Ksrc) { v[i] = *(const GAS f32x4*)(W + (size_t)k * Nsrc + sc); if (gain) gk[i] = gain[k]; } }
#pragma unroll
    for (int i = 0; i < 8; ++i) { LAS float* d = scr + (8 * i + kr) * 33 + 4 * jb; d[0] = v[i][0] * gk[i]; d[1] = v[i][1] * gk[i]; d[2] = v[i][2] * gk[i]; d[3] = v[i][3] * gk[i]; }
    LDS_WAIT(); asm volatile("" ::: "memory");
    const int c = lane & 7;
#pragma unroll
    for (int j = 0; j < 4; ++j) { const int n = (lane >> 3) + 8 * j; const LAS float* s = scr + (8 * c) * 33 + n;
        u32x4 o; o.x = pk2(s[0 * 33], s[1 * 33]); o.y = pk2(s[2 * 33], s[3 * 33]); o.z = pk2(s[4 * 33], s[5 * 33]); o.w = pk2(s[6 * 33], s[7 * 33]);
        *(GAS u32x4*)(WT + (size_t)(n0 + n) * Kd + koff + k0 + 8 * c) = o; }
    LDS_WAIT(); asm volatile("" ::: "memory");
}
__device__ __forceinline__ float wave_sum(float v) {
#pragma unroll
    for (int o = 1; o < 64; o <<= 1) v += __shfl_xor(v, o);
    return v;
}

struct Frame { LAS unsigned char* lds; int vcu, G, wave_s; };
#define F_LANE ((int)__builtin_amdgcn_mbcnt_hi(~0u, __builtin_amdgcn_mbcnt_lo(~0u, 0u)))
#define F_WAVE (F.wave_s)
#define F_TID (F.wave_s * 64 + F_LANE)

__device__ __forceinline__ void p0_prologue(const Frame& F, const Args& A) {
    LAS float* scr = (LAS float*)(F.lds + F_WAVE * 16384);
    const int gw = F.vcu * NWAVES + F_WAVE, NGW = F.G * NWAVES;
    unsigned char* ws = A.ws;
    constexpr int I_WIN = 16 * 128, I_WGU = 16 * 176, I_WD = 44 * 32, I_WO = 16 * 32, I_WPG = 16 * 32, I_WMB = 8 * 32, I_WML = 8 * 32, I_WQB = 4 * 24, I_WKVB = 4 * 32, I_WPP = 4 * 32;
    constexpr int NITEMS = I_WIN + I_WGU + I_WD + I_WO + I_WPG + I_WMB + I_WML + I_WQB + I_WKVB + I_WPP;
    for (int it = gw; it < NITEMS; it += NGW) {
        int r = it;
        if (r < I_WIN) { transpose_item(A.in[3], 1024, 4000, A.in[2], (bf16_t*)(ws + WS_WIN), 1024, SrcWin(), scr, r, 128, F_LANE); continue; } r -= I_WIN;
        if (r < I_WGU) { transpose_item(A.in[12], 1024, 2 * DFF, A.in[11], (bf16_t*)(ws + WS_WGU), 1024, SrcWgu(), scr, r, 176, F_LANE); continue; } r -= I_WGU;
        if (r < I_WD) { transpose_item(A.in[13], DFF, 1024, nullptr, (bf16_t*)(ws + WS_WD), DFF, SrcId(), scr, r, 32, F_LANE); continue; } r -= I_WD;
        if (r < I_WO) { transpose_item(A.in[10], 1024, 1024, nullptr, (bf16_t*)(ws + WS_WO), 1024, SrcId(), scr, r, 32, F_LANE); continue; } r -= I_WO;
        if (r < I_WPG) { transpose_item(A.in[15], 1024, 1024, A.in[14], (bf16_t*)(ws + WS_WPG), 1024, SrcId(), scr, r, 32, F_LANE); continue; } r -= I_WPG;
        if (r < I_WMB) { transpose_item(A.in[8], 512, 1024, nullptr, (bf16_t*)(ws + WS_WBR), 1024, SrcId(), scr, r, 32, F_LANE, 0); continue; } r -= I_WMB;
        if (r < I_WML) { transpose_item(A.in[9], 512, 1024, nullptr, (bf16_t*)(ws + WS_WBR), 1024, SrcId(), scr, r, 32, F_LANE, 512); continue; } r -= I_WML;
        if (r < I_WQB) { transpose_item(A.in[5], 256, 768, A.in[4], (bf16_t*)(ws + WS_WQB), 256, SrcWqb(), scr, r, 24, F_LANE); continue; } r -= I_WQB;
        if (r < I_WKVB) { transpose_item(A.in[7], 128, 1024, A.in[6], (bf16_t*)(ws + WS_WKVB), 256, SrcId(), scr, r, 32, F_LANE); continue; } r -= I_WKVB;
        transpose_item(A.in[16], 256, 1024, nullptr, (bf16_t*)(ws + WS_WPP), 256, SrcId(), scr, r, 32, F_LANE);
    }
    const float* x = A.in[0]; const float* p = A.in[1]; bf16_t* XB = (bf16_t*)(ws + WS_XB); bf16_t* PB = (bf16_t*)(ws + WS_PB); float* rstd0 = (float*)(ws + WS_RSTD0);
    for (int m0 = gw * 4; m0 < T; m0 += NGW * 4) {
        f32x4 v[4][4], pv_[4];
#pragma unroll
        for (int rr = 0; rr < 4; ++rr) { const GAS f32x4* xr = (const GAS f32x4*)(x + (size_t)(m0 + rr) * D) + F_LANE;
#pragma unroll
            for (int j = 0; j < 4; ++j) v[rr][j] = xr[64 * j];
            pv_[rr] = *((const GAS f32x4*)(p + (size_t)(m0 + rr) * 256) + F_LANE); }
#pragma unroll
        for (int rr = 0; rr < 4; ++rr) { const int m = m0 + rr; float s = 0.f;
#pragma unroll
            for (int j = 0; j < 4; ++j) s += (v[rr][j][0] * v[rr][j][0] + v[rr][j][1] * v[rr][j][1]) + (v[rr][j][2] * v[rr][j][2] + v[rr][j][3] * v[rr][j][3]);
            s = wave_sum(s);
            GAS u32x2* o8 = (GAS u32x2*)(XB + (size_t)m * D) + F_LANE;
#pragma unroll
            for (int j = 0; j < 4; ++j) o8[64 * j] = pack4(v[rr][j]);
            if (F_LANE == 0) rstd0[m] = 1.0f / sqrtf(s * (1.0f / 1024.0f) + EPS);
            *((GAS u32x2*)(PB + (size_t)m * 256) + F_LANE) = pack4(pv_[rr]); }
    }
    float2* tab64 = (float2*)(ws + WS_ROPE64); float2* tab32 = (float2*)(ws + WS_ROPE32);
    for (int idx = (F.vcu * NWAVES * 64) + F_TID; idx < S * 48; idx += F.G * NWAVES * 64) {
        const int t = idx / 48, j = idx % 48; const int half = (j < 32) ? 32 : 16, i = (j < 32) ? j : j - 32;
        const float e = (float)i * (2.0f / (float)(2 * half)); const float inv = 1.0f / powf(10000.0f, e); const float ang = (float)t * inv;
        float c, s; sincos_acc(ang, c, s);
        if (j < 32) tab64[t * 32 + i] = make_float2(c, s); else tab32[t * 16 + i] = make_float2(c, s);
    }
}

__device__ __forceinline__ void p9_final(const Frame& F, const Args& A) {
    const int gw = F.vcu * NWAVES + F_WAVE, NGW = F.G * NWAVES; const float* ssq = (const float*)(A.ws + WS_SSQ_Y); const float* g = A.in[17];
    f32x4 gv[4];
#pragma unroll
    for (int j = 0; j < 4; ++j) gv[j] = *((const GAS f32x4*)g + F_LANE + 64 * j);
    for (int m = gw; m < T; m += NGW) {
        const float rs = rstd_from16(ssq + (size_t)m * 16);
        GAS f32x4* xr = (GAS f32x4*)(A.out + (size_t)m * D) + F_LANE;
#pragma unroll
        for (int j = 0; j < 4; ++j) xr[64 * j] = xr[64 * j] * rs * gv[j];
    }
}

__global__ void __launch_bounds__(NWAVES * 64, 2) mega_fwd(Args args) {
    extern __shared__ __attribute__((aligned(16))) unsigned char lds[];
    Frame F;
    F.lds = (LAS unsigned char*)lds;
        F.wave_s = __builtin_amdgcn_readfirstlane((int)threadIdx.x >> 6);
    F.G = gridDim.x; { const int bx = blockIdx.x; F.vcu = (F.G % 8 == 0) ? (bx % 8) * (F.G / 8) + bx / 8 : bx; }
    volatile LAS unsigned* MISC = (volatile LAS unsigned*)(F.lds + MISC_OFF);
    for (int u = F_TID; u < 128; u += NWAVES * 64) MISC[u] = 0u;
    __syncthreads();
    (void)xcd_barrier_post((unsigned*)(args.ws + WS_CTL) + CW_BAR, MISC + 8, F_TID);
#define GRIDBAR() do { XcdBarrier bar_; bar_.bar = (unsigned*)(args.ws + WS_CTL) + CW_BAR; bar_.x = xb_xcc_id(); bar_.st = (volatile LAS unsigned*)(F.lds + MISC_OFF) + 8; xcd_barrier(bar_, F_TID); } while (0)
#define IN(k) true
#define MK_PTRS const Args& A_ = args; unsigned char* ws = A_.ws; bf16_t* XB = (bf16_t*)(ws + WS_XB); bf16_t* PB = (bf16_t*)(ws + WS_PB); bf16_t* QA = (bf16_t*)(ws + WS_QA); bf16_t* KA = (bf16_t*)(ws + WS_KA); bf16_t* VA = (bf16_t*)(ws + WS_VA); bf16_t* LAT = (bf16_t*)(ws + WS_LAT); bf16_t* KR = (bf16_t*)(ws + WS_KR); bf16_t* GA = (bf16_t*)(ws + WS_GA); bf16_t* GB = (bf16_t*)(ws + WS_GB); bf16_t* QM = (bf16_t*)(ws + WS_QM); bf16_t* KM = (bf16_t*)(ws + WS_KM); bf16_t* VM = (bf16_t*)(ws + WS_VM); bf16_t* MOML = (bf16_t*)(ws + WS_MOML); bf16_t* MIX = (bf16_t*)(ws + WS_MIX); bf16_t* ACT = (bf16_t*)(ws + WS_ACT); float* rstd0 = (float*)(ws + WS_RSTD0); float* ssq_cq = (float*)(ws + WS_SSQ_CQ); float* ssq_kv = (float*)(ws + WS_SSQ_KV); float* kmp = (float*)(ws + WS_KMP); float* ssq_x = (float*)(ws + WS_SSQ_X); float* ssq_y = (float*)(ws + WS_SSQ_Y); const float2* rope64 = (const float2*)(ws + WS_ROPE64); const float2* rope32 = (const float2*)(ws + WS_ROPE32);
#ifdef MK_PROBE_A
#define STAMP(k) do { if (blockIdx.x == 0 && F_TID == 0) ((unsigned long long*)(args.ws + WS_CTL + 65536))[(k) + 1] = __builtin_amdgcn_s_memrealtime(); } while (0)
#else
#define STAMP(k) do { } while (0)
#endif
#define SEAM(k) do { if (IN(k) && IN((k) + 1)) GRIDBAR(); STAMP(k); } while (0)
    const int bx = (int)blockIdx.x;

    STAMP(-1);
    if (((MK_PHMASK >> 0) & 1) && IN(0)) for (int rep_ = 0; rep_ < NREP(0); ++rep_) { if (rep_) GRIDBAR(); MK_PTRS (void)XB; (void)PB; (void)QA; (void)KA; (void)VA; (void)LAT; (void)KR; (void)GA; (void)GB; (void)QM; (void)KM; (void)VM; (void)MOML; (void)MIX; (void)ACT; (void)rstd0; (void)ssq_cq; (void)ssq_kv; (void)kmp; (void)ssq_x; (void)ssq_y; (void)rope64; (void)rope32; p0_prologue(F, A_); }
    SEAM(0);
    if (((MK_PHMASK >> 1) & 1) && IN(1)) for (int rep_ = 0; rep_ < NREP(1); ++rep_) { if (rep_) GRIDBAR(); MK_PTRS (void)XB; (void)PB; (void)QA; (void)KA; (void)VA; (void)LAT; (void)KR; (void)GA; (void)GB; (void)QM; (void)KM; (void)VM; (void)MOML; (void)MIX; (void)ACT; (void)rstd0; (void)ssq_cq; (void)ssq_kv; (void)kmp; (void)ssq_x; (void)ssq_y; (void)rope64; (void)rope32;
        pg8::Gemm g{XB, (const bf16_t*)(ws + WS_WIN), T, 4096, 1024, 1024, 1024}; pg8::StaticOrder So; So.init(T, 4096, F.G, bx);
        EpiInProj E{ws};
        pg8::gemm_phase<EpiInProj, pg8::StaticOrder, true, true>(F.lds, g, So, E, F_TID);
    }
    SEAM(1);
    if (((MK_PHMASK >> 2) & 1) && IN(2)) for (int rep_ = 0; rep_ < NREP(2); ++rep_) { if (rep_) GRIDBAR(); MK_PTRS (void)XB; (void)PB; (void)QA; (void)KA; (void)VA; (void)LAT; (void)KR; (void)GA; (void)GB; (void)QM; (void)KM; (void)VM; (void)MOML; (void)MIX; (void)ACT; (void)rstd0; (void)ssq_cq; (void)ssq_kv; (void)kmp; (void)ssq_x; (void)ssq_y; (void)rope64; (void)rope32;
        { const int bh = F.vcu >> 3, s = F.vcu & 7;
          if (bh < NB * 8 && F.G == 256) { const int b = bh >> 3, h = bh & 7;
              for (int r2 = 0; r2 < ((MK_DUP == 33) ? 2 : 1); ++r2) moba::select_units4(b, h, s, QA, kmp, (unsigned char*)A_.out, (char*)lds, F_TID); } }
        { pg8::Gemm g{LAT, (const bf16_t*)(ws + WS_WQB), T, 768, 256, 512, 256}; pg8::StaticOrder So; So.init(T, 768, F.G, bx);
          EpiQb E{ws}; pg8::gemm_phase<EpiQb, pg8::StaticOrder, true, true>(F.lds, g, So, E, F_TID); }
        { pg8::Gemm g{LAT + 256, (const bf16_t*)(ws + WS_WKVB), T, 1024, 128, 512, 256};     pg8::StaticOrder So; So.init(T, 1024, F.G, bx);
          EpiKvb E{ws}; pg8::gemm_phase<EpiKvb, pg8::StaticOrder, true, true>(F.lds, g, So, E, F_TID); }
    }
    SEAM(2);
    if (((MK_PHMASK >> 3) & 1) && IN(3)) for (int rep_ = 0; rep_ < NREP(3); ++rep_) { if (rep_) GRIDBAR(); MK_PTRS (void)XB; (void)PB; (void)QA; (void)KA; (void)VA; (void)LAT; (void)KR; (void)GA; (void)GB; (void)QM; (void)KM; (void)VM; (void)MOML; (void)MIX; (void)ACT; (void)rstd0; (void)ssq_cq; (void)ssq_kv; (void)kmp; (void)ssq_x; (void)ssq_y; (void)rope64; (void)rope32;
        const int bh = F.vcu >> 3, s = F.vcu & 7;
        if (bh < NB * 8 && F.G == 256) {
            const int b = bh >> 3, h = bh & 7;
#ifndef MK_NO_MOBA
            { constexpr unsigned JMASK[8] = {0x00420001u, 0x40840002u, 0x20204004u, 0x02101008u, 0x08080210u, 0x04008420u, 0x01010140u, 0x90002880u};
              const unsigned jm = (s == 0) ? JMASK[0] : (s == 1) ? JMASK[1] : (s == 2) ? JMASK[2] : (s == 3) ? JMASK[3] : (s == 4) ? JMASK[4] : (s == 5) ? JMASK[5] : (s == 6) ? JMASK[6] : JMASK[7];
              for (int r2 = 0; r2 < ((MK_DUP == 30) ? 2 : 1); ++r2)
              for (int j = 0; j < 32; ++j) if ((jm >> j) & 1u) moba::sparse_item<8>(b, h, j, QA, KA, VA, (unsigned char*)A_.out, (bf16_t*)(ws + WS_GB + (size_t)32 * 1024 * 1024), (char*)lds, F_TID);
              if (F_TID == 0) {
                  __builtin_amdgcn_fence(__ATOMIC_RELEASE, "agent"); asm volatile("s_waitcnt vmcnt(0)" ::: "memory");
                  __hip_atomic_fetch_add((unsigned*)(ws + WS_CTL) + CW_MOBA + 64 * bh, 1u, __ATOMIC_RELAXED, __HIP_MEMORY_SCOPE_AGENT); } }
#endif
#ifndef MK_NO_MLA
            for (int r2 = 0; r2 < ((MK_DUP == 31) ? 2 : 1); ++r2)
            for (int i = 0; i < 4; ++i) { const int qb = (i == 0) ? s : (i == 1) ? 15 - s : (i == 2) ? 16 + s : 31 - s;
                MLA_UNIT<96, false, 8, 768, 768, 512, 512>(b, h, qb, QM, h * 96, KM, h * 96, VM, h * 64, LAT, h * 64, kmp, (char*)lds, F_TID); }
#endif
        }
    }
    if (((MK_PHMASK >> 3) & 1)) {
        MK_PTRS (void)XB; (void)PB; (void)KR; (void)LAT; (void)GA; (void)GB; (void)QM; (void)KM; (void)VM; (void)MIX; (void)ACT; (void)rstd0; (void)ssq_cq; (void)ssq_kv; (void)ssq_x; (void)ssq_y; (void)rope64; (void)rope32;
        const int bh = F.vcu >> 3, s = F.vcu & 7;
        if (bh < NB * 8 && F.G == 256) { const int b = bh >> 3, h = bh & 7;
            if (F_WAVE == 0) { unsigned* w_ = (unsigned*)(ws + WS_CTL) + CW_MOBA + 64 * bh; unsigned sp_ = 0;
                while ((unsigned)__builtin_amdgcn_readfirstlane(__hip_atomic_load(w_, __ATOMIC_RELAXED, __HIP_MEMORY_SCOPE_AGENT)) < 8u) { __builtin_amdgcn_s_sleep(4); if (++sp_ > (1u << 22)) break; }
                __builtin_amdgcn_fence(__ATOMIC_ACQUIRE, "agent"); asm volatile("s_waitcnt vmcnt(0)" ::: "memory"); }
            __syncthreads();
            for (int i = 0; i < 4; ++i) { const int qb = (i == 0) ? s : (i == 1) ? 15 - s : (i == 2) ? 16 + s : 31 - s;
                moba::merge_block(b, h, qb, QA, (const unsigned char*)A_.out, (const bf16_t*)(ws + WS_GB + (size_t)32 * 1024 * 1024), F_TID); } } }
    SEAM(3);
    if (((MK_PHMASK >> 4) & 1) && IN(4)) for (int rep_ = 0; rep_ < NREP(4); ++rep_) { if (rep_) GRIDBAR(); MK_PTRS (void)XB; (void)PB; (void)QA; (void)KA; (void)VA; (void)LAT; (void)KR; (void)GA; (void)GB; (void)QM; (void)KM; (void)VM; (void)MOML; (void)MIX; (void)ACT; (void)rstd0; (void)ssq_cq; (void)ssq_kv; (void)kmp; (void)ssq_x; (void)ssq_y; (void)rope64; (void)rope32;
        pg8::Gemm g{QA, (const bf16_t*)(ws + WS_WBR), T, 1024, 512, 512, 1024}; pg8::PairOrder So; So.init(T, 1024, F.G, bx); So.ksub = 512; So.adelta = (int)((WS_LAT - WS_QA) / 2);
        EpiBranch E{(const unsigned char*)GA, (const unsigned char*)GB, MIX}; pg8::gemm_phase<EpiBranch, pg8::PairOrder, true, true>(F.lds, g, So, E, F_TID);
    }
    SEAM(4);
    if (((MK_PHMASK >> 5) & 1) && IN(5)) for (int rep_ = 0; rep_ < NREP(5); ++rep_) { if (rep_) GRIDBAR(); MK_PTRS (void)XB; (void)PB; (void)QA; (void)KA; (void)VA; (void)LAT; (void)KR; (void)GA; (void)GB; (void)QM; (void)KM; (void)VM; (void)MOML; (void)MIX; (void)ACT; (void)rstd0; (void)ssq_cq; (void)ssq_kv; (void)kmp; (void)ssq_x; (void)ssq_y; (void)rope64; (void)rope32;
        pg8::Gemm g{MIX, (const bf16_t*)(ws + WS_WO), T, 1024, 1024, 1024, 1024}; pg8::StaticOrder So; So.init(T, 1024, F.G, bx);
        EpiResidT<false> E{XB, XB, ssq_x}; pg8::gemm_phase<EpiResidT<false>, pg8::StaticOrder, true, true>(F.lds, g, So, E, F_TID);
    }
    SEAM(5);
    if (((MK_PHMASK >> 6) & 1) && IN(6)) for (int rep_ = 0; rep_ < NREP(6); ++rep_) { if (rep_) GRIDBAR(); MK_PTRS (void)XB; (void)PB; (void)QA; (void)KA; (void)VA; (void)LAT; (void)KR; (void)GA; (void)GB; (void)QM; (void)KM; (void)VM; (void)MOML; (void)MIX; (void)ACT; (void)rstd0; (void)ssq_cq; (void)ssq_kv; (void)kmp; (void)ssq_x; (void)ssq_y; (void)rope64; (void)rope32;
        pg8::Gemm g{XB, (const bf16_t*)(ws + WS_WGU), T, 2 * DFF, 1024, 1024, 1024}; pg8::StaticOrder So; So.init(T, 2 * DFF, F.G, bx);
#if MK_DUP >= 61 && MK_DUP <= 63
        { EpiGateUp E{ssq_x, ACT}; pg8::gemm_phase<EpiGateUp, pg8::StaticOrder, true, true>(F.lds, g, So, E, F_TID); GRIDBAR(); }
        { EpiGateUpT<MK_DUP - 60> E{ssq_x, ACT}; pg8::gemm_phase<EpiGateUpT<MK_DUP - 60>, pg8::StaticOrder, true, true>(F.lds, g, So, E, F_TID); }
#else
        EpiGateUp E{ssq_x, ACT}; pg8::gemm_phase<EpiGateUp, pg8::StaticOrder, true, true>(F.lds, g, So, E, F_TID);
#endif
    }
    SEAM(6);
    if (((MK_PHMASK >> 7) & 1) && IN(7)) for (int rep_ = 0; rep_ < NREP(7); ++rep_) { if (rep_) GRIDBAR(); MK_PTRS (void)XB; (void)PB; (void)QA; (void)KA; (void)VA; (void)LAT; (void)KR; (void)GA; (void)GB; (void)QM; (void)KM; (void)VM; (void)MOML; (void)MIX; (void)ACT; (void)rstd0; (void)ssq_cq; (void)ssq_kv; (void)kmp; (void)ssq_x; (void)ssq_y; (void)rope64; (void)rope32;
        pg8::Gemm g{ACT, (const bf16_t*)(ws + WS_WD), T, 1024, DFF, DFF, DFF}; pg8::StaticOrder So; So.init(T, 1024, F.G, bx);
        EpiResidT<false> E{XB, XB, ssq_x}; pg8::gemm_phase<EpiResidT<false>, pg8::StaticOrder, true, true>(F.lds, g, So, E, F_TID);
    }
    SEAM(7);
    if (((MK_PHMASK >> 8) & 1) && IN(8)) for (int rep_ = 0; rep_ < NREP(8); ++rep_) { if (rep_) GRIDBAR(); MK_PTRS (void)XB; (void)PB; (void)QA; (void)KA; (void)VA; (void)LAT; (void)KR; (void)GA; (void)GB; (void)QM; (void)KM; (void)VM; (void)MOML; (void)MIX; (void)ACT; (void)rstd0; (void)ssq_cq; (void)ssq_kv; (void)kmp; (void)ssq_x; (void)ssq_y; (void)rope64; (void)rope32;
        bf16_t* TMP = (bf16_t*)(ws + WS_TMP8);
        { pg8::Gemm g{XB, (const bf16_t*)(ws + WS_WPG), T, 1024, 1024, 1024, 1024}; pg8::StaticOrder So; So.init(T, 1024, F.G, bx);
          EpiPleA E{ssq_x, (unsigned char*)TMP}; pg8::gemm_phase<EpiPleA, pg8::StaticOrder, true, true>(F.lds, g, So, E, F_TID); }
        { pg8::Gemm g{PB, (const bf16_t*)(ws + WS_WPP), T, 1024, 256, 256, 256}; pg8::StaticOrder So; So.init(T, 1024, F.G, bx);
          EpiPleB E{(const unsigned char*)TMP, XB, A_.out, A_.in[17], ssq_y, (unsigned*)(ws + WS_CTL) + CW_PNL, F.lds + XL_OFF}; pg8::gemm_phase<EpiPleB, pg8::StaticOrder, true, true>(F.lds, g, So, E, F_TID); }
    }
#ifdef MK_PROBE_A
    STAMP(9);
    if (blockIdx.x == 0 && F_TID < 64) {
        asm volatile("s_waitcnt vmcnt(0)" ::: "memory");
        const unsigned long long* ts = (const unsigned long long*)(args.ws + WS_CTL + 65536);
        const float dA = (float)(ts[MK_PROBE_A + 1] - ts[MK_PROBE_A]) * 0.01f, dB = (float)(ts[MK_PROBE_B + 1] - ts[MK_PROBE_B]) * 0.01f;
        if (F_TID == 0) args.out[0] += dA;
        for (int r = 1; r < 16; ++r) for (int c = F_TID; c < 1024; c += 64) args.out[(size_t)r * 2048 * 1024 + c] += dB;
    }
#endif
#undef IN
#undef SEAM
}

static inline bool launch(void* const* d_in, float* out, unsigned char* ws, hipStream_t stream, int ph_lo, int ph_hi) {
    static int grid = 0;
    if (grid == 0) {
        int dev = 0, cus = 0, per_cu = 0;
        if (hipGetDevice(&dev) != hipSuccess || hipDeviceGetAttribute(&cus, hipDeviceAttributeMultiprocessorCount, dev) != hipSuccess) { fprintf(stderr, "mk: device query failed\n"); grid = -1; return false; }
        if (hipFuncSetAttribute((const void*)mega_fwd, hipFuncAttributeMaxDynamicSharedMemorySize, LDS_BYTES) != hipSuccess) { fprintf(stderr, "mk: hipFuncSetAttribute failed\n"); grid = -1; return false; }
        if (hipOccupancyMaxActiveBlocksPerMultiprocessor(&per_cu, (const void*)mega_fwd, NWAVES * 64, LDS_BYTES) != hipSuccess || per_cu < 1) { fprintf(stderr, "mk: occupancy query says %d blocks per CU\n", per_cu); (void)hipGetLastError(); grid = -1; return false; }
        grid = cus;
        if (grid != 256) fprintf(stderr, "mk: %d CUs (expected 256)\n", grid);
    }
    if (grid < 0) return false;
    if (hipMemsetAsync(ws + WS_CTL, 0, CTL_ZERO_BYTES, stream) != hipSuccess) return false;
    Args a{};
    for (int i = 0; i < 18; ++i) a.in[i] = (const float*)d_in[i];
    a.out = out; a.ws = ws; a.ph_lo = ph_lo; a.ph_hi = ph_hi;
    hipLaunchKernelGGL(mega_fwd, dim3(grid), dim3(NWAVES * 64), LDS_BYTES, stream, a);
    return hipPeekAtLastError() == hipSuccess;
}
}
extern "C" void kernel_launch(void* const* d_in, const int* in_sizes, int n_in, void* d_out, int out_size, void* d_ws, size_t ws_size, hipStream_t stream) {
    if (n_in != 18 || out_size != 4 * 8192 * 1024 || ws_size < mk::WS_MEGA_END) { fprintf(stderr, "kernel_launch: unexpected sizes n_in %d out %d ws %zu\n", n_in, out_size, ws_size); return; }
    mk::launch(d_in, (float*)d_out, (unsigned char*)d_ws, stream, 0, 10);
}
```

```cpp
#include <hip/hip_runtime.h>
#include <cstdio>
#include <cstdint>
namespace pg8 {
#define PG8_LAS __attribute__((address_space(3)))
typedef unsigned short bf16_t;
typedef short bf16x8 __attribute__((ext_vector_type(8)));
typedef float f32x4 __attribute__((ext_vector_type(4)));
typedef unsigned u32x4 __attribute__((ext_vector_type(4)));
constexpr int BM = 256, BK = 64, HALF = 128, HTB = HALF * BK * 2  , STAGE_BYTES = 8 * HTB, NXCD = 8, WGM = 4;

__host__ __device__ __forceinline__ int lds_byte(int r, int c) { const int st = (r >> 4) * 2 + (c >> 5), rr = r & 15, cc = c & 31, ob = rr * 64 + cc * 2; return st * 1024 + (ob ^ (((ob >> 9) & 1) << 5)); }
__host__ __device__ __forceinline__ void stage_rc(int b, int& R, int& C) { const int st = b / 1024, sb = b % 1024, swz = sb ^ (((sb >> 9) & 1) << 5); R = (st >> 1) * 16 + swz / 64; C = (st & 1) * 32 + (swz % 64) / 2; }
__host__ __device__ __forceinline__ int perm32(int rho) { const int n = rho >> 4, i = rho & 15; return 8 * (i >> 2) + 4 * n + (i & 3); }

struct Unit { int pm, pn, koff, sub, koffa; };
struct Gemm { const bf16_t* A; const bf16_t* Bt; int M, N, K, lda, ldb; };

struct StaticOrder {
    int nM, nN, nwg, G, c;
    __host__ __device__ void init(int M, int N, int G_, int c_) { nM = M / BM; nN = N / BM; nwg = nM * nN; G = G_; c = c_; }
    __host__ __device__ bool next(int i, Unit& u) const {
        const long L = (long)i * G + c; if (L >= nwg) return false;
        int wgid = (int)L; { const int q = nwg / NXCD, r = nwg % NXCD, xcd = wgid % NXCD, off = wgid / NXCD; wgid = (xcd < r ? xcd * (q + 1) : r * (q + 1) + (xcd - r) * q) + off; }
        const int nig = WGM * nN, gid = wgid / nig, fm = gid * WGM, gsz = (nM - fm) < WGM ? (nM - fm) : WGM;
        u.pm = fm + ((wgid % nig) % gsz); u.pn = (wgid % nig) / gsz; u.koff = 0; u.koffa = 0; u.sub = 0; return true;
    }
    __device__ __forceinline__ void a_ready(const Unit&) const {}
    __device__ __forceinline__ void done(const Unit&) const {}
};
struct PairOrder : StaticOrder { int ksub, adelta;
    __host__ __device__ bool next(int i, Unit& u) const { if (!StaticOrder::next(i >> 1, u)) return false; u.sub = i & 1; u.koff = (i & 1) * ksub; u.koffa = (i & 1) * adelta; return true; } };


typedef float f32x2 __attribute__((ext_vector_type(2)));
template <class Epi, class Sched, bool ALIGN_EPI = false, bool SP2 = false>
__device__ __forceinline__ void gemm_phase(PG8_LAS unsigned char* lds, const Gemm g, const Sched& S, const Epi& E, const int tid0) {
    int tid_ = tid0; asm volatile("" : "+v"(tid_));
    const int tid = tid_, wid = __builtin_amdgcn_readfirstlane(tid >> 6), lane = tid & 63, wr = wid >> 2, wc = wid & 3, fr = lane & 15, fq = lane >> 4;
    int K_ = g.K; asm volatile("" : "+s"(K_));
    const int K = K_, nt = K / BK;
    unsigned voffA[2], voffB[2];
#pragma unroll
    for (int i = 0; i < 2; ++i) { int R, C; stage_rc(tid * 16 + i * 8192, R, C); const int Rb = Epi::PERM ? ((R & ~31) + perm32(R & 31)) : R;
        voffA[i] = (unsigned)(R * g.lda + C) * 2u; voffB[i] = (unsigned)(Rb * g.ldb + C) * 2u; }
    const size_t kstep = (size_t)(BK * 2);
    const size_t hstep = (size_t)HALF * g.ldb * 2, hstepA = (size_t)HALF * g.lda * 2;
    const size_t tstep = 2 * hstep, tstepA = 2 * hstepA;
    const unsigned ldsw = (unsigned)wid * 1024u;
    const int aoff = lds_byte(wr * 64 + fr, fq * 8), boff = lds_byte(wc * 32 + fr, fq * 8);
#define PG8_SA(b, h) (((b) * 2 + (h)) * HTB)
#define PG8_SB(b, h) ((4 + (b) * 2 + (h)) * HTB)
#define PG8_STAGE(bufoff, gbase, voff) do { _Pragma("unroll") for (int _i = 0; _i < 2; ++_i) \
        __builtin_amdgcn_global_load_lds((const unsigned*)((const char*)(gbase) + (voff)[_i]), (PG8_LAS unsigned*)(lds + (bufoff) + ldsw + _i * 8192), 16, 0, 0); } while (0)
#define PG8_LDA(dst, b, h) do { _Pragma("unroll") for (int m = 0; m < 4; ++m) _Pragma("unroll") for (int k = 0; k < 2; ++k) dst[m][k] = *(const PG8_LAS bf16x8*)(lds + PG8_SA(b, h) + aoff + m * 2048 + k * 1024); } while (0)
#define PG8_LDB(dst, b, h) do { _Pragma("unroll") for (int n = 0; n < 2; ++n) _Pragma("unroll") for (int k = 0; k < 2; ++k) dst[n][k] = *(const PG8_LAS bf16x8*)(lds + PG8_SB(b, h) + boff + n * 2048 + k * 1024); } while (0)
#define PG8_MMA(ai, bj, At, Bt) do { __builtin_amdgcn_s_setprio(1); _Pragma("unroll") for (int m = 0; m < 4; ++m) _Pragma("unroll") for (int n = 0; n < 2; ++n) _Pragma("unroll") for (int k = 0; k < 2; ++k) \
        acc[ai][bj][m][n] = __builtin_amdgcn_mfma_f32_16x16x32_bf16(Bt[n][k], At[m][k], acc[ai][bj][m][n], 0, 0, 0); __builtin_amdgcn_s_setprio(0); } while (0)
#define PG8_WAIT_V(n) asm volatile("s_waitcnt vmcnt(" #n ")" ::: "memory")
#define PG8_WAIT_L(n) asm volatile("s_waitcnt lgkmcnt(" #n ")" ::: "memory")
#define PG8_BAR __builtin_amdgcn_s_barrier()
#define PG8_SCHED __builtin_amdgcn_sched_barrier(0)
    Unit cur, nxt; int ui = 0;
    if (!S.next(0, cur)) return;
    f32x4 acc[2][2][4][2];
#pragma unroll
    for (int a = 0; a < 2; ++a)
#pragma unroll
        for (int b = 0; b < 2; ++b)
#pragma unroll
            for (int m = 0; m < 4; ++m)
#pragma unroll
                for (int n = 0; n < 2; ++n) acc[a][b][m][n] = (f32x4){0.f, 0.f, 0.f, 0.f};
    bf16x8 At[4][2], B0[2][2], B1[2][2];
    const char* cA = (const char*)g.A + (size_t)cur.pm * tstepA + (size_t)cur.koffa * 2; const char* cB = (const char*)g.Bt + (size_t)cur.pn * tstep + (size_t)cur.koff * 2;
    S.a_ready(cur);
    if constexpr (SP2) {
        PG8_STAGE(PG8_SB(0, 0), cB, voffB); PG8_STAGE(PG8_SB(0, 1), cB + hstep, voffB); PG8_STAGE(PG8_SA(0, 0), cA, voffA); PG8_STAGE(PG8_SA(0, 1), cA + hstepA, voffA);
        if (wr == 1) PG8_BAR;
        PG8_WAIT_V(2); PG8_BAR;
        PG8_STAGE(PG8_SB(1, 0), cB + kstep, voffB); PG8_STAGE(PG8_SA(1, 0), cA + kstep, voffA); PG8_STAGE(PG8_SB(1, 1), cB + hstep + kstep, voffB);
        PG8_WAIT_V(6); PG8_BAR;
    } else {
        PG8_STAGE(PG8_SB(0, 0), cB, voffB); PG8_STAGE(PG8_SA(0, 0), cA, voffA); PG8_STAGE(PG8_SB(0, 1), cB + hstep, voffB); PG8_STAGE(PG8_SA(0, 1), cA + hstepA, voffA);
        if (wr == 1) PG8_BAR;
        PG8_WAIT_V(4); PG8_BAR;
        PG8_STAGE(PG8_SB(1, 0), cB + kstep, voffB); PG8_STAGE(PG8_SA(1, 0), cA + kstep, voffA); PG8_STAGE(PG8_SB(1, 1), cB + hstep + kstep, voffB);
        PG8_WAIT_V(6); PG8_BAR;
    }
    for (;;) {
        const bool has_next = S.next(ui + 1, nxt);
        const char* nA = has_next ? (const char*)g.A + (size_t)nxt.pm * tstepA + (size_t)nxt.koffa * 2 : cA; const char* nB = has_next ? (const char*)g.Bt + (size_t)nxt.pn * tstep + (size_t)nxt.koff * 2 : cB;
        for (int t = 0; t < nt; t += 2) {
            const bool last = (t == nt - 2);
            const char* a1 = cA + (size_t)(t + 1) * kstep;
            const char* a2 = last ? nA : cA + (size_t)(t + 2) * kstep; const char* b2 = last ? nB : cB + (size_t)(t + 2) * kstep;
            const char* a3 = a2 + kstep; const char* b3 = b2 + kstep;
            if (last && has_next) S.a_ready(nxt);
            if constexpr (SP2) {
            PG8_LDB(B0, 0, 0); PG8_LDB(B1, 0, 1); PG8_SCHED; PG8_LDA(At, 0, 0); PG8_STAGE(PG8_SA(1, 1), a1 + hstepA, voffA);
            PG8_WAIT_V(8); PG8_WAIT_L(0); PG8_BAR; PG8_MMA(0, 0, At, B0); PG8_MMA(0, 1, At, B1); PG8_BAR; PG8_SCHED;
            PG8_LDA(At, 0, 1); PG8_STAGE(PG8_SB(0, 0), b2, voffB); PG8_STAGE(PG8_SB(0, 1), b2 + hstep, voffB); PG8_STAGE(PG8_SA(0, 0), a2, voffA);
            PG8_WAIT_V(8); PG8_WAIT_L(0); PG8_BAR; PG8_MMA(1, 0, At, B0); PG8_MMA(1, 1, At, B1); PG8_BAR; PG8_SCHED;
            PG8_LDB(B0, 1, 0); PG8_LDB(B1, 1, 1); PG8_SCHED; PG8_LDA(At, 1, 0); PG8_STAGE(PG8_SA(0, 1), a2 + hstepA, voffA);
            PG8_WAIT_V(8); PG8_WAIT_L(0); PG8_BAR; PG8_MMA(0, 0, At, B0); PG8_MMA(0, 1, At, B1); PG8_BAR; PG8_SCHED;
            PG8_LDA(At, 1, 1); PG8_STAGE(PG8_SB(1, 0), b3, voffB); PG8_STAGE(PG8_SB(1, 1), b3 + hstep, voffB); PG8_STAGE(PG8_SA(1, 0), a3, voffA);
            PG8_WAIT_V(8); PG8_WAIT_L(0); PG8_BAR; PG8_MMA(1, 0, At, B0); PG8_MMA(1, 1, At, B1); PG8_BAR; PG8_SCHED;
            } else {
            PG8_LDB(B0, 0, 0); PG8_SCHED; PG8_LDA(At, 0, 0); PG8_STAGE(PG8_SA(1, 1), a1 + hstepA, voffA);
            PG8_WAIT_L(8); PG8_BAR; PG8_WAIT_L(0); PG8_MMA(0, 0, At, B0); PG8_BAR; PG8_SCHED;
            PG8_LDB(B1, 0, 1); PG8_STAGE(PG8_SB(0, 0), b2, voffB);
            PG8_BAR; PG8_WAIT_L(0); PG8_MMA(0, 1, At, B1); PG8_BAR;
            PG8_LDA(At, 0, 1); PG8_STAGE(PG8_SA(0, 0), a2, voffA);
            PG8_BAR; PG8_WAIT_L(0); PG8_MMA(1, 0, At, B0); PG8_BAR; PG8_SCHED;
            PG8_STAGE(PG8_SB(0, 1), b2 + hstep, voffB);
            PG8_WAIT_V(6); PG8_BAR; PG8_MMA(1, 1, At, B1); PG8_BAR;
            PG8_LDB(B0, 1, 0); PG8_SCHED; PG8_LDA(At, 1, 0); PG8_STAGE(PG8_SA(0, 1), a2 + hstepA, voffA);
            PG8_WAIT_L(8); PG8_BAR; PG8_WAIT_L(0); PG8_MMA(0, 0, At, B0); PG8_BAR; PG8_SCHED;
            PG8_LDB(B1, 1, 1); PG8_STAGE(PG8_SB(1, 0), b3, voffB);
            PG8_BAR; PG8_WAIT_L(0); PG8_MMA(0, 1, At, B1); PG8_BAR;
            PG8_LDA(At, 1, 1); PG8_STAGE(PG8_SA(1, 0), a3, voffA);
            PG8_BAR; PG8_WAIT_L(0); PG8_MMA(1, 0, At, B0); PG8_BAR; PG8_SCHED;
            PG8_STAGE(PG8_SB(1, 1), b3 + hstep, voffB);
            PG8_WAIT_V(6); PG8_BAR; PG8_MMA(1, 1, At, B1); PG8_BAR;
            }
        }
        if constexpr (ALIGN_EPI) { if (wr == 0) PG8_BAR; }
        if constexpr (!Epi::AFTER_DRAIN) { E(acc, cur, wr, wc, fr, fq); S.done(cur); }
        if (!has_next) break;
        if (!(Epi::HAS_MID && cur.sub == 0))
#pragma unroll
        for (int a = 0; a < 2; ++a)
#pragma unroll
            for (int b = 0; b < 2; ++b)
#pragma unroll
                for (int m = 0; m < 4; ++m)
#pragma unroll
                    for (int n = 0; n < 2; ++n) acc[a][b][m][n] = (f32x4){0.f, 0.f, 0.f, 0.f};
        cur = nxt; cA = nA; cB = nB; ++ui;
        if constexpr (ALIGN_EPI) { if (wr == 1) PG8_BAR; }
    }
    PG8_WAIT_V(0);
    if constexpr (!ALIGN_EPI) { if (wr == 0) PG8_BAR; }
    PG8_BAR;
    if constexpr (Epi::AFTER_DRAIN) { E.fused(acc, cur, wr, wc, fr, fq, lds, wid, lane); S.done(cur); }
#undef PG8_SA
#undef PG8_SB
#undef PG8_STAGE
#undef PG8_LDA
#undef PG8_LDB
#undef PG8_MMA
#undef PG8_WAIT_V
#undef PG8_WAIT_L
#undef PG8_BAR
#undef PG8_SCHED
}
}
#ifndef MK_NB
#define MK_NB 4
#endif
namespace mk {
using pg8::bf16_t; using pg8::f32x4; using pg8::u32x4; using pg8::bf16x8;
typedef unsigned u32x2 __attribute__((ext_vector_type(2)));
typedef float f32x16 __attribute__((ext_vector_type(16)));
typedef short s16x4 __attribute__((ext_vector_type(4)));
constexpr int NB = MK_NB, S = 8192, T = NB * S, D = 1024, DFF = 2816, NWAVES = 8;
constexpr float EPS = 1e-6f;
constexpr float LOG2E = 1.4426950408889634f;
constexpr float C2A = 0.125f * LOG2E;
constexpr float C2B = 0.10206207261596577f * LOG2E;

constexpr size_t MiB = (size_t)1 << 20;
constexpr size_t WS_CTL = 0, CTL_ZERO_BYTES = 1 * MiB;
constexpr size_t WS_ROPE64 = 1 * MiB, WS_ROPE32 = 3 * MiB;
constexpr size_t WS_RSTD0 = 4 * MiB;
constexpr size_t WS_SSQ_CQ = WS_RSTD0 + 256 * 1024;
constexpr size_t WS_SSQ_KV = WS_SSQ_CQ + 512 * 1024;
constexpr size_t WS_KMP = WS_SSQ_KV + 512 * 1024;
constexpr size_t WS_SSQ_X = 6 * MiB;
constexpr size_t WS_SSQ_Y = 8 * MiB;
constexpr size_t WS_W = 10 * MiB;
constexpr size_t WS_WIN = WS_W, WS_WGU = WS_WIN + (size_t)4096 * 1024 * 2, WS_WD = WS_WGU + (size_t)5632 * 1024 * 2, WS_WO = WS_WD + (size_t)1024 * 2816 * 2,
                 WS_WPG = WS_WO + 2 * MiB, WS_WBR = WS_WPG + 2 * MiB  , WS_WQB = WS_WBR + 2 * MiB, WS_WKVB = WS_WQB + (size_t)768 * 256 * 2,
                 WS_WPP = WS_WKVB + (size_t)1024 * 256 * 2, WS_WEND = WS_WPP + (size_t)1024 * 256 * 2;
constexpr size_t WS_ACT0 = 44 * MiB;
static_assert(WS_WEND <= WS_ACT0, "weights fit");
constexpr size_t TB = (size_t)T;
constexpr size_t WS_XB = WS_ACT0;
constexpr size_t WS_PB = WS_XB + TB * 1024 * 2;
constexpr size_t WS_QA = WS_PB + TB * 256 * 2;
constexpr size_t WS_KA = WS_QA + TB * 512 * 2;
constexpr size_t WS_VA = WS_KA + TB * 512 * 2;
constexpr size_t WS_LAT = WS_VA + TB * 512 * 2;
constexpr size_t WS_KR = WS_LAT + TB * 512 * 2;
constexpr size_t WS_GA = WS_KR + TB * 64;
constexpr size_t WS_GB = WS_GA + TB * 1024 * 2;
constexpr size_t WS_QM = WS_GB + TB * 1024 * 2;
constexpr size_t WS_KM = WS_QM + TB * 768 * 2;
constexpr size_t WS_VM = WS_KM + TB * 768 * 2;
constexpr size_t WS_MEGA_END = WS_VM + TB * 512 * 2;
constexpr size_t WS_MOML = WS_XB;
constexpr size_t WS_MIX = WS_KA;
constexpr size_t WS_ACT = WS_QA;
constexpr size_t WS_TMP8 = WS_QA;
static_assert(WS_ACT + TB * 2816 * 2 <= WS_MEGA_END, "ACT overlay");
static_assert(NB != 4 || WS_MEGA_END <= 512 * MiB, "workspace map fits 512 MiB");
constexpr int CW_BAR = 4096, CW_MOBA = 32768, CW_PNL = 65536;

constexpr int LDS_BYTES = 163840;
constexpr int RING_BYTES = 131072, XL_OFF = 131072  , MISC_OFF = 163840 - 512;

#define GAS __attribute__((address_space(1)))
#define LAS __attribute__((address_space(3)))
typedef GAS unsigned gu32;
#define LDS_WAIT() asm volatile("s_waitcnt lgkmcnt(0)" ::: "memory")
#define VM_WAIT() asm volatile("s_waitcnt vmcnt(0)" ::: "memory")
__device__ __forceinline__ unsigned f2bf(float f) { unsigned u = __builtin_bit_cast(unsigned, f); return (u + 0x7fffu + ((u >> 16) & 1u)) >> 16; }
typedef float f32x2_c __attribute__((ext_vector_type(2))); typedef __bf16 bf16x2_c __attribute__((ext_vector_type(2)));
__device__ __forceinline__ unsigned pk2(float lo, float hi) { f32x2_c v = {lo, hi}; bf16x2_c b = __builtin_convertvector(v, bf16x2_c); return __builtin_bit_cast(unsigned, b); }
__device__ __forceinline__ float bf2f(unsigned short b) { return __builtin_bit_cast(float, (unsigned)b << 16); }
__device__ __forceinline__ float bflo(unsigned w) { return __builtin_bit_cast(float, w << 16); }
__device__ __forceinline__ float bfhi(unsigned w) { return __builtin_bit_cast(float, w & 0xffff0000u); }
__device__ __forceinline__ float sigm(float v) { return __builtin_amdgcn_rcpf(1.0f + __builtin_amdgcn_exp2f(-LOG2E * v)); }
__device__ __forceinline__ u32x4 pack8(const f32x4& a, const f32x4& b) { u32x4 w; w.x = pk2(a[0], a[1]); w.y = pk2(a[2], a[3]); w.z = pk2(b[0], b[1]); w.w = pk2(b[2], b[3]); return w; }
__device__ __forceinline__ u32x2 pack4(const f32x4& a) { u32x2 w; w.x = pk2(a[0], a[1]); w.y = pk2(a[2], a[3]); return w; }

__device__ __forceinline__ void sincos_acc(float ang, float& c, float& s) {
    const double x = (double)ang;
    const double k = __builtin_rint(x * 0.63661977236758134308);
    const double r = __builtin_fma(-k, 1.5707963267948966192, x) - k * 6.123233995736766036e-17;
    const double r2 = r * r;
    double sp = -2.5052108385441718775e-08; sp = sp * r2 + 2.7557319223985890653e-06; sp = sp * r2 - 1.9841269841269841270e-04; sp = sp * r2 + 8.3333333333333333333e-03; sp = sp * r2 - 1.6666666666666666667e-01;
    const double sn = r + r * r2 * sp;
    double cp = 2.0876756987868098979e-09; cp = cp * r2 - 2.7557319223985890653e-07; cp = cp * r2 + 2.4801587301587301587e-05; cp = cp * r2 - 1.3888888888888888889e-03; cp = cp * r2 + 4.1666666666666666667e-02; cp = cp * r2 - 0.5;
    const double cs = 1.0 + r2 * cp;
    const int q = (int)((long long)k & 3);
    const double cc = (q == 0) ? cs : (q == 1) ? -sn : (q == 2) ? -cs : sn;
    const double ss = (q == 0) ? sn : (q == 1) ? cs : (q == 2) ? -sn : -cs;
    c = (float)cc; s = (float)ss;
}

#define XB_TMO      128
#define XB_XCNT(j)  (256  + 64 * (j))
#define XB_XSUB(j)  (1280 + 64 * (j))
#define XB_XGEN(j)  (2304 + 64 * (j))
#define XB_TOP      3328
#define XB_TOPGEN   3392
#define XCD_BAR_WORDS 3456
#define XB_SPIN_CAP (1u << 18)
__device__ __forceinline__ unsigned xb_ld(unsigned* p)              { return __hip_atomic_load(p, __ATOMIC_RELAXED, __HIP_MEMORY_SCOPE_AGENT); }
__device__ __forceinline__ unsigned xb_add(unsigned* p, unsigned v) { return __hip_atomic_fetch_add(p, v, __ATOMIC_RELAXED, __HIP_MEMORY_SCOPE_AGENT); }
__device__ __forceinline__ unsigned xb_xcc_id() { return (unsigned)__builtin_amdgcn_s_getreg((3 << 11) | 20) & 0xFu; }
#define XB_SPIN(cond, bar) do { unsigned _sp = 0; while (cond) { __builtin_amdgcn_s_sleep(1); \
    if ((++_sp & 255u) == 0u) { if (xb_ld(&(bar)[XB_TMO])) break; if (_sp > XB_SPIN_CAP) { atomicAdd(&(bar)[XB_TMO], 1u); break; } } } } while (0)
struct XcdBarrier { unsigned* bar; unsigned x; volatile LAS unsigned* st; };
__device__ __forceinline__ XcdBarrier xcd_barrier_post(unsigned* bar, volatile LAS unsigned* st, const int tid0) {
    XcdBarrier b; b.bar = bar; b.x = xb_xcc_id(); b.st = st;
    if (tid0 == 0) (void)xb_add(&bar[XB_XCNT(b.x)], 1u);
    return b;
}
__device__ __forceinline__ void xcd_barrier_complete(unsigned* bar, unsigned x, unsigned& nloc, unsigned& nx) {
    const unsigned G = gridDim.x * gridDim.y * gridDim.z;
    unsigned sum, cnt, mine, sp = 0u;
    for (;;) {
        sum = 0u; cnt = 0u; mine = 0u;
#pragma unroll
        for (unsigned j = 0; j < 16; ++j) { const unsigned c = xb_ld(&bar[XB_XCNT(j)]); sum += c; cnt += (c > 0u) ? 1u : 0u; mine = (j == x) ? c : mine; }
        if (sum == G) break;
        __builtin_amdgcn_s_sleep(1);
        if ((++sp & 255u) == 0u) { if (xb_ld(&bar[XB_TMO])) break; if (sp > XB_SPIN_CAP) { atomicAdd(&bar[XB_TMO], 1u); break; } }
    }
    nloc = mine > 0u ? mine : 1u; nx = cnt > 0u ? cnt : 1u;
}
__device__ __forceinline__ void xcd_barrier(const XcdBarrier& b, const int tid0) {
    asm volatile("s_waitcnt vmcnt(0)" ::: "memory");
    __syncthreads();
    if (tid0 == 0) {
        unsigned* bar = b.bar;
        __builtin_amdgcn_s_waitcnt(0);
        unsigned nloc = b.st[0], nx = b.st[1];
        if (nloc == 0u) { xcd_barrier_complete(bar, b.x, nloc, nx); b.st[0] = nloc; b.st[1] = nx; }
        const unsigned old = xb_add(&bar[XB_XSUB(b.x)], 1u);
        const unsigned gen = old / nloc;
        if (old + 1u == (gen + 1u) * nloc) {
            __builtin_amdgcn_fence(__ATOMIC_RELEASE, "agent");
            asm volatile("s_waitcnt vmcnt(0)" ::: "memory");
            const unsigned og = xb_add(&bar[XB_TOP], 1u);
            const unsigned tg = og / nx;
            if (og + 1u == (tg + 1u) * nx) xb_add(&bar[XB_TOPGEN], 1u);
            else XB_SPIN(xb_ld(&bar[XB_TOPGEN]) == tg, bar);
            xb_add(&bar[XB_XGEN(b.x)], 1u);
            __builtin_amdgcn_fence(__ATOMIC_ACQUIRE, "agent");
            asm volatile("s_waitcnt vmcnt(0)" ::: "memory");
        } else {
            XB_SPIN(xb_ld(&bar[XB_XGEN(b.x)]) == gen, bar);
            __builtin_amdgcn_fence(__ATOMIC_ACQUIRE, "agent");
            asm volatile("s_waitcnt vmcnt(0)" ::: "memory");
        }
    }
    __syncthreads();
}
}
namespace mk {
using pg8::Unit;
#define EPI_ROW(u, ai, m) ((u).pm * 256 + (ai) * 128 + wr * 64 + (m) * 16 + fr)
#define EPI_FOR_ROWS _Pragma("unroll") for (int ai = 0; ai < 2; ++ai) _Pragma("unroll") for (int m = 0; m < 4; ++m)
__device__ __forceinline__ bool epi_fence() { asm volatile("" ::: "memory"); return true; }

__device__ __forceinline__ float rstd_from16(const float* p) {
    const f32x4 a = *(const f32x4*)p, b = *(const f32x4*)(p + 4), c = *(const f32x4*)(p + 8), d = *(const f32x4*)(p + 12);
    const float s = (((a[0] + a[1]) + (a[2] + a[3])) + ((b[0] + b[1]) + (b[2] + b[3]))) + (((c[0] + c[1]) + (c[2] + c[3])) + ((d[0] + d[1]) + (d[2] + d[3])));
    return __builtin_amdgcn_rsqf(s * (1.0f / 1024.0f) + EPS);
}
__device__ __forceinline__ float rstd_from4(const float* p, float invn) {
    const f32x4 a = *(const f32x4*)p; return __builtin_amdgcn_rsqf(((a[0] + a[1]) + (a[2] + a[3])) * invn + EPS);
}
#define EPI_RSTD8(rsv, ssqp) do { f32x4 sq_[2][4]; \
    _Pragma("unroll") for (int ai = 0; ai < 2; ++ai) _Pragma("unroll") for (int m = 0; m < 4; ++m) sq_[ai][m] = *(const f32x4*)((ssqp) + (size_t)EPI_ROW(u, ai, m) * 16 + 4 * fq); \
    _Pragma("unroll") for (int ai = 0; ai < 2; ++ai) _Pragma("unroll") for (int m = 0; m < 4; ++m) { float s_ = (sq_[ai][m][0] + sq_[ai][m][1]) + (sq_[ai][m][2] + sq_[ai][m][3]); \
        s_ += __shfl_xor(s_, 16); s_ += __shfl_xor(s_, 32); rsv[ai][m] = __builtin_amdgcn_rsqf(s_ * (1.0f / 1024.0f) + EPS); } } while (0)
#define EPI_PRELOAD_RS(expr) float rsv[2][4]; _Pragma("unroll") for (int ai = 0; ai < 2; ++ai) _Pragma("unroll") for (int m = 0; m < 4; ++m) { const int row = EPI_ROW(u, ai, m); rsv[ai][m] = (expr); }
__device__ __forceinline__ float sumsq8(const f32x4& a, const f32x4& b) { return ((a[0] * a[0] + a[1] * a[1]) + (a[2] * a[2] + a[3] * a[3])) + ((b[0] * b[0] + b[1] * b[1]) + (b[2] * b[2] + b[3] * b[3])); }

struct EpiInProj {
    static constexpr bool PERM = true, AFTER_DRAIN = false, HAS_MID = false;
    unsigned char* ws;
    __device__ __forceinline__ void operator()(const f32x4 (&acc)[2][2][4][2], const Unit& u, int wr, int wc, int fr, int fq) const {
        const int pn = u.pn;
        const float* rstd0 = (const float*)(ws + WS_RSTD0); const float2* rope64 = (const float2*)(ws + WS_ROPE64); const float2* rope32 = (const float2*)(ws + WS_ROPE32);
        bf16_t* QA = (bf16_t*)(ws + WS_QA); bf16_t* KA = (bf16_t*)(ws + WS_KA); bf16_t* VA = (bf16_t*)(ws + WS_VA); bf16_t* LAT = (bf16_t*)(ws + WS_LAT); bf16_t* KR = (bf16_t*)(ws + WS_KR);
        bf16_t* GA = (bf16_t*)(ws + WS_GA); bf16_t* GB = (bf16_t*)(ws + WS_GB); float* ssq_cq = (float*)(ws + WS_SSQ_CQ); float* ssq_kv = (float*)(ws + WS_SSQ_KV); float* kmp = (float*)(ws + WS_KMP);
        if (pn < 4) {
            const bool isk = pn >= 2; bf16_t* dst = isk ? KA : QA; const float sc = isk ? 1.0f : C2A;
            const int e = (wc & 1) * 16 + fq * 4;
            float cs1[2][4], cs2[2][4];
#pragma unroll
            for (int bj = 0; bj < 2; ++bj)
#pragma unroll
                for (int i = 0; i < 4; ++i) { cs1[bj][i] = 0.f; cs2[bj][i] = 0.f; }
            EPI_PRELOAD_RS(rstd0[row])
#pragma unroll
            for (int ai = 0; ai < 2; ++ai) {
#pragma unroll
            for (int m = 0; m < 4; ++m) {
                const int row = EPI_ROW(u, ai, m); const float rs = rsv[ai][m]; const int t = row & (S - 1);
                const f32x4 ca = *(const f32x4*)(rope64 + t * 32 + e), cb = *(const f32x4*)(rope64 + t * 32 + e + 2);
                const float c[4] = {ca[0], ca[2], cb[0], cb[2]}, s[4] = {ca[1], ca[3], cb[1], cb[3]};
#pragma unroll
                for (int bj = 0; bj < 2; ++bj) {
                    const int head = 4 * (pn & 1) + 2 * bj + (wc >> 1);
                    f32x4 y1, y2;
#pragma unroll
                    for (int i = 0; i < 4; ++i) { const float x1 = acc[ai][bj][m][0][i] * rs, x2 = acc[ai][bj][m][1][i] * rs; y1[i] = x1 * c[i] - x2 * s[i]; y2[i] = x2 * c[i] + x1 * s[i]; }
                    if (isk) {
#pragma unroll
                        for (int i = 0; i < 4; ++i) { cs1[bj][i] += y1[i]; cs2[bj][i] += y2[i]; } }
                    bf16_t* p = dst + (size_t)row * 512 + head * 64 + e;
                    *(u32x2*)p = pack4(y1 * sc); *(u32x2*)(p + 32) = pack4(y2 * sc);
                }
            }
            }
            if (isk) {
#pragma unroll
                for (int bj = 0; bj < 2; ++bj)
#pragma unroll
                    for (int i = 0; i < 4; ++i) {
                        float a = cs1[bj][i], b = cs2[bj][i];
#pragma unroll
                        for (int o = 1; o < 16; o <<= 1) { a += __shfl_xor(a, o); b += __shfl_xor(b, o); }
                        cs1[bj][i] = a; cs2[bj][i] = b;
                    }
                if (fr == 0) {
#pragma unroll
                    for (int bj = 0; bj < 2; ++bj) { const int head = 4 * (pn & 1) + 2 * bj + (wc >> 1); float* p = kmp + (size_t)(u.pm * 2 + wr) * 512 + head * 64 + e;
                        *(f32x4*)p = (f32x4){cs1[bj][0], cs1[bj][1], cs1[bj][2], cs1[bj][3]}; *(f32x4*)(p + 32) = (f32x4){cs2[bj][0], cs2[bj][1], cs2[bj][2], cs2[bj][3]}; }
                }
            }
        } else if (pn < 6) {
            EPI_PRELOAD_RS(rstd0[row])
            EPI_FOR_ROWS { const int row = EPI_ROW(u, ai, m); const float rs = rsv[ai][m];
#pragma unroll
                for (int bj = 0; bj < 2; ++bj) *(u32x4*)(VA + (size_t)row * 512 + (pn - 4) * 256 + bj * 128 + wc * 32 + 8 * fq) = pack8(acc[ai][bj][m][0] * rs, acc[ai][bj][m][1] * rs); }
        } else if (pn < 8) {
            float* ssq = (pn == 6) ? ssq_cq : ssq_kv;
            EPI_PRELOAD_RS(rstd0[row])
#pragma unroll
            for (int ai = 0; ai < 2; ++ai) {
#pragma unroll
            for (int m = 0; m < 4; ++m) { const int row = EPI_ROW(u, ai, m); const float rs = rsv[ai][m];
                const f32x4 a0 = acc[ai][0][m][0] * rs, a1 = acc[ai][0][m][1] * rs, b0 = acc[ai][1][m][0] * rs, b1 = acc[ai][1][m][1] * rs;
                bf16_t* p = LAT + (size_t)row * 512 + (pn - 6) * 256 + wc * 32 + 8 * fq;
                *(u32x4*)p = pack8(a0, a1); *(u32x4*)(p + 128) = pack8(b0, b1);
                float q = sumsq8(a0, a1); if (pn == 6) q += sumsq8(b0, b1);
                q += __shfl_xor(q, 16); q += __shfl_xor(q, 32);
                if (fq == 0) ssq[(size_t)row * 4 + wc] = q;
                if (pn == 7 && wc == 0) {
                    const int t = row & (S - 1);
                    const f32x4 ca = *(const f32x4*)(rope32 + t * 16 + 4 * fq), cb = *(const f32x4*)(rope32 + t * 16 + 4 * fq + 2);
                    const float c[4] = {ca[0], ca[2], cb[0], cb[2]}, s[4] = {ca[1], ca[3], cb[1], cb[3]};
                    f32x4 y1, y2;
#pragma unroll
                    for (int i = 0; i < 4; ++i) { y1[i] = b0[i] * c[i] - b1[i] * s[i]; y2[i] = b1[i] * c[i] + b0[i] * s[i]; }
                    bf16_t* k = KR + (size_t)row * 32 + 4 * fq; *(u32x2*)k = pack4(y1); *(u32x2*)(k + 16) = pack4(y2);
                }
            }
            }
        } else {
            unsigned char* dst = (unsigned char*)((pn < 12) ? GA : GB) + ((pn - 8) & 3) * 256 + wc * 64 + fq * 16;
            EPI_PRELOAD_RS(rstd0[row])
            EPI_FOR_ROWS { const int row = EPI_ROW(u, ai, m); const float rs = rsv[ai][m];
                u32x4 w = {0u, 0u, 0u, 0u};
#pragma unroll
                for (int bj = 0; bj < 2; ++bj)
#pragma unroll
                    for (int n = 0; n < 2; ++n) { const f32x4 a = acc[ai][bj][m][n] * rs; unsigned q = 0u;
                        q = __builtin_amdgcn_cvt_pk_u8_f32(sigm(a[0]) * 255.0f, 0, q); q = __builtin_amdgcn_cvt_pk_u8_f32(sigm(a[1]) * 255.0f, 1, q);
                        q = __builtin_amdgcn_cvt_pk_u8_f32(sigm(a[2]) * 255.0f, 2, q); q = __builtin_amdgcn_cvt_pk_u8_f32(sigm(a[3]) * 255.0f, 3, q);
                        w[bj * 2 + n] = q; }
                *(u32x4*)(dst + (size_t)row * 1024) = w; }
        }
    }
};

struct EpiQb {
    static constexpr bool PERM = true, AFTER_DRAIN = false, HAS_MID = false;
    unsigned char* ws;
    __device__ __forceinline__ void operator()(const f32x4 (&acc)[2][2][4][2], const Unit& u, int wr, int wc, int fr, int fq) const {
        const float* ssq_cq = (const float*)(ws + WS_SSQ_CQ); const float2* rope32 = (const float2*)(ws + WS_ROPE32); bf16_t* QM = (bf16_t*)(ws + WS_QM);
        EPI_PRELOAD_RS(rstd_from4(ssq_cq + (size_t)row * 4, 1.0f / 256.0f) * C2B)
#pragma unroll
        for (int ai = 0; ai < 2; ++ai) {
#pragma unroll
        for (int m = 0; m < 4; ++m) { const int row = EPI_ROW(u, ai, m); const float rs = rsv[ai][m]; const int t = row & (S - 1);
#pragma unroll
            for (int bj = 0; bj < 2; ++bj) {
                const int G = u.pn * 8 + bj * 4 + wc, head = G / 3, part = G - head * 3;
                const f32x4 a = acc[ai][bj][m][0] * rs, b = acc[ai][bj][m][1] * rs;
                if (part < 2) *(u32x4*)(QM + (size_t)row * 768 + head * 96 + part * 32 + 8 * fq) = pack8(a, b);
                else {
                    const f32x4 ca = *(const f32x4*)(rope32 + t * 16 + 4 * fq), cb = *(const f32x4*)(rope32 + t * 16 + 4 * fq + 2);
                    const float c[4] = {ca[0], ca[2], cb[0], cb[2]}, s[4] = {ca[1], ca[3], cb[1], cb[3]};
                    f32x4 y1, y2;
#pragma unroll
                    for (int i = 0; i < 4; ++i) { y1[i] = a[i] * c[i] - b[i] * s[i]; y2[i] = b[i] * c[i] + a[i] * s[i]; }
                    bf16_t* p = QM + (size_t)row * 768 + head * 96 + 64 + 4 * fq; *(u32x2*)p = pack4(y1); *(u32x2*)(p + 16) = pack4(y2);
                }
            } }
        }
    }
};
struct EpiKvb {
    static constexpr bool PERM = true, AFTER_DRAIN = false, HAS_MID = false;
    unsigned char* ws;
    __device__ __forceinline__ void operator()(const f32x4 (&acc)[2][2][4][2], const Unit& u, int wr, int wc, int fr, int fq) const {
        const float* ssq_kv = (const float*)(ws + WS_SSQ_KV); const bf16_t* KR = (const bf16_t*)(ws + WS_KR); bf16_t* KM = (bf16_t*)(ws + WS_KM); bf16_t* VM = (bf16_t*)(ws + WS_VM);
        EPI_PRELOAD_RS(rstd_from4(ssq_kv + (size_t)row * 4, 1.0f / 128.0f))
        u32x4 krv[2][4];
        if (wc == 0) {
#pragma unroll
            for (int ai = 0; ai < 2; ++ai)
#pragma unroll
                for (int m = 0; m < 4; ++m) krv[ai][m] = *(const u32x4*)(KR + (size_t)EPI_ROW(u, ai, m) * 32 + 8 * fq); }
        EPI_FOR_ROWS { const int row = EPI_ROW(u, ai, m); const float rs = rsv[ai][m];
            u32x4 kr; if (wc == 0) kr = krv[ai][m];
#pragma unroll
            for (int bj = 0; bj < 2; ++bj) {
                const int head = u.pn * 2 + bj; const u32x4 w = pack8(acc[ai][bj][m][0] * rs, acc[ai][bj][m][1] * rs);
                if (wc < 2) *(u32x4*)(KM + (size_t)row * 768 + head * 96 + wc * 32 + 8 * fq) = w;
                else *(u32x4*)(VM + (size_t)row * 512 + head * 64 + (wc - 2) * 32 + 8 * fq) = w;
                if (wc == 0) *(u32x4*)(KM + (size_t)row * 768 + head * 96 + 64 + 8 * fq) = kr;
            } }
    }
};
struct EpiBranch {
    static constexpr bool PERM = true, AFTER_DRAIN = false, HAS_MID = true;
    const unsigned char* GA; const unsigned char* GB; bf16_t* MIX;
    static __device__ __forceinline__ f32x4 ub4(unsigned w) { return (f32x4){(float)(w & 255u), (float)((w >> 8) & 255u), (float)((w >> 16) & 255u), (float)(w >> 24)}; }
    static constexpr float TINY8 = 2.2117724e-16f;
    __device__ __forceinline__ void mid(f32x4 (&acc)[2][2][4][2], const Unit& u, int wr, int wc, int fr, int fq) const {
#pragma unroll
        for (int ai = 0; ai < 2; ++ai) {
        u32x4 ga[4], gb[4];
#pragma unroll
        for (int m = 0; m < 4; ++m) { const size_t off = (size_t)EPI_ROW(u, ai, m) * 1024 + u.pn * 256 + wc * 64 + fq * 16; ga[m] = *(const u32x4*)(GA + off); gb[m] = *(const u32x4*)(GB + off); }
#pragma unroll
        for (int m = 0; m < 4; ++m)
#pragma unroll
            for (int bj = 0; bj < 2; ++bj)
#pragma unroll
                for (int n = 0; n < 2; ++n) { const f32x4 av = ub4(ga[m][bj * 2 + n]), bv = ub4(gb[m][bj * 2 + n]);
#pragma unroll
                    for (int i = 0; i < 4; ++i) acc[ai][bj][m][n][i] *= av[i] * __builtin_amdgcn_rcpf(__builtin_fmaxf(bv[i], TINY8)); }
        asm volatile("" ::: "memory");
        }
    }
    __device__ __forceinline__ void operator()(f32x4 (&acc)[2][2][4][2], const Unit& u, int wr, int wc, int fr, int fq) const {
        if (u.sub == 0) { mid(acc, u, wr, wc, fr, fq); return; }
#pragma unroll
        for (int ai = 0; ai < 2; ++ai) {
        u32x4 gb[4];
#pragma unroll
        for (int m = 0; m < 4; ++m) gb[m] = *(const u32x4*)(GB + (size_t)EPI_ROW(u, ai, m) * 1024 + u.pn * 256 + wc * 64 + fq * 16);
#pragma unroll
        for (int m = 0; m < 4; ++m)
#pragma unroll
            for (int bj = 0; bj < 2; ++bj) { const size_t off = (size_t)EPI_ROW(u, ai, m) * 1024 + u.pn * 256 + bj * 128 + wc * 32 + 8 * fq;
                f32x4 g0 = ub4(gb[m][bj * 2]), g1 = ub4(gb[m][bj * 2 + 1]);
#pragma unroll
                for (int i = 0; i < 4; ++i) { g0[i] = __builtin_fmaxf(g0[i], TINY8) * (1.0f / 255.0f); g1[i] = __builtin_fmaxf(g1[i], TINY8) * (1.0f / 255.0f); }
                *(u32x4*)(MIX + off) = pack8(acc[ai][bj][m][0] * g0, acc[ai][bj][m][1] * g1); }
        }
    }
};
template <bool F32IN> struct EpiResidT {
    static constexpr bool PERM = true, AFTER_DRAIN = false, HAS_MID = false;
    const void* XI; bf16_t* XBo; float* ssq;
    __device__ __forceinline__ void operator()(const f32x4 (&acc)[2][2][4][2], const Unit& u, int wr, int wc, int fr, int fq) const {
#pragma unroll
        for (int ai = 0; ai < 2; ++ai) {
        f32x4 xr[4][2][2];
#pragma unroll
        for (int m = 0; m < 4; ++m)
#pragma unroll
            for (int bj = 0; bj < 2; ++bj) { const size_t off = (size_t)EPI_ROW(u, ai, m) * 1024 + u.pn * 256 + bj * 128 + wc * 32 + 8 * fq;
                if (F32IN) { xr[m][bj][0] = *(const f32x4*)((const float*)XI + off); xr[m][bj][1] = *(const f32x4*)((const float*)XI + off + 4); }
                else { const u32x4 g = *(const u32x4*)((const bf16_t*)XI + off); xr[m][bj][0] = (f32x4){bflo(g.x), bfhi(g.x), bflo(g.y), bfhi(g.y)}; xr[m][bj][1] = (f32x4){bflo(g.z), bfhi(g.z), bflo(g.w), bfhi(g.w)}; } }
#pragma unroll
        for (int m = 0; m < 4; ++m) { const int row = EPI_ROW(u, ai, m); float q = 0.f;
#pragma unroll
            for (int bj = 0; bj < 2; ++bj) { const size_t off = (size_t)row * 1024 + u.pn * 256 + bj * 128 + wc * 32 + 8 * fq;
                const f32x4 v0 = xr[m][bj][0] + acc[ai][bj][m][0], v1 = xr[m][bj][1] + acc[ai][bj][m][1];
                *(u32x4*)(XBo + off) = pack8(v0, v1); q += sumsq8(v0, v1); }
            q += __shfl_xor(q, 16); q += __shfl_xor(q, 32);
            if (fq == 0) ssq[(size_t)row * 16 + u.pn * 4 + wc] = q; }
        }
    }
};
template <int MODE  > struct EpiGateUpT {
    static constexpr bool PERM = true, AFTER_DRAIN = false, HAS_MID = false;
    const float* ssq; bf16_t* ACT;
    __device__ __forceinline__ void operator()(const f32x4 (&acc)[2][2][4][2], const Unit& u, int wr, int wc, int fr, int fq) const {
        if (MODE == 2) {
#pragma unroll
            for (int a = 0; a < 2; ++a)
#pragma unroll
                for (int b = 0; b < 2; ++b)
#pragma unroll
                    for (int m = 0; m < 4; ++m)
#pragma unroll
                        for (int n = 0; n < 2; ++n) asm volatile("" :: "v"(acc[a][b][m][n]));
            return; }
        float rsv[2][4];
        if (MODE == 3) {
#pragma unroll
            for (int ai = 0; ai < 2; ++ai)
#pragma unroll
                for (int m = 0; m < 4; ++m) { rsv[ai][m] = 1.0f + 0.001f * (float)(fr + m); asm volatile("" : "+v"(rsv[ai][m])); }
        } else {
        EPI_RSTD8(rsv, ssq);
        }
        EPI_FOR_ROWS { const int row = EPI_ROW(u, ai, m); const float rs = rsv[ai][m];
            f32x4 o0, o1;
#pragma unroll
            for (int n = 0; n < 2; ++n) {
                const f32x4 g4 = acc[ai][0][m][n], u4 = acc[ai][1][m][n]; const f32x4 t4 = g4 * (-LOG2E * rs);
                f32x4 d4 = {__builtin_amdgcn_exp2f(t4[0]), __builtin_amdgcn_exp2f(t4[1]), __builtin_amdgcn_exp2f(t4[2]), __builtin_amdgcn_exp2f(t4[3])};
                d4 = d4 + 1.0f;
                const f32x4 r4 = {__builtin_amdgcn_rcpf(d4[0]), __builtin_amdgcn_rcpf(d4[1]), __builtin_amdgcn_rcpf(d4[2]), __builtin_amdgcn_rcpf(d4[3])};
                const f32x4 o4 = (g4 * u4) * r4 * (rs * rs);
                if (n == 0) o0 = o4; else o1 = o4; }
            const u32x4 w = pack8(o0, o1);
            if (MODE == 0) *(u32x4*)(ACT + (size_t)row * DFF + u.pn * 128 + wc * 32 + 8 * fq) = w; else asm volatile("" :: "v"(w.x), "v"(w.y), "v"(w.z), "v"(w.w)); }
    }
};
typedef EpiGateUpT<0> EpiGateUp;
struct EpiPleA {
    static constexpr bool PERM = true, AFTER_DRAIN = false, HAS_MID = false;
    const float* ssq_in; unsigned char* S8;
    __device__ __forceinline__ void operator()(const f32x4 (&acc)[2][2][4][2], const Unit& u, int wr, int wc, int fr, int fq) const {
        float rsv8[2][4]; EPI_RSTD8(rsv8, ssq_in);
#pragma unroll
        for (int ai = 0; ai < 2; ++ai) {
#pragma unroll
            for (int m = 0; m < 4; ++m) { const int row = EPI_ROW(u, ai, m); const float rs = rsv8[ai][m]; u32x4 w = {0u, 0u, 0u, 0u};
#pragma unroll
                for (int bj = 0; bj < 2; ++bj)
#pragma unroll
                    for (int n = 0; n < 2; ++n) { const f32x4 a = acc[ai][bj][m][n] * rs; unsigned q = 0u;
                        q = __builtin_amdgcn_cvt_pk_u8_f32(sigm(a[0]) * 255.0f, 0, q); q = __builtin_amdgcn_cvt_pk_u8_f32(sigm(a[1]) * 255.0f, 1, q);
                        q = __builtin_amdgcn_cvt_pk_u8_f32(sigm(a[2]) * 255.0f, 2, q); q = __builtin_amdgcn_cvt_pk_u8_f32(sigm(a[3]) * 255.0f, 3, q);
                        w[bj * 2 + n] = q; }
                *(u32x4*)(S8 + (size_t)row * 1024 + u.pn * 256 + wc * 64 + fq * 16) = w; } }
    }
};
struct EpiPleB {
    static constexpr bool PERM = true, AFTER_DRAIN = false, HAS_MID = false;
    const unsigned char* S8; const bf16_t* XBi; float* OUT; const float* gain; float* xslot; unsigned* cnt; LAS unsigned char* xl;
    __device__ __forceinline__ void operator()(f32x4 (&acc)[2][2][4][2], const Unit& u, int wr, int wc, int fr, int fq) const {
        LAS float* P = (LAS float*)xl;
        LAS float* Sx = (LAS float*)(xl + 4096);
        const int wid = wr * 4 + wc, lane = fq * 16 + fr;
#pragma unroll
        for (int ai = 0; ai < 2; ++ai) {
#pragma unroll
        for (int mh = 0; mh < 2; ++mh) {
        u32x4 xg[2][2], sg[2];
#pragma unroll
        for (int mm = 0; mm < 2; ++mm) { const size_t r_ = (size_t)EPI_ROW(u, ai, mh * 2 + mm) * 1024; sg[mm] = *(const u32x4*)(S8 + r_ + u.pn * 256 + wc * 64 + fq * 16);
#pragma unroll
            for (int bj = 0; bj < 2; ++bj) xg[mm][bj] = *(const u32x4*)(XBi + r_ + u.pn * 256 + bj * 128 + wc * 32 + 8 * fq); }
#pragma unroll
        for (int mm = 0; mm < 2; ++mm) { const int m = mh * 2 + mm; float q = 0.f;
#pragma unroll
            for (int bj = 0; bj < 2; ++bj) { const u32x4 g = xg[mm][bj];
                f32x4 v0 = {bflo(g.x), bfhi(g.x), bflo(g.y), bfhi(g.y)}, v1 = {bflo(g.z), bfhi(g.z), bflo(g.w), bfhi(g.w)};
                const f32x4 s0 = EpiBranch::ub4(sg[mm][bj * 2]) * (1.0f / 255.0f), s1 = EpiBranch::ub4(sg[mm][bj * 2 + 1]) * (1.0f / 255.0f);
                v0 += s0 * acc[ai][bj][m][0]; v1 += s1 * acc[ai][bj][m][1];
                acc[ai][bj][m][0] = v0; acc[ai][bj][m][1] = v1; q += sumsq8(v0, v1); }
            q += __shfl_xor(q, 16); q += __shfl_xor(q, 32);
            if (fq == 0) P[(ai * 128 + wr * 64 + m * 16 + fr) * 4 + wc] = q; }
        }
        }
        asm volatile("s_waitcnt lgkmcnt(0)\n\ts_barrier" ::: "memory");
        const int row = wid * 32 + (lane & 31);
        if (lane < 32) { const float s4 = (P[row * 4 + 0] + P[row * 4 + 1]) + (P[row * 4 + 2] + P[row * 4 + 3]);
            __hip_atomic_store(xslot + ((size_t)(u.pm * 256 + row) * 4 + u.pn), s4, __ATOMIC_RELAXED, __HIP_MEMORY_SCOPE_AGENT); }
        asm volatile("s_waitcnt vmcnt(0)" ::: "memory");
        if (lane == 0) __hip_atomic_fetch_add(cnt + 64 * u.pm, 1u, __ATOMIC_RELAXED, __HIP_MEMORY_SCOPE_AGENT);
        if (wid == 0) { unsigned sp_ = 0;
            while ((unsigned)__builtin_amdgcn_readfirstlane(__hip_atomic_load(cnt + 64 * u.pm, __ATOMIC_RELAXED, __HIP_MEMORY_SCOPE_AGENT)) < 32u) { __builtin_amdgcn_s_sleep(2); if (++sp_ > (1u << 20)) break; } }
        asm volatile("s_waitcnt vmcnt(0) lgkmcnt(0)\n\ts_barrier" ::: "memory");
        if (lane < 32) { const float* sl = xslot + (size_t)(u.pm * 256 + row) * 4; float tot = 0.f;
#pragma unroll
            for (int t = 0; t < 4; ++t) tot += __hip_atomic_load(sl + t, __ATOMIC_RELAXED, __HIP_MEMORY_SCOPE_AGENT);
            Sx[row] = __builtin_amdgcn_rsqf(tot * (1.0f / 1024.0f) + EPS); }
        asm volatile("s_waitcnt lgkmcnt(0)\n\ts_barrier" ::: "memory");
        f32x4 gv[2][2];
#pragma unroll
        for (int bj = 0; bj < 2; ++bj) { gv[bj][0] = *(const f32x4*)(gain + u.pn * 256 + bj * 128 + wc * 32 + 8 * fq); gv[bj][1] = *(const f32x4*)(gain + u.pn * 256 + bj * 128 + wc * 32 + 8 * fq + 4); }
        EPI_FOR_ROWS { const int row2 = EPI_ROW(u, ai, m); const float rs3 = Sx[ai * 128 + wr * 64 + m * 16 + fr];
#pragma unroll
            for (int bj = 0; bj < 2; ++bj) { const size_t off = (size_t)row2 * 1024 + u.pn * 256 + bj * 128 + wc * 32 + 8 * fq;
                *(f32x4*)(OUT + off) = acc[ai][bj][m][0] * rs3 * gv[bj][0]; *(f32x4*)(OUT + off + 4) = acc[ai][bj][m][1] * rs3 * gv[bj][1]; } }
        asm volatile("s_waitcnt lgkmcnt(0)\n\ts_barrier" ::: "memory");
    }
};
}
#define ATT_UNIT unit2
namespace mk { namespace att {
constexpr size_t moba_SC_PART = 0, moba_SC_ML = (size_t)T * 8 * 3 * 128;
#define SBAR() __builtin_amdgcn_sched_barrier(0)
#define MFMA32(a, b, c) __builtin_amdgcn_mfma_f32_32x32x16_bf16(a, b, c, 0, 0, 0)
#define MX3(a, b, c) __builtin_fmaxf(__builtin_fmaxf((a), (b)), (c))
__device__ __forceinline__ int crow(int r, int hi) { return (r & 3) + 8 * (r >> 2) + 4 * hi; }
__device__ __forceinline__ void glds16(const void* g, unsigned lds_base) {
    unsigned sv; asm volatile("s_mov_b32 %0, m0\n\ts_mov_b32 m0, %2\n\ts_nop 0\n\tglobal_load_lds_dwordx4 %1, off\n\ts_mov_b32 m0, %0" : "=&s"(sv) : "v"(g), "s"(lds_base) : "memory"); }
typedef float f32x2_t __attribute__((ext_vector_type(2))); typedef __bf16 bf16x2_t __attribute__((ext_vector_type(2)));
__device__ __forceinline__ unsigned cvtpk(float lo, float hi) { f32x2_t v = {lo, hi}; bf16x2_t b = __builtin_convertvector(v, bf16x2_t); return __builtin_bit_cast(unsigned, b); }
__device__ __forceinline__ float fadd_s(float a, float b) { float r; asm("v_add_f32_e32 %0, %1, %2" : "=v"(r) : "v"(a), "v"(b)); return r; }
__device__ __forceinline__ float fsub_s(float a, float b) { float r; asm("v_sub_f32_e32 %0, %1, %2" : "=v"(r) : "v"(a), "v"(b)); return r; }
__device__ __forceinline__ float rowmax(const f32x16& p0, const f32x16& p1) {
    float a = MX3(p0[0], p0[1], p1[0]), b = MX3(p0[2], p0[3], p1[1]); a = MX3(a, p1[2], p1[3]);
#pragma unroll
    for (int r = 4; r < 16; r += 4) { a = MX3(a, p0[r], p0[r + 1]); b = MX3(b, p0[r + 2], p0[r + 3]); a = MX3(a, p1[r], p1[r + 1]); b = MX3(b, p1[r + 2], p1[r + 3]); }
    float m = __builtin_fmaxf(a, b); auto rr = __builtin_amdgcn_permlane32_swap(__float_as_uint(m), __float_as_uint(m), false, false);
    return __builtin_fmaxf(__uint_as_float(rr[0]), __uint_as_float(rr[1])); }
__device__ __forceinline__ void cmask(f32x16& p0, f32x16& p1, int jb, int qrel, int hi) {
    const int kb = 64 * jb + 4 * hi;
#pragma unroll
    for (int r = 0; r < 16; ++r) { const int kv = kb + (r & 3) + 8 * (r >> 2); if (kv > qrel) p0[r] = -INFINITY; if (kv + 32 > qrel) p1[r] = -INFINITY; } }
typedef __attribute__((address_space(3))) const char* lds_cptr;
typedef short v4i16_t __attribute__((ext_vector_type(4)));
__device__ __forceinline__ bf16x8 ldsfrag(lds_cptr p) { return *(const __attribute__((address_space(3))) bf16x8*)(p); }
__device__ __forceinline__ void kload2(bf16x8* kf, lds_cptr kp, int j) { kf[2 * j] = ldsfrag(kp + j * 2048); kf[2 * j + 1] = ldsfrag(kp + j * 2048 + 512); }
__device__ __forceinline__ s16x4 vtr(lds_cptr p) { return __builtin_bit_cast(s16x4, __builtin_amdgcn_ds_read_tr16_b64_v4i16((__attribute__((address_space(3))) v4i16_t*)p)); }
__device__ __forceinline__ void pv(f32x16* o, int vb, bf16x8 pa0, bf16x8 pa1, bf16x8 pa2, bf16x8 pa3) {
#pragma unroll
    for (int d0 = 0; d0 < 2; ++d0) { s16x4 lo[4], hi[4];
#pragma unroll
        for (int ks = 0; ks < 4; ++ks) {
            asm volatile("ds_read_b64_tr_b16 %0,%1 offset:%c2" : "=&v"(lo[ks]) : "v"(vb), "i"(d0 * 4096 + ks * 1024) : "memory");
            asm volatile("ds_read_b64_tr_b16 %0,%1 offset:%c2" : "=&v"(hi[ks]) : "v"(vb), "i"(d0 * 4096 + ks * 1024 + 512) : "memory"); }
        asm volatile("s_waitcnt lgkmcnt(0)" ::: "memory"); SBAR();
#define PK(k) (bf16x8){lo[k][0], lo[k][1], lo[k][2], lo[k][3], hi[k][0], hi[k][1], hi[k][2], hi[k][3]}
        o[d0] = MFMA32(pa0, PK(0), o[d0]); o[d0] = MFMA32(pa1, PK(1), o[d0]); o[d0] = MFMA32(pa2, PK(2), o[d0]); o[d0] = MFMA32(pa3, PK(3), o[d0]);
#undef PK
    } }
struct TopSel { float v0, v1, v2; int i0, i1, i2;
    __device__ __forceinline__ void init() { v0 = v1 = v2 = -3e38f; i0 = i1 = i2 = 99; }
    __device__ __forceinline__ void ins(float v, int i) {
        const bool b0 = v > v0 || (v == v0 && i < i0), b1 = v > v1 || (v == v1 && i < i1), b2 = v > v2 || (v == v2 && i < i2);
        if (b0) { v2 = v1; i2 = i1; v1 = v0; i1 = i0; v0 = v; i0 = i; } else if (b1) { v2 = v1; i2 = i1; v1 = v; i1 = i; } else if (b2) { v2 = v; i2 = i; } }
    __device__ __forceinline__ void ins_up(float v, int i) {
        const bool b0 = v > v0, b1 = v > v1, b2 = v > v2;
        if (b0) { v2 = v1; i2 = i1; v1 = v0; i1 = i0; v0 = v; i0 = i; } else if (b1) { v2 = v1; i2 = i1; v1 = v; i1 = i; } else if (b2) { v2 = v; i2 = i; } }
};
template <int N> __device__ __forceinline__ void wait_bar() { asm volatile("s_waitcnt vmcnt(%0) lgkmcnt(0)\n\ts_barrier" :: "n"(N) : "memory"); }

constexpr int ATT_LDS_MAX = 4 * 8192 + 8 * 4096 + 4 * 8192 + NWAVES * 256 + NWAVES * 6144;
static_assert(ATT_LDS_MAX <= MISC_OFF, "attention LDS");

template <int DQK, bool MOBA, int THRL, int qp, int kp, int vp, int op, bool BAND = false>
__device__ __forceinline__ void unit2(int b, int h, int qb, const bf16_t* Q, int qo, const bf16_t* K, int ko, const bf16_t* V, int vo,
                                      bf16_t* O, int oo, const float* kmp, char* shm, const int tid0, const unsigned char* sc = nullptr) {
    constexpr int NKS = DQK / 16, SLOTK = 8192, SLOTV = 8192, SLOTR = 4096;
    constexpr int LDS_K = 0, LDS_KR = 4 * SLOTK, LDS_V = LDS_KR + ((DQK == 96) ? 8 * SLOTR : 0), LDS_WS = LDS_V + 4 * SLOTV, LDS_OST = LDS_WS + NWAVES * 256;
    int tid_ = tid0; asm volatile("" : "+v"(tid_));
    const int tid = tid_, lane = tid & 63, r32 = lane & 31, hi = lane >> 5; const int wid = __builtin_amdgcn_readfirstlane(tid >> 6);
    const bool two = (DQK == 96) && (wid >= 4);
    if (wid >= 4) __builtin_amdgcn_s_setprio(1);
    const long rowbase = (long)b * S; const int q0 = qb * 256;
    const bf16_t* Qw = Q + (rowbase + q0 + wid * 32) * qp + qo;
    const unsigned lds0 = (unsigned)(uintptr_t)shm;
    float* wsf = (float*)(shm + LDS_WS) + wid * 64;
    const long kv0 = rowbase + (BAND ? q0 : 0);
    const bf16_t* ksrc = K + (kv0 + lane) * kp + ko + wid * 8;
    const bf16_t* vsrc = V + (kv0 + 16 * (wid & 3) + (lane >> 2)) * vp + vo + (wid >> 2) * 32 + (lane & 3) * 8;
    const unsigned kdst = lds0 + LDS_K + wid * 1024, vdst = lds0 + LDS_V + wid * 1024, kdstr = lds0 + LDS_KR + (wid & 3) * 1024;
#define DMA_K(t, slot) do { glds16(ksrc + (long)(t) * 64 * kp, (unsigned)__builtin_amdgcn_readfirstlane(kdst + (slot))); \
        if (two) glds16(ksrc + (long)(t) * 64 * kp + 32  , (unsigned)__builtin_amdgcn_readfirstlane(kdstr + ((t) & 7) * SLOTR)); } while (0)
#define DMA_V(t, slot) glds16(vsrc + (long)(t) * 64 * vp, (unsigned)__builtin_amdgcn_readfirstlane(vdst + (slot)))
#define WB_PRO() do { if (two) wait_bar<5>(); else wait_bar<3>(); } while (0)
#define WB_STD() do { if (two) wait_bar<6>(); else wait_bar<4>(); } while (0)
    const int vb0 = (int)(lds0 + LDS_V) + ((lane >> 4) & 1) * 32 + (lane & 3) * 8 + (4 * hi + ((lane & 15) >> 2)) * 64;
    const lds_cptr shm3 = (lds_cptr)shm; const lds_cptr kp0 = shm3 + LDS_K + hi * 1024 + r32 * 16; const lds_cptr vp0 = shm3 + LDS_V + ((lane >> 4) & 1) * 32 + (lane & 3) * 8 + (4 * hi + ((lane & 15) >> 2)) * 64;
    const lds_cptr qlds = shm3 + LDS_OST + wid * 6144 + lane * 16;
    const int NT = BAND ? 4 : (q0 + 256) / 64;
    bf16x8 kf[8];
    DMA_K(0, 0); DMA_V(0, 0); DMA_K(1, SLOTK);
    bf16x8 qr[NKS];
#pragma unroll
    for (int d0 = 0; d0 < NKS; ++d0) qr[d0] = *reinterpret_cast<const bf16x8*>(&Qw[(long)r32 * qp + d0 * 16 + hi * 8]);
    unsigned sel = 0u;
    if (MOBA && qb > 0) {
        f32x16 g = f32x16{};
        const float* kq0 = kmp + ((size_t)(b * 32 + r32) * 2) * 512 + h * 64 + hi * 8;
#pragma unroll
        for (int d0 = 0; d0 < 4; ++d0) {
            const f32x4 a0 = *(const f32x4*)(kq0 + d0 * 16), a1 = *(const f32x4*)(kq0 + d0 * 16 + 4), b0 = *(const f32x4*)(kq0 + 512 + d0 * 16), b1 = *(const f32x4*)(kq0 + 512 + d0 * 16 + 4);
            const f32x4 m0 = (a0 + b0) * (1.0f / 256.0f), m1 = (a1 + b1) * (1.0f / 256.0f);
            unsigned short hh[8], ll[8];
#pragma unroll
            for (int i = 0; i < 4; ++i) { hh[i] = (unsigned short)f2bf(m0[i]); ll[i] = (unsigned short)f2bf(m0[i] - bf2f(hh[i])); hh[4 + i] = (unsigned short)f2bf(m1[i]); ll[4 + i] = (unsigned short)f2bf(m1[i] - bf2f(hh[4 + i])); }
            const bf16x8 fh = {(short)hh[0], (short)hh[1], (short)hh[2], (short)hh[3], (short)hh[4], (short)hh[5], (short)hh[6], (short)hh[7]};
            const bf16x8 fl = {(short)ll[0], (short)ll[1], (short)ll[2], (short)ll[3], (short)ll[4], (short)ll[5], (short)ll[6], (short)ll[7]};
            g = MFMA32(fh, qr[d0], g); g = MFMA32(fl, qr[d0], g);
        }
        TopSel ts; ts.init();
#pragma unroll
        for (int r = 0; r < 16; ++r) { const int j = crow(r, hi); ts.ins(j < qb ? g[r] : -3e38f, j); }
        const float pv0 = __shfl_xor(ts.v0, 32), pv1 = __shfl_xor(ts.v1, 32), pv2 = __shfl_xor(ts.v2, 32);
        const int pi0 = __shfl_xor(ts.i0, 32), pi1 = __shfl_xor(ts.i1, 32), pi2 = __shfl_xor(ts.i2, 32);
        ts.ins(pv0, pi0); ts.ins(pv1, pi1); ts.ins(pv2, pi2);
        if (ts.v0 > -1e37f) sel |= 1u << (ts.i0 & 31); if (ts.v1 > -1e37f) sel |= 1u << (ts.i1 & 31); if (ts.v2 > -1e37f) sel |= 1u << (ts.i2 & 31);
    }
    if (MOBA) sel |= 1u << qb;
    {
#pragma unroll
        for (int d0 = 0; d0 < NKS; ++d0) *(__attribute__((address_space(3))) bf16x8*)(qlds + d0 * 1024) = qr[d0];
    }
#ifndef ATT_PARKQ
#define ATT_PARKQ (DQK == 96)
#endif
#ifndef ATT_QREG
#define ATT_QREG 5
#endif
#define QF(d0) (((ATT_PARKQ) && (d0) >= ATT_QREG) ? ldsfrag(qlds + (((d0) < NKS) ? (d0) : 0) * 1024) : qr[((d0) < NKS) ? (d0) : 0])
    constexpr bool NEGM = true;
    constexpr bool VLATE = false;
    float mhat = 0.f, l_reg = 0.f; f32x16 o[2]; o[0] = f32x16{}; o[1] = f32x16{};
    const float msk0 = (MOBA && !(sel & 1u)) ? -1e30f : 0.f;
    f32x16 negm;
#pragma unroll
    for (int r = 0; r < 16; ++r) negm[r] = msk0;
    asm volatile("" : "+v"(negm));
#define CINIT (NEGM ? negm : f32x16{})
#define SUBM(x) (NEGM ? (x) : ((x) - mhat))
#define CMASK(P0, P1, t) do { int jb_ = (t) - (NT - 4); if (jb_ >= 0) cmask(P0, P1, jb_, wid * 32 + r32, hi); } while (0)
#define SETBLK(t) do { if (MOBA && (((t) & 3) == 0)) { const float msk_ = ((sel >> ((t) >> 2)) & 1u) ? 0.f : -1e30f; \
        _Pragma("unroll") for (int r = 0; r < 16; ++r) negm[r] = msk_ - mhat; asm volatile("" : "+v"(negm)); } } while (0)
    bool resc = false;
#define RESC() do { if (resc) { asm volatile("s_waitcnt lgkmcnt(0)" ::: "memory"); \
        _Pragma("unroll") for (int d_ = 0; d_ < 2; ++d_) _Pragma("unroll") for (int r = 0; r < 16; ++r) o[d_][r] *= wsf[crow(r, hi)]; } } while (0)
    f32x16 pA0, pA1, pB0, pB1;
#define KSLOT(t) ((((t)) & 3) * SLOTK)
#define VSLOT(t) ((((t)) & 3) * SLOTV)
#define ROT() do { } while (0)
    DMA_K(2, 2 * SLOTK);
    WB_PRO();
    { lds_cptr kb = kp0;
#pragma unroll
      for (int d0 = 0; d0 < NKS; ++d0) { const int ko_ = (d0 < 4) ? d0 * 2048 : (LDS_KR - LDS_K) + (d0 - 4) * 2048; const bf16x8 k0 = ldsfrag(kb + ko_), k1 = ldsfrag(kb + ko_ + 512); const bf16x8 qf = QF(d0);
          if (d0 == 0) { pA0 = MFMA32(k0, qf, CINIT); pA1 = MFMA32(k1, qf, CINIT); } else { pA0 = MFMA32(k0, qf, pA0); pA1 = MFMA32(k1, qf, pA1); } } }
    asm volatile("s_nop 15\n\ts_nop 7" : "+v"(pA0), "+v"(pA1)); CMASK(pA0, pA1, 0);
    { const float rm = rowmax(pA0, pA1); const float dl = (rm > -1e29f) ? rm : 0.f; mhat = dl;
#pragma unroll
      for (int r = 0; r < 16; ++r) { pA0[r] = fsub_s(pA0[r], dl); pA1[r] = fsub_s(pA1[r], dl); }
      if (NEGM) {
#pragma unroll
          for (int r = 0; r < 16; ++r) negm[r] = msk0 - mhat;
          asm volatile("" : "+v"(negm)); }
#pragma unroll
      for (int r = 0; r < 16; ++r) { pA0[r] = __builtin_amdgcn_exp2f(pA0[r]); pA1[r] = __builtin_amdgcn_exp2f(pA1[r]); } }
    wait_bar<0>();
    DMA_K(3, 3 * SLOTK); DMA_V(1, SLOTV); if (4 < NT) { DMA_K(4, 0); } DMA_V(2, 2 * SLOTV);
#pragma unroll
    for (int j = 0; j < 4; ++j) kload2(kf, kp0 + SLOTK, j);
    wait_bar<63>();
    constexpr int NVS = VLATE ? 4 : 8;
    s16x4 vlo[NVS], vhi[NVS]; u32x4 pw0, pw1, pw2, pw3;
#define VS(i) (VLATE ? (((i) & 3) * 2 + (((i) >> 2) & 1)) & 3 : (i))
#define PKW(P, B) cvtpk(P[B], P[B + 1])
#define PAF(k) __builtin_bit_cast(bf16x8, pw##k)
#define VFR(i) (bf16x8){vlo[VS(i)][0], vlo[VS(i)][1], vlo[VS(i)][2], vlo[VS(i)][3], vhi[VS(i)][0], vhi[VS(i)][1], vhi[VS(i)][2], vhi[VS(i)][3]}
#define PIN(x) asm volatile("" : "+v"(x))
#define GAPA(MF, A0, A1, A2, A3, W0, W1, PW) do { MF; sacc += A0; sacc += A1; sacc += A2; sacc += A3; PIN(sacc); W0; W1; PIN(PW); SBAR(); } while (0)
#define EX(v) __builtin_amdgcn_exp2f(v)
#define GAPB(MF, X, B) do { MF; X[B] = EX(SUBM(X[B])); X[B + 1] = EX(SUBM(X[B + 1])); X[B + 2] = EX(SUBM(X[B + 2])); X[B + 3] = EX(SUBM(X[B + 3])); PIN(X); SBAR(); } while (0)
#define VRD(i) do { vlo[VS(i)] = vtr(vp_ + (((i) >> 2) * 4096 + ((i) & 3) * 1024)); vhi[VS(i)] = vtr(vp_ + (((i) >> 2) * 4096 + ((i) & 3) * 1024 + 512)); } while (0)
#define VRDA(i) do { if (!VLATE) { VRD(i); } } while (0)
#define VRDL(i) do { if (VLATE) { VRD(i); SBAR(); } } while (0)
#define KRD(G, j) do { if (G) { kload2(kf, kp0 + knx_, j); SBAR(); } } while (0)
#define STEP(C0, C1, P0, P1, t, GK, GV, GL) do { SBAR(); \
    const lds_cptr vp_ = vp0 + VSLOT((t) - 1); const int knx_ = KSLOT((t) + 1); \
    bf16x8 qa_ = QF(0); \
    VRD(0); SBAR(); float sacc = (P0[0] + P0[1]); \
    GAPA(C0 = MFMA32(kf[0], qa_, CINIT), P0[2], P0[3], P0[4], P0[5],     pw0[0] = PKW(P0, 0),  pw0[1] = PKW(P0, 2),  pw0); \
    bf16x8 qb_ = QF(1); \
    VRD(4); SBAR(); GAPA(C1 = MFMA32(kf[1], qa_, CINIT), P0[6], P0[7], P0[8], P0[9],     pw0[2] = PKW(P0, 4),  pw0[3] = PKW(P0, 6),  pw0); \
    VRD(1); SBAR(); GAPA(C0 = MFMA32(kf[2], qb_, C0),   P0[10], P0[11], P0[12], P0[13], pw1[0] = PKW(P0, 8),  pw1[1] = PKW(P0, 10), pw1); \
    qa_ = QF(2); \
    VRD(5); SBAR(); GAPA(C1 = MFMA32(kf[3], qb_, C1),   P0[14], P0[15], P1[0], P1[1],   pw1[2] = PKW(P0, 12), pw1[3] = PKW(P0, 14), pw1); \
    bf16x8 kr0_, kr1_, kr2_, kr3_; const lds_cptr krp_ = kp0 + (LDS_KR - LDS_K) + ((t) & 7) * SLOTR; \
    if (DQK == 96) { kr0_ = ldsfrag(krp_); kr1_ = ldsfrag(krp_ + 512); } \
    VRDA(2); SBAR(); GAPA(C0 = MFMA32(kf[4], qa_, C0),   P1[2], P1[3], P1[4], P1[5],     pw2[0] = PKW(P1, 0),  pw2[1] = PKW(P1, 2),  pw2); \
    qb_ = QF(3); \
    VRDA(6); SBAR(); GAPA(C1 = MFMA32(kf[5], qa_, C1),   P1[6], P1[7], P1[8], P1[9],     pw2[2] = PKW(P1, 4),  pw2[3] = PKW(P1, 6),  pw2); \
    if (DQK == 96) { kr2_ = ldsfrag(krp_ + 2048); kr3_ = ldsfrag(krp_ + 2048 + 512); } \
    VRDA(3); SBAR(); GAPA(C0 = MFMA32(kf[6], qb_, C0),   P1[10], P1[11], P1[12], P1[13], pw3[0] = PKW(P1, 8),  pw3[1] = PKW(P1, 10), pw3); \
    if (DQK == 96) qa_ = QF(4); \
    VRDA(7); SBAR(); GAPA(C1 = MFMA32(kf[7], qb_, C1),   P1[14], P1[15], 0.f, 0.f,       pw3[2] = PKW(P1, 12), pw3[3] = PKW(P1, 14), pw3); \
    if (DQK == 96) { \
        C0 = MFMA32(kr0_, qa_, C0); SBAR(); qb_ = QF(5); C1 = MFMA32(kr1_, qa_, C1); SBAR(); \
        C0 = MFMA32(kr2_, qb_, C0); SBAR(); C1 = MFMA32(kr3_, qb_, C1); SBAR(); } \
    l_reg += sacc; \
    if (GK) { DMA_K((t) + 4, KSLOT((t) + 4)); } if (GV) { DMA_V((t) + 2, VSLOT((t) + 2)); } \
    CMASK(C0, C1, t); \
    { float a = MX3(C0[0], C0[1], C1[0]), b_ = MX3(C0[2], C0[3], C1[1]); a = MX3(a, C1[2], C1[3]); \
      _Pragma("unroll") for (int r = 4; r < 16; r += 4) { a = MX3(a, C0[r], C0[r + 1]); b_ = MX3(b_, C0[r + 2], C0[r + 3]); a = MX3(a, C1[r], C1[r + 1]); b_ = MX3(b_, C1[r + 2], C1[r + 3]); } \
      float rm = __builtin_fmaxf(a, b_); { auto rr = __builtin_amdgcn_permlane32_swap(__float_as_uint(rm), __float_as_uint(rm), false, false); rm = __builtin_fmaxf(__uint_as_float(rr[0]), __uint_as_float(rr[1])); } \
      if (!NEGM) rm -= mhat; \
      resc = false; \
      if (__builtin_expect(__any(rm > (float)THRL), 0)) { const float dl = __builtin_fmaxf(rm, 0.f); mhat += dl; \
        if (NEGM) { _Pragma("unroll") for (int r = 0; r < 16; ++r) { C0[r] -= dl; C1[r] -= dl; } \
                    _Pragma("unroll") for (int r = 0; r < 16; ++r) negm[r] -= dl; asm volatile("" : "+v"(negm)); } \
        const float f = __builtin_amdgcn_exp2f(-dl); l_reg *= f; if (hi == 0) wsf[r32] = f; resc = true; } } \
    SBAR(); \
    GAPB(o[0] = MFMA32(PAF(0), VFR(0), o[0]), C0, 0);  VRDL(2); \
    GAPB(o[1] = MFMA32(PAF(0), VFR(4), o[1]), C0, 4);  VRDL(6); \
    KRD(GL, 0); GAPB(o[0] = MFMA32(PAF(1), VFR(1), o[0]), C0, 8);  VRDL(3); \
    KRD(GL, 1); GAPB(o[1] = MFMA32(PAF(1), VFR(5), o[1]), C0, 12); VRDL(7); \
    KRD(GL, 2); GAPB(o[0] = MFMA32(PAF(2), VFR(2), o[0]), C1, 0); \
    KRD(GL, 3); GAPB(o[1] = MFMA32(PAF(2), VFR(6), o[1]), C1, 4); \
    GAPB(o[0] = MFMA32(PAF(3), VFR(3), o[0]), C1, 8); \
    GAPB(o[1] = MFMA32(PAF(3), VFR(7), o[1]), C1, 12); \
    } while (0)
    int t = 1;
#undef CMASK
#define CMASK(P0, P1, t) do { } while (0)
    for (; t + 5 < NT; t += 2) {
        STEP(pB0, pB1, pA0, pA1, t, true, true, true);     WB_STD(); RESC(); ROT(); SETBLK(t + 1);
        STEP(pA0, pA1, pB0, pB1, t + 1, true, true, true); WB_STD(); RESC(); ROT();
    }
#undef CMASK
#define CMASK(P0, P1, t) do { int jb_ = (t) - (NT - 4); if (jb_ >= 0) cmask(P0, P1, jb_, wid * 32 + r32, hi); } while (0)
#define ENDW(tt) do { wait_bar<0>(); } while (0)
    for (; t + 1 < NT; t += 2) {
        STEP(pB0, pB1, pA0, pA1, t, (t + 4 < NT), (t + 2 < NT), (t + 1 < NT));       ENDW(t);     RESC(); ROT(); SETBLK(t + 1);
        STEP(pA0, pA1, pB0, pB1, t + 1, (t + 5 < NT), (t + 3 < NT), (t + 2 < NT));   ENDW(t + 1); RESC(); ROT();
    }
    STEP(pB0, pB1, pA0, pA1, NT - 1, false, false, false); RESC();
    { float sacc = pB0[0] + pB0[1];
#pragma unroll
      for (int r = 2; r < 16; ++r) sacc += pB0[r];
#pragma unroll
      for (int r = 0; r < 16; ++r) sacc += pB1[r];
      l_reg += sacc;
      pw0 = (u32x4){PKW(pB0, 0), PKW(pB0, 2), PKW(pB0, 4), PKW(pB0, 6)}; pw1 = (u32x4){PKW(pB0, 8), PKW(pB0, 10), PKW(pB0, 12), PKW(pB0, 14)};
      pw2 = (u32x4){PKW(pB1, 0), PKW(pB1, 2), PKW(pB1, 4), PKW(pB1, 6)}; pw3 = (u32x4){PKW(pB1, 8), PKW(pB1, 10), PKW(pB1, 12), PKW(pB1, 14)};
      SBAR(); pv(o, vb0 + VSLOT(NT - 1), PAF(0), PAF(1), PAF(2), PAF(3)); }
    { auto rr = __builtin_amdgcn_permlane32_swap(__float_as_uint(l_reg), __float_as_uint(l_reg), false, false); l_reg = __uint_as_float(rr[0]) + __uint_as_float(rr[1]); }
    if (hi == 0) { wsf[32 + r32] = l_reg; if (BAND) wsf[r32] = mhat; } asm volatile("s_waitcnt lgkmcnt(0)" ::: "memory");
    float rli[16];
#pragma unroll
    for (int r = 0; r < 16; ++r) rli[r] = __builtin_amdgcn_rcpf(wsf[32 + crow(r, hi)]);
    bf16_t* Ow = O + (rowbase + q0 + wid * 32) * op + oo;
    { bf16_t* stg = (bf16_t*)(shm + LDS_OST + wid * 6144);
#pragma unroll
      for (int r = 0; r < 16; ++r) { const int orow = crow(r, hi);
#pragma unroll
          for (int d0 = 0; d0 < 2; ++d0) stg[orow * 64 + d0 * 32 + r32] = (bf16_t)f2bf(o[d0][r] * rli[r]); }
      asm volatile("s_waitcnt lgkmcnt(0)" ::: "memory");
      if (!BAND) {
#pragma unroll
      for (int i = 0; i < 4; ++i) { const int row = i * 8 + (lane >> 3), ch = lane & 7; const u32x4 v = *(const u32x4*)(stg + row * 64 + ch * 8); *(u32x4*)(Ow + (long)row * op + ch * 8) = v; }
      } else {
      const bf16_t* PART = (const bf16_t*)(sc + moba_SC_PART); const float* ML = (const float*)(sc + moba_SC_ML);
      u32x4 pp[4][3]; f32x4 mlv[4]; float m2v[4], l2v[4];
#pragma unroll
      for (int i = 0; i < 4; ++i) { const int row = i * 8 + (lane >> 3), ch = lane & 7; const size_t th = (size_t)(rowbase + q0 + wid * 32 + row) * 8 + h;
          mlv[i] = *(const f32x4*)(ML + th * 8); m2v[i] = ML[th * 8 + 4]; l2v[i] = ML[th * 8 + 5];
#pragma unroll
          for (int k = 0; k < 3; ++k) pp[i][k] = *(const u32x4*)(PART + (th * 3 + k) * 64 + ch * 8); }
#pragma unroll
      for (int i = 0; i < 4; ++i) { const int row = i * 8 + (lane >> 3), ch = lane & 7;
          const u32x4 vb_ = *(const u32x4*)(stg + row * 64 + ch * 8); const float mb = wsf[row], lb = wsf[32 + row];
          const f32x4 ml01 = mlv[i]; const float m2 = m2v[i], l2 = l2v[i];
          const u32x4 p0 = pp[i][0], p1 = pp[i][1], p2 = pp[i][2];
          const float M = __builtin_fmaxf(__builtin_fmaxf(mb, ml01[0]), __builtin_fmaxf(ml01[2], m2));
          const float wb = lb * __builtin_amdgcn_exp2f(mb - M), w0 = ml01[1] * __builtin_amdgcn_exp2f(ml01[0] - M), w1 = ml01[3] * __builtin_amdgcn_exp2f(ml01[2] - M), w2 = l2 * __builtin_amdgcn_exp2f(m2 - M);
          const float inv = __builtin_amdgcn_rcpf((wb + w0) + (w1 + w2));
          const bool u0 = ml01[1] > 0.f, u1 = ml01[3] > 0.f, u2 = l2 > 0.f;
          unsigned ow[4];
#pragma unroll
          for (int c = 0; c < 4; ++c) { const unsigned xb = vb_[c], x0 = p0[c], x1 = p1[c], x2 = p2[c];
              float lo = wb * bflo(xb), hi_ = wb * bfhi(xb);
              if (u0) { lo += w0 * bflo(x0); hi_ += w0 * bfhi(x0); } if (u1) { lo += w1 * bflo(x1); hi_ += w1 * bfhi(x1); } if (u2) { lo += w2 * bflo(x2); hi_ += w2 * bfhi(x2); }
              ow[c] = pk2(lo * inv, hi_ * inv); }
          *(u32x4*)(Ow + (long)row * op + ch * 8) = (u32x4){ow[0], ow[1], ow[2], ow[3]}; } } }
    __builtin_amdgcn_s_setprio(0);
    asm volatile("s_waitcnt vmcnt(0) lgkmcnt(0)\n\ts_barrier" ::: "memory");
#undef DMA_K
#undef DMA_V
#undef WB_PRO
#undef WB_STD
#undef QF
#undef CINIT
#undef SUBM
#undef VS
#undef VRDA
#undef VRDL
#undef CMASK
#undef SETBLK
#undef RESC
#undef ROT
#undef PKW
#undef PAF
#undef VFR
#undef PIN
#undef GAPA
#undef EX
#undef GAPB
#undef VRD
#undef KRD
#undef STEP
#undef ENDW
#undef KSLOT
#undef VSLOT
}
} }
namespace mk { namespace moba {
using namespace att;
constexpr size_t SC_PART = 0;
constexpr size_t SC_ML = SC_PART + (size_t)T * 8 * 3 * 128;
constexpr size_t SC_LIST = SC_ML + (size_t)T * 8 * 32;
constexpr size_t SC_CNT = SC_LIST + (size_t)NB * 8 * 32 * 32 * 512;
constexpr size_t SC_END = SC_CNT + (size_t)NB * 8 * 32 * 32 * 4;
static_assert(SC_END <= (size_t)T * 1024 * 4, "MoBA scratch fits d_out");
static_assert(SC_PART == att::moba_SC_PART && SC_ML == att::moba_SC_ML, "scratch map shared with the band epilogue");
typedef unsigned short u16;

constexpr int S1_STRIDE = 256 + 32 * 256 * 2;
__device__ __forceinline__ void select_units4(int b, int h, int s, const bf16_t* QA, const float* kmp, unsigned char* sc, char* shm, const int tid0) {
    int tid_ = tid0; asm volatile("" : "+v"(tid_));
    const int tid = tid_, lane = tid & 63, r32 = lane & 31, hi = lane >> 5; const int wid = __builtin_amdgcn_readfirstlane(tid >> 6);
    const int bh = b * 8 + h;
    if (tid < 128) ((LAS unsigned*)(shm + (tid >> 5) * S1_STRIDE))[tid & 31] = 0u;
    bf16x8 fh[4], fl[4];
    { const float* kq0 = kmp + ((size_t)(b * 32 + r32) * 2) * 512 + h * 64 + hi * 8;
#pragma unroll
      for (int d0 = 0; d0 < 4; ++d0) {
          const f32x4 a0 = *(const f32x4*)(kq0 + d0 * 16), a1 = *(const f32x4*)(kq0 + d0 * 16 + 4), b0 = *(const f32x4*)(kq0 + 512 + d0 * 16), b1 = *(const f32x4*)(kq0 + 512 + d0 * 16 + 4);
          const f32x4 m0 = (a0 + b0) * (1.0f / 256.0f), m1 = (a1 + b1) * (1.0f / 256.0f);
          unsigned short hh[8], ll[8];
#pragma unroll
          for (int i = 0; i < 4; ++i) { hh[i] = (unsigned short)f2bf(m0[i]); ll[i] = (unsigned short)f2bf(m0[i] - bf2f(hh[i])); hh[4 + i] = (unsigned short)f2bf(m1[i]); ll[4 + i] = (unsigned short)f2bf(m1[i] - bf2f(hh[4 + i])); }
          fh[d0] = (bf16x8){(short)hh[0], (short)hh[1], (short)hh[2], (short)hh[3], (short)hh[4], (short)hh[5], (short)hh[6], (short)hh[7]};
          fl[d0] = (bf16x8){(short)ll[0], (short)ll[1], (short)ll[2], (short)ll[3], (short)ll[4], (short)ll[5], (short)ll[6], (short)ll[7]}; } }
    bf16x8 qr[4][4];
#pragma unroll
    for (int u = 0; u < 4; ++u) { const int qb = (u == 0) ? s : (u == 1) ? 15 - s : (u == 2) ? 16 + s : 31 - s; const bf16_t* Qw = QA + ((size_t)b * S + qb * 256 + wid * 32 + r32) * 512 + h * 64;
#pragma unroll
        for (int d0 = 0; d0 < 4; ++d0) qr[u][d0] = *reinterpret_cast<const bf16x8*>(Qw + d0 * 16 + hi * 8); }
    asm volatile("s_waitcnt lgkmcnt(0)\n\ts_barrier" ::: "memory");
#pragma unroll
    for (int u = 0; u < 4; ++u) { const int qb = (u == 0) ? s : (u == 1) ? 15 - s : (u == 2) ? 16 + s : 31 - s;
        LAS unsigned* cnt = (LAS unsigned*)(shm + u * S1_STRIDE); LAS u16* lst = (LAS u16*)(shm + u * S1_STRIDE + 256);
        const int q = qb * 256 + wid * 32 + r32;
        float* ML = (float*)(sc + SC_ML) + ((size_t)(b * S + q) * 8 + h) * 8;
        TopSel ts; ts.init();
        if (qb > 0) {
            f32x16 g = f32x16{};
#pragma unroll
            for (int d0 = 0; d0 < 4; ++d0) { g = MFMA32(fh[d0], qr[u][d0], g); g = MFMA32(fl[d0], qr[u][d0], g); }
#pragma unroll
            for (int r = 0; r < 16; ++r) { const int j = crow(r, hi); ts.ins_up(j < qb ? g[r] : -3e38f, j); }
            const float pv0 = __shfl_xor(ts.v0, 32), pv1 = __shfl_xor(ts.v1, 32), pv2 = __shfl_xor(ts.v2, 32);
            const int pi0 = __shfl_xor(ts.i0, 32), pi1 = __shfl_xor(ts.i1, 32), pi2 = __shfl_xor(ts.i2, 32);
            ts.ins(pv0, pi0); ts.ins(pv1, pi1); ts.ins(pv2, pi2);
        }
        if (hi == 0) {
            const float vv[3] = {ts.v0, ts.v1, ts.v2}; const int ii[3] = {ts.i0, ts.i1, ts.i2};
#pragma unroll
            for (int k = 0; k < 3; ++k) {
                if (vv[k] > -1e37f) { const int j = ii[k] & 31; const unsigned pos = __hip_atomic_fetch_add(cnt + j, 1u, __ATOMIC_RELAXED, __HIP_MEMORY_SCOPE_WORKGROUP); lst[j * 256 + pos] = (u16)(q | (k << 13)); }
                else { ML[2 * k] = -1e30f; ML[2 * k + 1] = 0.f; }
            }
        }
    }
    asm volatile("s_waitcnt lgkmcnt(0)\n\ts_barrier" ::: "memory");
    unsigned* CNT = (unsigned*)(sc + SC_CNT); u16* LIST = (u16*)(sc + SC_LIST);
#pragma unroll 1
    for (int u = 0; u < 4; ++u) { const int qb = (u == 0) ? s : (u == 1) ? 15 - s : (u == 2) ? 16 + s : 31 - s;
        LAS unsigned* cnt = (LAS unsigned*)(shm + u * S1_STRIDE); LAS u16* lst = (LAS u16*)(shm + u * S1_STRIDE + 256);
        for (int j = wid; j < qb; j += NWAVES) {
            const unsigned c = cnt[j];
            if (lane == 0) CNT[(bh * 32 + j) * 32 + qb] = c;
            u16* dst = LIST + ((size_t)(bh * 32 + j) * 32 + qb) * 256;
            for (unsigned i = lane; i < c; i += 64) dst[i] = lst[j * 256 + i];
        } }
    asm volatile("s_waitcnt vmcnt(0) lgkmcnt(0)\n\ts_barrier" ::: "memory");
}

constexpr int S2_K = 0, S2_V = 32768, S2_LIST = 65536, S2_WS = S2_LIST + 16384, S2_STG = S2_WS + NWAVES * 256, S2_QP = S2_STG + NWAVES * 4096  , S2_END = S2_QP + NWAVES * 4096;
static_assert(S2_END <= MISC_OFF, "S2 LDS");

template <int NZ, int THR>
__device__ __forceinline__ void s2_pass(int r, int N, int b, int h, long rowbase, const bf16_t* QA, LAS u16* listc, char* shm, float* wsf, bf16_t* stg, bf16_t* PART, float* ML, int lane, int r32, int hi) {
    bf16x8 qr[NZ][4]; int qiv[NZ], slv[NZ]; bool vav[NZ];
#pragma unroll
    for (int z = 0; z < NZ; ++z) { const int e = 32 * (r + z * NWAVES) + r32; vav[z] = e < N; const unsigned ent = vav[z] ? (unsigned)listc[e] : 0u; qiv[z] = ent & 0x1fff; slv[z] = ent >> 13;
        const bf16_t* Qw = QA + (rowbase + qiv[z]) * 512 + h * 64;
#pragma unroll
        for (int d0 = 0; d0 < 4; ++d0) qr[z][d0] = *reinterpret_cast<const bf16x8*>(Qw + d0 * 16 + hi * 8); }
    float mhat[NZ], l_reg[NZ]; f32x16 o[NZ][2];
#pragma unroll
    for (int z = 0; z < NZ; ++z) { mhat[z] = 0.f; l_reg[z] = 0.f; o[z][0] = f32x16{}; o[z][1] = f32x16{}; }
#pragma unroll 1
    for (int t = 0; t < 4; ++t) {
        f32x16 p[NZ][2];
        { const char* kb = shm + S2_K + t * 8192 + hi * 1024 + r32 * 16;
#pragma unroll
          for (int d0 = 0; d0 < 4; ++d0) { const bf16x8 k0 = *reinterpret_cast<const bf16x8*>(kb + d0 * 2048), k1 = *reinterpret_cast<const bf16x8*>(kb + d0 * 2048 + 512);
#pragma unroll
              for (int z = 0; z < NZ; ++z) {
                  if (d0 == 0) { p[z][0] = MFMA32(k0, qr[z][0], f32x16{}); p[z][1] = MFMA32(k1, qr[z][0], f32x16{}); } else { p[z][0] = MFMA32(k0, qr[z][d0], p[z][0]); p[z][1] = MFMA32(k1, qr[z][d0], p[z][1]); } } } }
        float rm[NZ]; bool any = false;
#pragma unroll
        for (int z = 0; z < NZ; ++z) { rm[z] = rowmax(p[z][0], p[z][1]) - mhat[z]; any = any || (rm[z] > (float)THR); }
        if (t == 0) {
#pragma unroll
            for (int z = 0; z < NZ; ++z) mhat[z] = rm[z];
        } else if (__builtin_expect(__any(any), 0)) {
#pragma unroll
            for (int z = 0; z < NZ; ++z) { const float dl = __builtin_fmaxf(rm[z], 0.f); mhat[z] += dl; const float f = __builtin_amdgcn_exp2f(-dl); l_reg[z] *= f;
                if (hi == 0) wsf[r32] = f; asm volatile("s_waitcnt lgkmcnt(0)" ::: "memory");
#pragma unroll
                for (int d_ = 0; d_ < 2; ++d_)
#pragma unroll
                    for (int rr = 0; rr < 16; ++rr) o[z][d_][rr] *= wsf[crow(rr, hi)];
                asm volatile("s_waitcnt lgkmcnt(0)" ::: "memory"); }
        }
        u32x4 pw[NZ][4]; float sa[NZ][4];
#pragma unroll
        for (int z = 0; z < NZ; ++z) { sa[z][0] = 0.f; sa[z][1] = 0.f; sa[z][2] = 0.f; sa[z][3] = 0.f; }
#pragma unroll
        for (int rr = 0; rr < 16; ++rr)
#pragma unroll
            for (int z = 0; z < NZ; ++z) { const float mh = mhat[z]; p[z][0][rr] = __builtin_amdgcn_exp2f(p[z][0][rr] - mh); p[z][1][rr] = __builtin_amdgcn_exp2f(p[z][1][rr] - mh); sa[z][rr & 3] += p[z][0][rr] + p[z][1][rr]; }
#pragma unroll
        for (int z = 0; z < NZ; ++z) { l_reg[z] += (sa[z][0] + sa[z][1]) + (sa[z][2] + sa[z][3]);
            pw[z][0] = (u32x4){cvtpk(p[z][0][0], p[z][0][1]), cvtpk(p[z][0][2], p[z][0][3]), cvtpk(p[z][0][4], p[z][0][5]), cvtpk(p[z][0][6], p[z][0][7])};
            pw[z][1] = (u32x4){cvtpk(p[z][0][8], p[z][0][9]), cvtpk(p[z][0][10], p[z][0][11]), cvtpk(p[z][0][12], p[z][0][13]), cvtpk(p[z][0][14], p[z][0][15])};
            pw[z][2] = (u32x4){cvtpk(p[z][1][0], p[z][1][1]), cvtpk(p[z][1][2], p[z][1][3]), cvtpk(p[z][1][4], p[z][1][5]), cvtpk(p[z][1][6], p[z][1][7])};
            pw[z][3] = (u32x4){cvtpk(p[z][1][8], p[z][1][9]), cvtpk(p[z][1][10], p[z][1][11]), cvtpk(p[z][1][12], p[z][1][13]), cvtpk(p[z][1][14], p[z][1][15])}; }
        { const lds_cptr vp_ = (lds_cptr)shm + S2_V + t * 8192 + ((lane >> 4) & 1) * 32 + (lane & 3) * 8 + (4 * hi + ((lane & 15) >> 2)) * 64;
#pragma unroll
          for (int d0 = 0; d0 < 2; ++d0)
#pragma unroll
              for (int ks = 0; ks < 4; ++ks) { const s16x4 lo = vtr(vp_ + d0 * 4096 + ks * 1024), hh = vtr(vp_ + d0 * 4096 + ks * 1024 + 512);
                  const bf16x8 vf = {lo[0], lo[1], lo[2], lo[3], hh[0], hh[1], hh[2], hh[3]};
#pragma unroll
                  for (int z = 0; z < NZ; ++z) o[z][d0] = MFMA32(__builtin_bit_cast(bf16x8, pw[z][ks]), vf, o[z][d0]); } }
    }
#pragma unroll
    for (int z = 0; z < NZ; ++z) {
        float lz = l_reg[z];
        { auto rr = __builtin_amdgcn_permlane32_swap(__float_as_uint(lz), __float_as_uint(lz), false, false); lz = __uint_as_float(rr[0]) + __uint_as_float(rr[1]); }
        if (hi == 0) wsf[32 + r32] = lz; asm volatile("s_waitcnt lgkmcnt(0)" ::: "memory");
        float rli[16];
#pragma unroll
        for (int rr = 0; rr < 16; ++rr) rli[rr] = __builtin_amdgcn_rcpf(wsf[32 + crow(rr, hi)]);
#pragma unroll
        for (int rr = 0; rr < 16; ++rr) { const int orow = crow(rr, hi);
#pragma unroll
            for (int d0 = 0; d0 < 2; ++d0) stg[orow * 64 + d0 * 32 + r32] = (bf16_t)f2bf(o[z][d0][rr] * rli[rr]); }
        if (hi == 0 && vav[z]) { float* mlp = ML + ((size_t)(rowbase + qiv[z]) * 8 + h) * 8 + 2 * slv[z]; mlp[0] = mhat[z]; mlp[1] = lz; }
        asm volatile("s_waitcnt lgkmcnt(0)" ::: "memory");
#pragma unroll
        for (int i = 0; i < 4; ++i) { const int row = i * 8 + (lane >> 3), ch = lane & 7; const int e2 = 32 * (r + z * NWAVES) + row;
            if (e2 < N) { const unsigned en = (unsigned)listc[e2]; const int q2 = en & 0x1fff, s2 = en >> 13;
                *(u32x4*)(PART + (((size_t)(rowbase + q2) * 8 + h) * 3 + s2) * 64 + ch * 8) = *(const u32x4*)(stg + row * 64 + ch * 8); } }
        asm volatile("s_waitcnt lgkmcnt(0)" ::: "memory");
    }
}

template <int THRL>
__device__ __forceinline__ void s2_chain(int N, int ntile, int wid, int h, long rowbase, const bf16_t* QA, LAS u16* listc, char* shm, float* wsf, bf16_t* stg, bf16_t* PART, float* ML, int lane, int r32, int hi) {
    if (wid >= ntile) return;
    const lds_cptr shm3 = (lds_cptr)shm; const lds_cptr kp0 = shm3 + S2_K + hi * 1024 + r32 * 16;
    const lds_cptr vp0 = shm3 + S2_V + ((lane >> 4) & 1) * 32 + (lane & 3) * 8 + (4 * hi + ((lane & 15) >> 2)) * 64;
    const int vb0 = (int)((unsigned)(uintptr_t)shm + S2_V) + ((lane >> 4) & 1) * 32 + (lane & 3) * 8 + (4 * hi + ((lane & 15) >> 2)) * 64;
    bf16x8 kf[8], qr[4]; f32x16 o[2], negm, pA0, pA1, pB0, pB1; s16x4 vlo[8], vhi[8]; u32x4 pw0, pw1, pw2, pw3;
    float mhat = 0.f, l_reg = 0.f; bool resc = false;
    int r = wid; unsigned ent, entn = 0u;
    const unsigned qpd = (unsigned)(uintptr_t)shm + S2_QP + wid * 4096; const lds_cptr qpr = shm3 + S2_QP + wid * 4096 + lane * 16;
#define S2C_DMAQ(R_, E_) do { const int e_ = 32 * (R_) + r32; E_ = (e_ < N) ? (0x8000u | (unsigned)listc[e_]) : 0u; const bf16_t* Qw_ = QA + (rowbase + ((E_) & 0x1fff)) * 512 + h * 64 + hi * 8; \
        _Pragma("unroll") for (int d0 = 0; d0 < 4; ++d0) glds16(Qw_ + d0 * 16, (unsigned)__builtin_amdgcn_readfirstlane(qpd + d0 * 1024)); } while (0)
#define S2C_TAKEQ() do { asm volatile("s_waitcnt vmcnt(0)" ::: "memory"); _Pragma("unroll") for (int d0 = 0; d0 < 4; ++d0) qr[d0] = ldsfrag(qpr + d0 * 1024); } while (0)
#define S2C_FINAL(R_, E_, MH_) do { float lz = l_reg; \
        { auto rr = __builtin_amdgcn_permlane32_swap(__float_as_uint(lz), __float_as_uint(lz), false, false); lz = __uint_as_float(rr[0]) + __uint_as_float(rr[1]); } \
        if (hi == 0) wsf[32 + r32] = lz; asm volatile("s_waitcnt lgkmcnt(0)" ::: "memory"); \
        float rli[16]; _Pragma("unroll") for (int rr = 0; rr < 16; ++rr) rli[rr] = __builtin_amdgcn_rcpf(wsf[32 + crow(rr, hi)]); \
        _Pragma("unroll") for (int rr = 0; rr < 16; ++rr) { const int orow = crow(rr, hi); _Pragma("unroll") for (int d0 = 0; d0 < 2; ++d0) stg[orow * 64 + d0 * 32 + r32] = (bf16_t)f2bf(o[d0][rr] * rli[rr]); } \
        if (hi == 0 && ((E_) & 0x8000u)) { float* mlp = ML + ((size_t)(rowbase + ((E_) & 0x1fff)) * 8 + h) * 8 + 2 * (((E_) >> 13) & 3); mlp[0] = (MH_); mlp[1] = lz; } \
        asm volatile("s_waitcnt lgkmcnt(0)" ::: "memory"); \
        _Pragma("unroll") for (int i = 0; i < 4; ++i) { const int row = i * 8 + (lane >> 3), ch = lane & 7; const int e2 = 32 * (R_) + row; \
            if (e2 < N) { const unsigned en = (unsigned)listc[e2]; const int q2 = en & 0x1fff, s2 = en >> 13; \
                *(u32x4*)(PART + (((size_t)(rowbase + q2) * 8 + h) * 3 + s2) * 64 + ch * 8) = *(const u32x4*)(stg + row * 64 + ch * 8); } } \
        asm volatile("s_waitcnt lgkmcnt(0)" ::: "memory"); } while (0)
#define S2C_PKW(P, B) cvtpk(P[B], P[B + 1])
#define S2C_PAF(k) __builtin_bit_cast(bf16x8, pw##k)
#define S2C_VFR(i) (bf16x8){vlo[i][0], vlo[i][1], vlo[i][2], vlo[i][3], vhi[i][0], vhi[i][1], vhi[i][2], vhi[i][3]}
#define S2C_PIN(x) asm volatile("" : "+v"(x))
#define S2C_GAPA(MF, A0, A1, A2, A3, W0, W1, PW) do { MF; sacc += A0; sacc += A1; sacc += A2; sacc += A3; S2C_PIN(sacc); W0; W1; S2C_PIN(PW); SBAR(); } while (0)
#define S2C_EX(v) __builtin_amdgcn_exp2f(v)
#define S2C_GAPB(MF, X, B) do { MF; X[B] = S2C_EX(X[B]); X[B + 1] = S2C_EX(X[B + 1]); X[B + 2] = S2C_EX(X[B + 2]); X[B + 3] = S2C_EX(X[B + 3]); S2C_PIN(X); SBAR(); } while (0)
#define S2C_VRD(i) do { vlo[i] = vtr(vp_ + (((i) >> 2) * 4096 + ((i) & 3) * 1024)); vhi[i] = vtr(vp_ + (((i) >> 2) * 4096 + ((i) & 3) * 1024 + 512)); } while (0)
#define S2C_KRD(j) do { kload2(kf, kp0 + KN_, j); SBAR(); } while (0)
#define S2C_STEP(C0, C1, P0, P1, T_, BND) do { SBAR(); \
    const lds_cptr vp_ = vp0 + (((T_) + 3) & 3) * 8192; constexpr int KN_ = (((T_) + 1) & 3) * 8192; \
    S2C_VRD(0); SBAR(); float sacc = (P0[0] + P0[1]); \
    S2C_GAPA(C0 = MFMA32(kf[0], qr[0], negm), P0[2], P0[3], P0[4], P0[5],     pw0[0] = S2C_PKW(P0, 0),  pw0[1] = S2C_PKW(P0, 2),  pw0); \
    S2C_VRD(4); SBAR(); S2C_GAPA(C1 = MFMA32(kf[1], qr[0], negm), P0[6], P0[7], P0[8], P0[9],     pw0[2] = S2C_PKW(P0, 4),  pw0[3] = S2C_PKW(P0, 6),  pw0); \
    S2C_VRD(1); SBAR(); S2C_GAPA(C0 = MFMA32(kf[2], qr[1], C0),   P0[10], P0[11], P0[12], P0[13], pw1[0] = S2C_PKW(P0, 8),  pw1[1] = S2C_PKW(P0, 10), pw1); \
    S2C_VRD(5); SBAR(); S2C_GAPA(C1 = MFMA32(kf[3], qr[1], C1),   P0[14], P0[15], P1[0], P1[1],   pw1[2] = S2C_PKW(P0, 12), pw1[3] = S2C_PKW(P0, 14), pw1); \
    S2C_VRD(2); SBAR(); S2C_GAPA(C0 = MFMA32(kf[4], qr[2], C0),   P1[2], P1[3], P1[4], P1[5],     pw2[0] = S2C_PKW(P1, 0),  pw2[1] = S2C_PKW(P1, 2),  pw2); \
    S2C_VRD(6); SBAR(); S2C_GAPA(C1 = MFMA32(kf[5], qr[2], C1),   P1[6], P1[7], P1[8], P1[9],     pw2[2] = S2C_PKW(P1, 4),  pw2[3] = S2C_PKW(P1, 6),  pw2); \
    S2C_VRD(3); SBAR(); S2C_GAPA(C0 = MFMA32(kf[6], qr[3], C0),   P1[10], P1[11], P1[12], P1[13], pw3[0] = S2C_PKW(P1, 8),  pw3[1] = S2C_PKW(P1, 10), pw3); \
    S2C_VRD(7); SBAR(); S2C_GAPA(C1 = MFMA32(kf[7], qr[3], C1),   P1[14], P1[15], 0.f, 0.f,       pw3[2] = S2C_PKW(P1, 12), pw3[3] = S2C_PKW(P1, 14), pw3); \
    l_reg += sacc; \
    { float a = MX3(C0[0], C0[1], C1[0]), b_ = MX3(C0[2], C0[3], C1[1]); a = MX3(a, C1[2], C1[3]); \
      _Pragma("unroll") for (int rr = 4; rr < 16; rr += 4) { a = MX3(a, C0[rr], C0[rr + 1]); b_ = MX3(b_, C0[rr + 2], C0[rr + 3]); a = MX3(a, C1[rr], C1[rr + 1]); b_ = MX3(b_, C1[rr + 2], C1[rr + 3]); } \
      float rm = __builtin_fmaxf(a, b_); { auto rr = __builtin_amdgcn_permlane32_swap(__float_as_uint(rm), __float_as_uint(rm), false, false); rm = __builtin_fmaxf(__uint_as_float(rr[0]), __uint_as_float(rr[1])); } \
      resc = false; \
      if (BND) { mhat = rm;                                             \
        _Pragma("unroll") for (int rr = 0; rr < 16; ++rr) { C0[rr] -= rm; C1[rr] -= rm; } \
        _Pragma("unroll") for (int rr = 0; rr < 16; ++rr) negm[rr] = -rm; asm volatile("" : "+v"(negm)); } \
      else if (__builtin_expect(__any(rm > (float)THRL), 0)) { const float dl = __builtin_fmaxf(rm, 0.f); mhat += dl; \
        _Pragma("unroll") for (int rr = 0; rr < 16; ++rr) { C0[rr] -= dl; C1[rr] -= dl; } \
        _Pragma("unroll") for (int rr = 0; rr < 16; ++rr) negm[rr] -= dl; asm volatile("" : "+v"(negm)); \
        const float f = __builtin_amdgcn_exp2f(-dl); l_reg *= f; if (hi == 0) wsf[r32] = f; resc = true; } } \
    SBAR(); \
    S2C_GAPB(o[0] = MFMA32(S2C_PAF(0), S2C_VFR(0), o[0]), C0, 0); \
    S2C_GAPB(o[1] = MFMA32(S2C_PAF(0), S2C_VFR(4), o[1]), C0, 4); \
    S2C_KRD(0); S2C_GAPB(o[0] = MFMA32(S2C_PAF(1), S2C_VFR(1), o[0]), C0, 8); \
    S2C_KRD(1); S2C_GAPB(o[1] = MFMA32(S2C_PAF(1), S2C_VFR(5), o[1]), C0, 12); \
    S2C_KRD(2); S2C_GAPB(o[0] = MFMA32(S2C_PAF(2), S2C_VFR(2), o[0]), C1, 0); \
    S2C_KRD(3); S2C_GAPB(o[1] = MFMA32(S2C_PAF(2), S2C_VFR(6), o[1]), C1, 4); \
    S2C_GAPB(o[0] = MFMA32(S2C_PAF(3), S2C_VFR(3), o[0]), C1, 8); \
    S2C_GAPB(o[1] = MFMA32(S2C_PAF(3), S2C_VFR(7), o[1]), C1, 12); \
    } while (0)
#define S2C_RESC() do { if (resc) { asm volatile("s_waitcnt lgkmcnt(0)" ::: "memory"); \
        _Pragma("unroll") for (int d_ = 0; d_ < 2; ++d_) _Pragma("unroll") for (int rr = 0; rr < 16; ++rr) o[d_][rr] *= wsf[crow(rr, hi)]; } } while (0)
    S2C_DMAQ(r, ent); S2C_TAKEQ();
    o[0] = f32x16{}; o[1] = f32x16{};
#pragma unroll
    for (int rr = 0; rr < 16; ++rr) negm[rr] = 0.f;
    asm volatile("" : "+v"(negm));
    {
#pragma unroll
      for (int d0 = 0; d0 < 4; ++d0) { const bf16x8 k0 = ldsfrag(kp0 + d0 * 2048), k1 = ldsfrag(kp0 + d0 * 2048 + 512);
          if (d0 == 0) { pA0 = MFMA32(k0, qr[0], negm); pA1 = MFMA32(k1, qr[0], negm); } else { pA0 = MFMA32(k0, qr[d0], pA0); pA1 = MFMA32(k1, qr[d0], pA1); } } }
    { const float rm = rowmax(pA0, pA1); mhat = rm;
#pragma unroll
      for (int rr = 0; rr < 16; ++rr) { pA0[rr] -= rm; pA1[rr] -= rm; negm[rr] = -rm; }
      asm volatile("" : "+v"(negm));
#pragma unroll
      for (int rr = 0; rr < 16; ++rr) { pA0[rr] = __builtin_amdgcn_exp2f(pA0[rr]); pA1[rr] = __builtin_amdgcn_exp2f(pA1[rr]); } }
#pragma unroll
    for (int j = 0; j < 4; ++j) kload2(kf, kp0 + 8192, j);
    for (;;) {
        S2C_STEP(pB0, pB1, pA0, pA1, 1, false); S2C_RESC();
        const int rn = r + NWAVES; const bool more = rn < ntile;
        if (more) S2C_DMAQ(rn, entn);
        S2C_STEP(pA0, pA1, pB0, pB1, 2, false); S2C_RESC();
        S2C_STEP(pB0, pB1, pA0, pA1, 3, false); S2C_RESC();
        if (!more) break;
        S2C_TAKEQ();
#pragma unroll
        for (int rr = 0; rr < 16; ++rr) negm[rr] = 0.f;
        asm volatile("" : "+v"(negm));
        const float mh_old = mhat;
        S2C_STEP(pA0, pA1, pB0, pB1, 0, true);
        S2C_FINAL(r, ent, mh_old);
        o[0] = f32x16{}; o[1] = f32x16{}; l_reg = 0.f;
        r = rn; ent = entn;
    }
    { float sacc = pB0[0] + pB0[1];
#pragma unroll
      for (int rr = 2; rr < 16; ++rr) sacc += pB0[rr];
#pragma unroll
      for (int rr = 0; rr < 16; ++rr) sacc += pB1[rr];
      l_reg += sacc;
      pw0 = (u32x4){S2C_PKW(pB0, 0), S2C_PKW(pB0, 2), S2C_PKW(pB0, 4), S2C_PKW(pB0, 6)}; pw1 = (u32x4){S2C_PKW(pB0, 8), S2C_PKW(pB0, 10), S2C_PKW(pB0, 12), S2C_PKW(pB0, 14)};
      pw2 = (u32x4){S2C_PKW(pB1, 0), S2C_PKW(pB1, 2), S2C_PKW(pB1, 4), S2C_PKW(pB1, 6)}; pw3 = (u32x4){S2C_PKW(pB1, 8), S2C_PKW(pB1, 10), S2C_PKW(pB1, 12), S2C_PKW(pB1, 14)};
      SBAR(); pv(o, vb0 + 3 * 8192, S2C_PAF(0), S2C_PAF(1), S2C_PAF(2), S2C_PAF(3)); }
    S2C_FINAL(r, ent, mhat);
#undef S2C_DMAQ
#undef S2C_TAKEQ
#undef S2C_FINAL
#undef S2C_PKW
#undef S2C_PAF
#undef S2C_VFR
#undef S2C_PIN
#undef S2C_GAPA
#undef S2C_EX
#undef S2C_GAPB
#undef S2C_VRD
#undef S2C_KRD
#undef S2C_STEP
#undef S2C_RESC
}


__device__ __forceinline__ void merge_block(int b, int h, int qb, bf16_t* MO, const unsigned char* sc, const bf16_t* PARTO, const int tid0) {
    int tid_ = tid0; asm volatile("" : "+v"(tid_));
    const int tid = tid_, lane = tid & 63; const int wid = __builtin_amdgcn_readfirstlane(tid >> 6);
    const bf16_t* PART = (const bf16_t*)(sc + SC_PART); const float* ML = (const float*)(sc + SC_ML);
    const long row0 = (long)b * S + qb * 256 + wid * 32;
    u32x4 pp[4][4]; f32x4 mla[4], mlb[4];
#pragma unroll
    for (int i = 0; i < 4; ++i) { const int row = i * 8 + (lane >> 3), ch = lane & 7; const size_t th = (size_t)(row0 + row) * 8 + h;
        mla[i] = *(const f32x4*)(ML + th * 8); mlb[i] = *(const f32x4*)(ML + th * 8 + 4);
#pragma unroll
        for (int k = 0; k < 3; ++k) pp[i][k] = *(const u32x4*)(PART + (th * 3 + k) * 64 + ch * 8);
        pp[i][3] = *(const u32x4*)(PARTO + th * 64 + ch * 8); }
#pragma unroll
    for (int i = 0; i < 4; ++i) { const int row = i * 8 + (lane >> 3), ch = lane & 7;
        const float m0 = mla[i][0], l0 = mla[i][1], m1 = mla[i][2], l1 = mla[i][3], m2 = mlb[i][0], l2 = mlb[i][1], m3 = mlb[i][2], l3 = mlb[i][3];
        const float M = __builtin_fmaxf(__builtin_fmaxf(m3, m0), __builtin_fmaxf(m1, m2));
        const float w3 = l3 * __builtin_amdgcn_exp2f(m3 - M), w0 = l0 * __builtin_amdgcn_exp2f(m0 - M), w1 = l1 * __builtin_amdgcn_exp2f(m1 - M), w2 = l2 * __builtin_amdgcn_exp2f(m2 - M);
        const float inv = __builtin_amdgcn_rcpf((w3 + w0) + (w1 + w2));
        const bool u0 = l0 > 0.f, u1 = l1 > 0.f, u2 = l2 > 0.f;
        const u32x4 p0 = pp[i][0], p1 = pp[i][1], p2 = pp[i][2], p3 = pp[i][3];
        unsigned ow[4];
#pragma unroll
        for (int c = 0; c < 4; ++c) { float lo = w3 * bflo(p3[c]), hi_ = w3 * bfhi(p3[c]);
            if (u0) { lo += w0 * bflo(p0[c]); hi_ += w0 * bfhi(p0[c]); } if (u1) { lo += w1 * bflo(p1[c]); hi_ += w1 * bfhi(p1[c]); } if (u2) { lo += w2 * bflo(p2[c]); hi_ += w2 * bfhi(p2[c]); }
            ow[c] = pk2(lo * inv, hi_ * inv); }
        *(u32x4*)(MO + (size_t)(row0 + row) * 512 + h * 64 + ch * 8) = (u32x4){ow[0], ow[1], ow[2], ow[3]}; }
}
template <int THR>
__device__ __forceinline__ void own_pass(int j, int rt, int h, long rowbase, const bf16_t* QA, char* shm, float* wsf, bf16_t* stg, bf16_t* PARTO, float* ML, int lane, int r32, int hi) {
    const int qrel = rt * 32 + r32, q = j * 256 + qrel;
    bf16x8 qr[4];
    { const bf16_t* Qw = QA + (rowbase + q) * 512 + h * 64;
#pragma unroll
      for (int d0 = 0; d0 < 4; ++d0) qr[d0] = *reinterpret_cast<const bf16x8*>(Qw + d0 * 16 + hi * 8); }
    float mhat = 0.f, l_reg = 0.f; f32x16 o[2]; o[0] = f32x16{}; o[1] = f32x16{};
    const int tlast = rt >> 1;
#pragma unroll 1
    for (int t = 0; t <= tlast; ++t) {
        f32x16 p0, p1;
        { const char* kb = shm + S2_K + t * 8192 + hi * 1024 + r32 * 16;
#pragma unroll
          for (int d0 = 0; d0 < 4; ++d0) { const bf16x8 k0 = *reinterpret_cast<const bf16x8*>(kb + d0 * 2048), k1 = *reinterpret_cast<const bf16x8*>(kb + d0 * 2048 + 512);
              if (d0 == 0) { p0 = MFMA32(k0, qr[0], f32x16{}); p1 = MFMA32(k1, qr[0], f32x16{}); } else { p0 = MFMA32(k0, qr[d0], p0); p1 = MFMA32(k1, qr[d0], p1); } } }
        if (t == tlast) cmask(p0, p1, t, qrel, hi);
        const float rm = rowmax(p0, p1) - mhat;
        if (t == 0) mhat = rm;
        else if (__builtin_expect(__any(rm > (float)THR), 0)) { const float dl = __builtin_fmaxf(rm, 0.f); mhat += dl; const float f = __builtin_amdgcn_exp2f(-dl); l_reg *= f;
            if (hi == 0) wsf[r32] = f; asm volatile("s_waitcnt lgkmcnt(0)" ::: "memory");
#pragma unroll
            for (int d_ = 0; d_ < 2; ++d_)
#pragma unroll
                for (int rr = 0; rr < 16; ++rr) o[d_][rr] *= wsf[crow(rr, hi)];
            asm volatile("s_waitcnt lgkmcnt(0)" ::: "memory"); }
        u32x4 pw[4]; float sa[4] = {0.f, 0.f, 0.f, 0.f};
#pragma unroll
        for (int rr = 0; rr < 16; ++rr) { p0[rr] = __builtin_amdgcn_exp2f(p0[rr] - mhat); p1[rr] = __builtin_amdgcn_exp2f(p1[rr] - mhat); sa[rr & 3] += p0[rr] + p1[rr]; }
        l_reg += (sa[0] + sa[1]) + (sa[2] + sa[3]);
        pw[0] = (u32x4){cvtpk(p0[0], p0[1]), cvtpk(p0[2], p0[3]), cvtpk(p0[4], p0[5]), cvtpk(p0[6], p0[7])};
        pw[1] = (u32x4){cvtpk(p0[8], p0[9]), cvtpk(p0[10], p0[11]), cvtpk(p0[12], p0[13]), cvtpk(p0[14], p0[15])};
        pw[2] = (u32x4){cvtpk(p1[0], p1[1]), cvtpk(p1[2], p1[3]), cvtpk(p1[4], p1[5]), cvtpk(p1[6], p1[7])};
        pw[3] = (u32x4){cvtpk(p1[8], p1[9]), cvtpk(p1[10], p1[11]), cvtpk(p1[12], p1[13]), cvtpk(p1[14], p1[15])};
        { const lds_cptr vp_ = (lds_cptr)shm + S2_V + t * 8192 + ((lane >> 4) & 1) * 32 + (lane & 3) * 8 + (4 * hi + ((lane & 15) >> 2)) * 64;
#pragma unroll
          for (int d0 = 0; d0 < 2; ++d0)
#pragma unroll
              for (int ks = 0; ks < 4; ++ks) { const s16x4 lo = vtr(vp_ + d0 * 4096 + ks * 1024), hh = vtr(vp_ + d0 * 4096 + ks * 1024 + 512);
                  const bf16x8 vf = {lo[0], lo[1], lo[2], lo[3], hh[0], hh[1], hh[2], hh[3]};
                  o[d0] = MFMA32(__builtin_bit_cast(bf16x8, pw[ks]), vf, o[d0]); } }
    }
    float lz = l_reg;
    { auto rr = __builtin_amdgcn_permlane32_swap(__float_as_uint(lz), __float_as_uint(lz), false, false); lz = __uint_as_float(rr[0]) + __uint_as_float(rr[1]); }
    if (hi == 0) wsf[32 + r32] = lz; asm volatile("s_waitcnt lgkmcnt(0)" ::: "memory");
    float rli[16];
#pragma unroll
    for (int rr = 0; rr < 16; ++rr) rli[rr] = __builtin_amdgcn_rcpf(wsf[32 + crow(rr, hi)]);
#pragma unroll
    for (int rr = 0; rr < 16; ++rr) { const int orow = crow(rr, hi);
#pragma unroll
        for (int d0 = 0; d0 < 2; ++d0) stg[orow * 64 + d0 * 32 + r32] = (bf16_t)f2bf(o[d0][rr] * rli[rr]); }
    if (hi == 0) { float* mlp = ML + ((size_t)(rowbase + q) * 8 + h) * 8 + 6; mlp[0] = mhat; mlp[1] = lz; }
    asm volatile("s_waitcnt lgkmcnt(0)" ::: "memory");
#pragma unroll
    for (int i = 0; i < 4; ++i) { const int row = i * 8 + (lane >> 3), ch = lane & 7;
        *(u32x4*)(PARTO + ((size_t)(rowbase + j * 256 + rt * 32 + row) * 8 + h) * 64 + ch * 8) = *(const u32x4*)(stg + row * 64 + ch * 8); }
    asm volatile("s_waitcnt lgkmcnt(0)" ::: "memory");
}
template <int THR>
__device__ __forceinline__ void sparse_item(int b, int h, int j, const bf16_t* QA, const bf16_t* KA, const bf16_t* VA, unsigned char* sc, bf16_t* PARTO, char* shm, const int tid0) {
    int tid_ = tid0; asm volatile("" : "+v"(tid_));
    const int tid = tid_, lane = tid & 63, r32 = lane & 31, hi = lane >> 5; const int wid = __builtin_amdgcn_readfirstlane(tid >> 6);
    const int bh = b * 8 + h; const long rowbase = (long)b * S;
    const unsigned lds0 = (unsigned)(uintptr_t)shm;
    { const bf16_t* ksrc = KA + (rowbase + j * 256 + lane) * 512 + h * 64 + wid * 8;
      const bf16_t* vsrc = VA + (rowbase + j * 256 + 16 * (wid & 3) + (lane >> 2)) * 512 + h * 64 + (wid >> 2) * 32 + (lane & 3) * 8;
#pragma unroll
      for (int t = 0; t < 4; ++t) { glds16(ksrc + (long)t * 64 * 512, (unsigned)__builtin_amdgcn_readfirstlane(lds0 + S2_K + t * 8192 + wid * 1024));
                                    glds16(vsrc + (long)t * 64 * 512, (unsigned)__builtin_amdgcn_readfirstlane(lds0 + S2_V + t * 8192 + wid * 1024)); } }
    const unsigned* CNT = (const unsigned*)(sc + SC_CNT) + (bh * 32 + j) * 32; const u16* LIST = (const u16*)(sc + SC_LIST) + (size_t)(bh * 32 + j) * 32 * 256;
    LAS u16* listc = (LAS u16*)(shm + S2_LIST);
    unsigned c_ = (r32 > j) ? CNT[r32] : 0u;
    unsigned inc = c_;
#pragma unroll
    for (int o = 1; o < 32; o <<= 1) { const unsigned v = __shfl_up(inc, o, 32); if (r32 >= o) inc += v; }
    const unsigned pre = inc - c_; const int N = (int)__shfl(inc, 31, 32);
    for (int qq = j + 1 + wid; qq < 32; qq += NWAVES) {
        const unsigned c = __shfl(c_, qq, 32), base = __shfl(pre, qq, 32);
        for (unsigned i = lane; i < c; i += 64) listc[base + i] = LIST[(size_t)qq * 256 + i];
    }
    asm volatile("s_waitcnt vmcnt(0) lgkmcnt(0)\n\ts_barrier" ::: "memory");
    const int ntile = (N + 31) >> 5;
    float* wsf = (float*)(shm + S2_WS) + wid * 64;
    bf16_t* stg = (bf16_t*)(shm + S2_STG + wid * 4096);
    bf16_t* PART = (bf16_t*)(sc + SC_PART); float* ML = (float*)(sc + SC_ML);
#ifndef S2_SIMPLE
    own_pass<THR>(j, wid, h, rowbase, QA, shm, wsf, stg, PARTO, ML, lane, r32, hi);
    s2_chain<THR>(N, ntile, wid, h, rowbase, QA, listc, shm, wsf, stg, PART, ML, lane, r32, hi);
#else
    for (int r = wid; r < ntile; r += 2 * NWAVES) {
        if (r + NWAVES < ntile) s2_pass<2, THR>(r, N, b, h, rowbase, QA, listc, shm, wsf, stg, PART, ML, lane, r32, hi);
        else s2_pass<1, THR>(r, N, b, h, rowbase, QA, listc, shm, wsf, stg, PART, ML, lane, r32, hi);
    }
#endif
    asm volatile("s_waitcnt vmcnt(0) lgkmcnt(0)\n\ts_barrier" ::: "memory");
}

} }
#ifndef MK_PHMASK
#define MK_PHMASK 0x3ff
#endif
#ifndef MK_DUP
#define MK_DUP -1
#endif
#define NREP(k) ((MK_DUP == (k)) ? 2 : 1)
#ifndef MLA_UNIT
#define MLA_UNIT att::ATT_UNIT
#endif
namespace mk {
struct Args { const float* in[18]; float* out; unsigned char* ws; int ph_lo, ph_hi; };

__device__ __forceinline__ int pair32(int rem, int half) { const int fq = rem >> 3, n = (rem >> 2) & 1, i = rem & 3; return n * half + fq * 4 + i; }
struct SrcWin { __device__ __forceinline__ int operator()(int j) const {
    const int pn = j >> 8, jl = j & 255;
    if (pn < 4) { const int hj = j & 511, head = hj >> 6, jj = hj & 63, w = jj >> 5, rem = jj & 31; const int fq = rem >> 3, n = (rem >> 2) & 1, i = rem & 3;
        return (pn < 2 ? 0 : 512) + head * 64 + n * 32 + w * 16 + fq * 4 + i; }
    if (pn < 7) return j;
    if (pn == 7) { if (jl < 128) return 1792 + jl; if (jl < 160) return 1920 + pair32(jl - 128, 16); return -1; }
    return 1952 + (j - 2048);
} };
struct SrcWqb { __device__ __forceinline__ int operator()(int j) const { const int G = j >> 5, head = G / 3, part = G - 3 * head, rem = j & 31; return head * 96 + (part < 2 ? part * 32 + rem : 64 + pair32(rem, 16)); } };
struct SrcWgu { __device__ __forceinline__ int operator()(int j) const { const int pn = j >> 8, bj = (j >> 7) & 1, jj = j & 127; return bj * DFF + 128 * pn + jj; } };
struct SrcId { __device__ __forceinline__ int operator()(int j) const { return j; } };

template <class F>
__device__ __forceinline__ void transpose_item(const float* W, int Ksrc, int Nsrc, const float* gain, bf16_t* WT, int Kd, F src, LAS float* scr, int item, int nblk, int lane, int koff = 0) {
    const int kb = item / nblk, nb = item % nblk, k0 = 64 * kb, n0 = 32 * nb;
    const int kr = lane >> 3, jb = lane & 7;
    const int sc = src(n0 + 4 * jb);
    f32x4 v[8]; float gk[8];
#pragma unroll
    for (int i = 0; i < 8; ++i) { const int k = k0 + 8 * i + kr; v[i] = (f32x4){0.f, 0.f, 0.f, 0.f}; gk[i] = 1.f;
        if (sc >= 0 && k < Ksrc) { v[i] = *(const GAS f32x4*)(W + (size_t)k * Nsrc + sc); if (gain) gk[i] = gain[k]; } }
#pragma unroll
    for (int i = 0; i < 8; ++i) { LAS float* d = scr + (8 * i + kr) * 33 + 4 * jb; d[0] = v[i][0] * gk[i]; d[1] = v[i][1] * gk[i]; d[2] = v[i][2] * gk[i]; d[3] = v[i][3] * gk[i]; }
    LDS_WAIT(); asm volatile("" ::: "memory");
    const int c = lane & 7;
#pragma unroll
    for (int j = 0; j < 4; ++j) { const int n = (lane >> 3) + 8 * j; const LAS float* s = scr + (8 * c) * 33 + n;
        u32x4 o; o.x = pk2(s[0 * 33], s[1 * 33]); o.y = pk2(s[2 * 33], s[3 * 33]); o.z = pk2(s[4 * 33], s[5 * 33]); o.w = pk2(s[6 * 33], s[7 * 33]);
        *(GAS u32x4*)(WT + (size_t)(n0 + n) * Kd + koff + k0 + 8 * c) = o; }
    LDS_WAIT(); asm volatile("" ::: "memory");
}
__device__ __forceinline__ float wave_sum(float v) {
#pragma unroll
    for (int o = 1; o < 64; o <<= 1) v += __shfl_xor(v, o);
    return v;
}

struct Frame { LAS unsigned char* lds; int vcu, G, wave_s; };
#define F_LANE ((int)__builtin_amdgcn_mbcnt_hi(~0u, __builtin_amdgcn_mbcnt_lo(~0u, 0u)))
#define F_WAVE (F.wave_s)
#define F_TID (F.wave_s * 64 + F_LANE)

__device__ __forceinline__ void p0_prologue(const Frame& F, const Args& A) {
    LAS float* scr = (LAS float*)(F.lds + F_WAVE * 16384);
    const int gw = F.vcu * NWAVES + F_WAVE, NGW = F.G * NWAVES;
    unsigned char* ws = A.ws;
    constexpr int I_WIN = 16 * 128, I_WGU = 16 * 176, I_WD = 44 * 32, I_WO = 16 * 32, I_WPG = 16 * 32, I_WMB = 8 * 32, I_WML = 8 * 32, I_WQB = 4 * 24, I_WKVB = 4 * 32, I_WPP = 4 * 32;
    constexpr int NITEMS = I_WIN + I_WGU + I_WD + I_WO + I_WPG + I_WMB + I_WML + I_WQB + I_WKVB + I_WPP;
    for (int it = gw; it < NITEMS; it += NGW) {
        int r = it;
        if (r < I_WIN) { transpose_item(A.in[3], 1024, 4000, A.in[2], (bf16_t*)(ws + WS_WIN), 1024, SrcWin(), scr, r, 128, F_LANE); continue; } r -= I_WIN;
        if (r < I_WGU) { transpose_item(A.in[12], 1024, 2 * DFF, A.in[11], (bf16_t*)(ws + WS_WGU), 1024, SrcWgu(), scr, r, 176, F_LANE); continue; } r -= I_WGU;
        if (r < I_WD) { transpose_item(A.in[13], DFF, 1024, nullptr, (bf16_t*)(ws + WS_WD), DFF, SrcId(), scr, r, 32, F_LANE); continue; } r -= I_WD;
        if (r < I_WO) { transpose_item(A.in[10], 1024, 1024, nullptr, (bf16_t*)(ws + WS_WO), 1024, SrcId(), scr, r, 32, F_LANE); continue; } r -= I_WO;
        if (r < I_WPG) { transpose_item(A.in[15], 1024, 1024, A.in[14], (bf16_t*)(ws + WS_WPG), 1024, SrcId(), scr, r, 32, F_LANE); continue; } r -= I_WPG;
        if (r < I_WMB) { transpose_item(A.in[8], 512, 1024, nullptr, (bf16_t*)(ws + WS_WBR), 1024, SrcId(), scr, r, 32, F_LANE, 0); continue; } r -= I_WMB;
        if (r < I_WML) { transpose_item(A.in[9], 512, 1024, nullptr, (bf16_t*)(ws + WS_WBR), 1024, SrcId(), scr, r, 32, F_LANE, 512); continue; } r -= I_WML;
        if (r < I_WQB) { transpose_item(A.in[5], 256, 768, A.in[4], (bf16_t*)(ws + WS_WQB), 256, SrcWqb(), scr, r, 24, F_LANE); continue; } r -= I_WQB;
        if (r < I_WKVB) { transpose_item(A.in[7], 128, 1024, A.in[6], (bf16_t*)(ws + WS_WKVB), 256, SrcId(), scr, r, 32, F_LANE); continue; } r -= I_WKVB;
        transpose_item(A.in[16], 256, 1024, nullptr, (bf16_t*)(ws + WS_WPP), 256, SrcId(), scr, r, 32, F_LANE);
    }
    const float* x = A.in[0]; const float* p = A.in[1]; bf16_t* XB = (bf16_t*)(ws + WS_XB); bf16_t* PB = (bf16_t*)(ws + WS_PB); float* rstd0 = (float*)(ws + WS_RSTD0);
    for (int m0 = gw * 4; m0 < T; m0 += NGW * 4) {
        f32x4 v[4][4], pv_[4];
#pragma unroll
        for (int rr = 0; rr < 4; ++rr) { const GAS f32x4* xr = (const GAS f32x4*)(x + (size_t)(m0 + rr) * D) + F_LANE;
#pragma unroll
            for (int j = 0; j < 4; ++j) v[rr][j] = __builtin_nontemporal_load(xr + 64 * j);
            pv_[rr] = __builtin_nontemporal_load((const GAS f32x4*)(p + (size_t)(m0 + rr) * 256) + F_LANE); }
#pragma unroll
        for (int rr = 0; rr < 4; ++rr) { const int m = m0 + rr; float s = 0.f;
#pragma unroll
            for (int j = 0; j < 4; ++j) s += (v[rr][j][0] * v[rr][j][0] + v[rr][j][1] * v[rr][j][1]) + (v[rr][j][2] * v[rr][j][2] + v[rr][j][3] * v[rr][j][3]);
            s = wave_sum(s);
            GAS u32x2* o8 = (GAS u32x2*)(XB + (size_t)m * D) + F_LANE;
#pragma unroll
            for (int j = 0; j < 4; ++j) o8[64 * j] = pack4(v[rr][j]);
            if (F_LANE == 0) rstd0[m] = 1.0f / sqrtf(s * (1.0f / 1024.0f) + EPS);
            *((GAS u32x2*)(PB + (size_t)m * 256) + F_LANE) = pack4(pv_[rr]); }
    }
    float2* tab64 = (float2*)(ws + WS_ROPE64); float2* tab32 = (float2*)(ws + WS_ROPE32);
    for (int idx = (F.vcu * NWAVES * 64) + F_TID; idx < S * 48; idx += F.G * NWAVES * 64) {
        const int t = idx / 48, j = idx % 48; const int half = (j < 32) ? 32 : 16, i = (j < 32) ? j : j - 32;
        const float e = (float)i * (2.0f / (float)(2 * half)); const float inv = 1.0f / powf(10000.0f, e); const float ang = (float)t * inv;
        float c, s; sincos_acc(ang, c, s);
        if (j < 32) tab64[t * 32 + i] = make_float2(c, s); else tab32[t * 16 + i] = make_float2(c, s);
    }
}

__device__ __forceinline__ void p9_final(const Frame& F, const Args& A) {
    const int gw = F.vcu * NWAVES + F_WAVE, NGW = F.G * NWAVES; const float* ssq = (const float*)(A.ws + WS_SSQ_Y); const float* g = A.in[17];
    f32x4 gv[4];
#pragma unroll
    for (int j = 0; j < 4; ++j) gv[j] = *((const GAS f32x4*)g + F_LANE + 64 * j);
    for (int m = gw; m < T; m += NGW) {
        const float rs = rstd_from16(ssq + (size_t)m * 16);
        GAS f32x4* xr = (GAS f32x4*)(A.out + (size_t)m * D) + F_LANE;
#pragma unroll
        for (int j = 0; j < 4; ++j) xr[64 * j] = xr[64 * j] * rs * gv[j];
    }
}

__global__ void __launch_bounds__(NWAVES * 64, 2) mega_fwd(Args args) {
    extern __shared__ __attribute__((aligned(16))) unsigned char lds[];
    Frame F;
    F.lds = (LAS unsigned char*)lds;
        F.wave_s = __builtin_amdgcn_readfirstlane((int)threadIdx.x >> 6);
    F.G = gridDim.x; { const int bx = blockIdx.x; F.vcu = (F.G % 8 == 0) ? (bx % 8) * (F.G / 8) + bx / 8 : bx; }
    volatile LAS unsigned* MISC = (volatile LAS unsigned*)(F.lds + MISC_OFF);
    for (int u = F_TID; u < 128; u += NWAVES * 64) MISC[u] = 0u;
    __syncthreads();
    (void)xcd_barrier_post((unsigned*)(args.ws + WS_CTL) + CW_BAR, MISC + 8, F_TID);
#define GRIDBAR() do { XcdBarrier bar_; bar_.bar = (unsigned*)(args.ws + WS_CTL) + CW_BAR; bar_.x = xb_xcc_id(); bar_.st = (volatile LAS unsigned*)(F.lds + MISC_OFF) + 8; xcd_barrier(bar_, F_TID); } while (0)
#define IN(k) true
#define MK_PTRS const Args& A_ = args; unsigned char* ws = A_.ws; bf16_t* XB = (bf16_t*)(ws + WS_XB); bf16_t* PB = (bf16_t*)(ws + WS_PB); bf16_t* QA = (bf16_t*)(ws + WS_QA); bf16_t* KA = (bf16_t*)(ws + WS_KA); bf16_t* VA = (bf16_t*)(ws + WS_VA); bf16_t* LAT = (bf16_t*)(ws + WS_LAT); bf16_t* KR = (bf16_t*)(ws + WS_KR); bf16_t* GA = (bf16_t*)(ws + WS_GA); bf16_t* GB = (bf16_t*)(ws + WS_GB); bf16_t* QM = (bf16_t*)(ws + WS_QM); bf16_t* KM = (bf16_t*)(ws + WS_KM); bf16_t* VM = (bf16_t*)(ws + WS_VM); bf16_t* MOML = (bf16_t*)(ws + WS_MOML); bf16_t* MIX = (bf16_t*)(ws + WS_MIX); bf16_t* ACT = (bf16_t*)(ws + WS_ACT); float* rstd0 = (float*)(ws + WS_RSTD0); float* ssq_cq = (float*)(ws + WS_SSQ_CQ); float* ssq_kv = (float*)(ws + WS_SSQ_KV); float* kmp = (float*)(ws + WS_KMP); float* ssq_x = (float*)(ws + WS_SSQ_X); float* ssq_y = (float*)(ws + WS_SSQ_Y); const float2* rope64 = (const float2*)(ws + WS_ROPE64); const float2* rope32 = (const float2*)(ws + WS_ROPE32);
#ifdef MK_PROBE_A
#define STAMP(k) do { if (blockIdx.x == 0 && F_TID == 0) ((unsigned long long*)(args.ws + WS_CTL + 65536))[(k) + 1] = __builtin_amdgcn_s_memrealtime(); } while (0)
#else
#define STAMP(k) do { } while (0)
#endif
#define SEAM(k) do { if (IN(k) && IN((k) + 1)) GRIDBAR(); STAMP(k); } while (0)
    const int bx = (int)blockIdx.x;

    STAMP(-1);
    if (((MK_PHMASK >> 0) & 1) && IN(0)) for (int rep_ = 0; rep_ < NREP(0); ++rep_) { if (rep_) GRIDBAR(); MK_PTRS (void)XB; (void)PB; (void)QA; (void)KA; (void)VA; (void)LAT; (void)KR; (void)GA; (void)GB; (void)QM; (void)KM; (void)VM; (void)MOML; (void)MIX; (void)ACT; (void)rstd0; (void)ssq_cq; (void)ssq_kv; (void)kmp; (void)ssq_x; (void)ssq_y; (void)rope64; (void)rope32; p0_prologue(F, A_); }
    SEAM(0);
    if (((MK_PHMASK >> 1) & 1) && IN(1)) for (int rep_ = 0; rep_ < NREP(1); ++rep_) { if (rep_) GRIDBAR(); MK_PTRS (void)XB; (void)PB; (void)QA; (void)KA; (void)VA; (void)LAT; (void)KR; (void)GA; (void)GB; (void)QM; (void)KM; (void)VM; (void)MOML; (void)MIX; (void)ACT; (void)rstd0; (void)ssq_cq; (void)ssq_kv; (void)kmp; (void)ssq_x; (void)ssq_y; (void)rope64; (void)rope32;
        pg8::Gemm g{XB, (const bf16_t*)(ws + WS_WIN), T, 4096, 1024, 1024, 1024}; pg8::StaticOrder So; So.init(T, 4096, F.G, bx);
        EpiInProj E{ws};
        pg8::gemm_phase<EpiInProj, pg8::StaticOrder, true, true>(F.lds, g, So, E, F_TID);
    }
    SEAM(1);
    if (((MK_PHMASK >> 2) & 1) && IN(2)) for (int rep_ = 0; rep_ < NREP(2); ++rep_) { if (rep_) GRIDBAR(); MK_PTRS (void)XB; (void)PB; (void)QA; (void)KA; (void)VA; (void)LAT; (void)KR; (void)GA; (void)GB; (void)QM; (void)KM; (void)VM; (void)MOML; (void)MIX; (void)ACT; (void)rstd0; (void)ssq_cq; (void)ssq_kv; (void)kmp; (void)ssq_x; (void)ssq_y; (void)rope64; (void)rope32;
        { const int bh = F.vcu >> 3, s = F.vcu & 7;
          if (bh < NB * 8 && F.G == 256) { const int b = bh >> 3, h = bh & 7;
              for (int r2 = 0; r2 < ((MK_DUP == 33) ? 2 : 1); ++r2) moba::select_units4(b, h, s, QA, kmp, (unsigned char*)A_.out, (char*)lds, F_TID); } }
        { pg8::Gemm g{LAT, (const bf16_t*)(ws + WS_WQB), T, 768, 256, 512, 256}; pg8::StaticOrder So; So.init(T, 768, F.G, bx);
          EpiQb E{ws}; pg8::gemm_phase<EpiQb, pg8::StaticOrder, true, true>(F.lds, g, So, E, F_TID); }
        { pg8::Gemm g{LAT + 256, (const bf16_t*)(ws + WS_WKVB), T, 1024, 128, 512, 256};     pg8::StaticOrder So; So.init(T, 1024, F.G, bx);
          EpiKvb E{ws}; pg8::gemm_phase<EpiKvb, pg8::StaticOrder, true, true>(F.lds, g, So, E, F_TID); }
    }
    SEAM(2);
    if (((MK_PHMASK >> 3) & 1) && IN(3)) for (int rep_ = 0; rep_ < NREP(3); ++rep_) { if (rep_) GRIDBAR(); MK_PTRS (void)XB; (void)PB; (void)QA; (void)KA; (void)VA; (void)LAT; (void)KR; (void)GA; (void)GB; (void)QM; (void)KM; (void)VM; (void)MOML; (void)MIX; (void)ACT; (void)rstd0; (void)ssq_cq; (void)ssq_kv; (void)kmp; (void)ssq_x; (void)ssq_y; (void)rope64; (void)rope32;
        const int bh = F.vcu >> 3, s = F.vcu & 7;
        if (bh < NB * 8 && F.G == 256) {
            const int b = bh >> 3, h = bh & 7;
#ifndef MK_NO_MOBA
            { constexpr unsigned JMASK[8] = {0x00420001u, 0x40840002u, 0x20204004u, 0x02101008u, 0x08080210u, 0x04008420u, 0x01010140u, 0x90002880u};
              const unsigned jm = (s == 0) ? JMASK[0] : (s == 1) ? JMASK[1] : (s == 2) ? JMASK[2] : (s == 3) ? JMASK[3] : (s == 4) ? JMASK[4] : (s == 5) ? JMASK[5] : (s == 6) ? JMASK[6] : JMASK[7];
              for (int r2 = 0; r2 < ((MK_DUP == 30) ? 2 : 1); ++r2)
              for (int j = 0; j < 32; ++j) if ((jm >> j) & 1u) moba::sparse_item<8>(b, h, j, QA, KA, VA, (unsigned char*)A_.out, (bf16_t*)(ws + WS_GB + (size_t)32 * 1024 * 1024), (char*)lds, F_TID);
            }
#endif
#ifndef MK_NO_MLA
            for (int r2 = 0; r2 < ((MK_DUP == 31) ? 2 : 1); ++r2)
            for (int i = 0; i < 4; ++i) { const int qb = (i == 0) ? s : (i == 1) ? 15 - s : (i == 2) ? 16 + s : 31 - s;
#ifndef MK_NO_MOBA
                if (i == 2 && F_TID == 0) {
                    __builtin_amdgcn_fence(__ATOMIC_RELEASE, "agent"); asm volatile("s_waitcnt vmcnt(0)" ::: "memory");
                    __hip_atomic_fetch_add((unsigned*)(ws + WS_CTL) + CW_MOBA + 64 * bh, 1u, __ATOMIC_RELAXED, __HIP_MEMORY_SCOPE_AGENT); }
#endif
                MLA_UNIT<96, false, 8, 768, 768, 512, 512>(b, h, qb, QM, h * 96, KM, h * 96, VM, h * 64, LAT, h * 64, kmp, (char*)lds, F_TID); }
#endif
        }
    }
    if (((MK_PHMASK >> 3) & 1)) {
        MK_PTRS (void)XB; (void)PB; (void)KR; (void)LAT; (void)GA; (void)GB; (void)QM; (void)KM; (void)VM; (void)MIX; (void)ACT; (void)rstd0; (void)ssq_cq; (void)ssq_kv; (void)ssq_x; (void)ssq_y; (void)rope64; (void)rope32;
        const int bh = F.vcu >> 3, s = F.vcu & 7;
        if (bh < NB * 8 && F.G == 256) { const int b = bh >> 3, h = bh & 7;
            if (F_WAVE == 0) { unsigned* w_ = (unsigned*)(ws + WS_CTL) + CW_MOBA + 64 * bh; unsigned sp_ = 0;
                while ((unsigned)__builtin_amdgcn_readfirstlane(__hip_atomic_load(w_, __ATOMIC_RELAXED, __HIP_MEMORY_SCOPE_AGENT)) < 8u) { __builtin_amdgcn_s_sleep(4); if (++sp_ > (1u << 22)) break; }
                __builtin_amdgcn_fence(__ATOMIC_ACQUIRE, "agent"); asm volatile("s_waitcnt vmcnt(0)" ::: "memory"); }
            __syncthreads();
            for (int i = 0; i < 4; ++i) { const int qb = (i == 0) ? s : (i == 1) ? 15 - s : (i == 2) ? 16 + s : 31 - s;
                moba::merge_block(b, h, qb, QA, (const unsigned char*)A_.out, (const bf16_t*)(ws + WS_GB + (size_t)32 * 1024 * 1024), F_TID); } } }
    SEAM(3);
    if (((MK_PHMASK >> 4) & 1) && IN(4)) for (int rep_ = 0; rep_ < NREP(4); ++rep_) { if (rep_) GRIDBAR(); MK_PTRS (void)XB; (void)PB; (void)QA; (void)KA; (void)VA; (void)LAT; (void)KR; (void)GA; (void)GB; (void)QM; (void)KM; (void)VM; (void)MOML; (void)MIX; (void)ACT; (void)rstd0; (void)ssq_cq; (void)ssq_kv; (void)kmp; (void)ssq_x; (void)ssq_y; (void)rope64; (void)rope32;
        pg8::Gemm g{QA, (const bf16_t*)(ws + WS_WBR), T, 1024, 512, 512, 1024}; pg8::PairOrder So; So.init(T, 1024, F.G, bx); So.ksub = 512; So.adelta = (int)((WS_LAT - WS_QA) / 2);
        EpiBranch E{(const unsigned char*)GA, (const unsigned char*)GB, MIX}; pg8::gemm_phase<EpiBranch, pg8::PairOrder, true, true>(F.lds, g, So, E, F_TID);
    }
    SEAM(4);
    if (((MK_PHMASK >> 5) & 1) && IN(5)) for (int rep_ = 0; rep_ < NREP(5); ++rep_) { if (rep_) GRIDBAR(); MK_PTRS (void)XB; (void)PB; (void)QA; (void)KA; (void)VA; (void)LAT; (void)KR; (void)GA; (void)GB; (void)QM; (void)KM; (void)VM; (void)MOML; (void)MIX; (void)ACT; (void)rstd0; (void)ssq_cq; (void)ssq_kv; (void)kmp; (void)ssq_x; (void)ssq_y; (void)rope64; (void)rope32;
        pg8::Gemm g{MIX, (const bf16_t*)(ws + WS_WO), T, 1024, 1024, 1024, 1024}; pg8::StaticOrder So; So.init(T, 1024, F.G, bx);
        EpiResidT<false> E{XB, XB, ssq_x}; pg8::gemm_phase<EpiResidT<false>, pg8::StaticOrder, true, true>(F.lds, g, So, E, F_TID);
    }
    SEAM(5);
    if (((MK_PHMASK >> 6) & 1) && IN(6)) for (int rep_ = 0; rep_ < NREP(6); ++rep_) { if (rep_) GRIDBAR(); MK_PTRS (void)XB; (void)PB; (void)QA; (void)KA; (void)VA; (void)LAT; (void)KR; (void)GA; (void)GB; (void)QM; (void)KM; (void)VM; (void)MOML; (void)MIX; (void)ACT; (void)rstd0; (void)ssq_cq; (void)ssq_kv; (void)kmp; (void)ssq_x; (void)ssq_y; (void)rope64; (void)rope32;
        pg8::Gemm g{XB, (const bf16_t*)(ws + WS_WGU), T, 2 * DFF, 1024, 1024, 1024}; pg8::StaticOrder So; So.init(T, 2 * DFF, F.G, bx);
#if MK_DUP >= 61 && MK_DUP <= 63
        { EpiGateUp E{ssq_x, ACT}; pg8::gemm_phase<EpiGateUp, pg8::StaticOrder, true, true>(F.lds, g, So, E, F_TID); GRIDBAR(); }
        { EpiGateUpT<MK_DUP - 60> E{ssq_x, ACT}; pg8::gemm_phase<EpiGateUpT<MK_DUP - 60>, pg8::StaticOrder, true, true>(F.lds, g, So, E, F_TID); }
#else
        EpiGateUp E{ssq_x, ACT}; pg8::gemm_phase<EpiGateUp, pg8::StaticOrder, true, true>(F.lds, g, So, E, F_TID);
#endif
    }
    SEAM(6);
    if (((MK_PHMASK >> 7) & 1) && IN(7)) for (int rep_ = 0; rep_ < NREP(7); ++rep_) { if (rep_) GRIDBAR(); MK_PTRS (void)XB; (void)PB; (void)QA; (void)KA; (void)VA; (void)LAT; (void)KR; (void)GA; (void)GB; (void)QM; (void)KM; (void)VM; (void)MOML; (void)MIX; (void)ACT; (void)rstd0; (void)ssq_cq; (void)ssq_kv; (void)kmp; (void)ssq_x; (void)ssq_y; (void)rope64; (void)rope32;
        pg8::Gemm g{ACT, (const bf16_t*)(ws + WS_WD), T, 1024, DFF, DFF, DFF}; pg8::StaticOrder So; So.init(T, 1024, F.G, bx);
        EpiResidT<false> E{XB, XB, ssq_x}; pg8::gemm_phase<EpiResidT<false>, pg8::StaticOrder, true, true>(F.lds, g, So, E, F_TID);
    }
    SEAM(7);
    if (((MK_PHMASK >> 8) & 1) && IN(8)) for (int rep_ = 0; rep_ < NREP(8); ++rep_) { if (rep_) GRIDBAR(); MK_PTRS (void)XB; (void)PB; (void)QA; (void)KA; (void)VA; (void)LAT; (void)KR; (void)GA; (void)GB; (void)QM; (void)KM; (void)VM; (void)MOML; (void)MIX; (void)ACT; (void)rstd0; (void)ssq_cq; (void)ssq_kv; (void)kmp; (void)ssq_x; (void)ssq_y; (void)rope64; (void)rope32;
        bf16_t* TMP = (bf16_t*)(ws + WS_TMP8);
        { pg8::Gemm g{XB, (const bf16_t*)(ws + WS_WPG), T, 1024, 1024, 1024, 1024}; pg8::StaticOrder So; So.init(T, 1024, F.G, bx);
          EpiPleA E{ssq_x, (unsigned char*)TMP}; pg8::gemm_phase<EpiPleA, pg8::StaticOrder, true, true>(F.lds, g, So, E, F_TID); }
        { pg8::Gemm g{PB, (const bf16_t*)(ws + WS_WPP), T, 1024, 256, 256, 256}; pg8::StaticOrder So; So.init(T, 1024, F.G, bx);
          EpiPleB E{(const unsigned char*)TMP, XB, A_.out, A_.in[17], ssq_y, (unsigned*)(ws + WS_CTL) + CW_PNL, F.lds + XL_OFF}; pg8::gemm_phase<EpiPleB, pg8::StaticOrder, true, true>(F.lds, g, So, E, F_TID); }
    }
#ifdef MK_PROBE_A
    STAMP(9);
    if (blockIdx.x == 0 && F_TID < 64) {
        asm volatile("s_waitcnt vmcnt(0)" ::: "memory");
        const unsigned long long* ts = (const unsigned long long*)(args.ws + WS_CTL + 65536);
        const float dA = (float)(ts[MK_PROBE_A + 1] - ts[MK_PROBE_A]) * 0.01f, dB = (float)(ts[MK_PROBE_B + 1] - ts[MK_PROBE_B]) * 0.01f;
        if (F_TID == 0) args.out[0] += dA;
        for (int r = 1; r < 16; ++r) for (int c = F_TID; c < 1024; c += 64) args.out[(size_t)r * 2048 * 1024 + c] += dB;
    }
#endif
#undef IN
#undef SEAM
}

static inline bool launch(void* const* d_in, float* out, unsigned char* ws, hipStream_t stream, int ph_lo, int ph_hi) {
    static int grid = 0;
    if (grid == 0) {
        int dev = 0, cus = 0, per_cu = 0;
        if (hipGetDevice(&dev) != hipSuccess || hipDeviceGetAttribute(&cus, hipDeviceAttributeMultiprocessorCount, dev) != hipSuccess) { fprintf(stderr, "mk: device query failed\n"); grid = -1; return false; }
        if (hipFuncSetAttribute((const void*)mega_fwd, hipFuncAttributeMaxDynamicSharedMemorySize, LDS_BYTES) != hipSuccess) { fprintf(stderr, "mk: hipFuncSetAttribute failed\n"); grid = -1; return false; }
        if (hipOccupancyMaxActiveBlocksPerMultiprocessor(&per_cu, (const void*)mega_fwd, NWAVES * 64, LDS_BYTES) != hipSuccess || per_cu < 1) { fprintf(stderr, "mk: occupancy query says %d blocks per CU\n", per_cu); (void)hipGetLastError(); grid = -1; return false; }
        grid = cus;
        if (grid != 256) fprintf(stderr, "mk: %d CUs (expected 256)\n", grid);
    }
    if (grid < 0) return false;
    if (hipMemsetAsync(ws + WS_CTL, 0, CTL_ZERO_BYTES, stream) != hipSuccess) return false;
    Args a{};
    for (int i = 0; i < 18; ++i) a.in[i] = (const float*)d_in[i];
    a.out = out; a.ws = ws; a.ph_lo = ph_lo; a.ph_hi = ph_hi;
    hipLaunchKernelGGL(mega_fwd, dim3(grid), dim3(NWAVES * 64), LDS_BYTES, stream, a);
    return hipPeekAtLastError() == hipSuccess;
}
}
extern "C" void kernel_launch(void* const* d_in, const int* in_sizes, int n_in, void* d_out, int out_size, void* d_ws, size_t ws_size, hipStream_t stream) {
    if (n_in != 18 || out_size != 4 * 8192 * 1024 || ws_size < mk::WS_MEGA_END) { fprintf(stderr, "kernel_launch: unexpected sizes n_in %d out %d ws %zu\n", n_in, out_size, ws_size); return; }
    mk::launch(d_in, (float*)d_out, (unsigned char*)d_ws, stream, 0, 10);
}
```
